# Optimizing an MI355X kernel written in HIP

```python
import math
import jax
import jax.numpy as jnp
from jax import lax
import numpy as np

D_MODEL = 2048
BATCH = 8
SEQ = 4096
DEPTH = 4

HEAD_DIM = 128
REL_HEADS = 8
A_HEADS = REL_HEADS
A_KV_HEADS = 2
A_WINDOW = 128
B_HEADS = 8
C_HEADS = REL_HEADS
C_KV_GROUPS = 2
CMP_BLOCK = 32
CMP_STRIDE = 16
CMP_HIDDEN = 256
SEL_BLOCK = 64
N_SELECT = 8
C_WINDOW = 512
D_HEADS = 8
D_CONV = 4
GDN_CHUNK = 64
NUM_BUCKETS = 32
MAX_DISTANCE = 128
D_FF = 11 * D_MODEL // 4
FFN_CONV = 3
Q_BLOCK = 128
EPS = 1e-6
NEG_INF = -1e30
FORCE_SCORE = 1e9
SCALE = HEAD_DIM ** -0.5
EVEN_WIDTH = (A_HEADS + B_HEADS) * HEAD_DIM
ODD_WIDTH = (C_HEADS + D_HEADS) * HEAD_DIM
EVEN_SPLITS = (A_HEADS * HEAD_DIM, A_KV_HEADS * HEAD_DIM, A_KV_HEADS * HEAD_DIM,
               B_HEADS * HEAD_DIM, B_HEADS * HEAD_DIM, B_HEADS * HEAD_DIM, B_HEADS)
ODD_SPLITS = ((C_HEADS * HEAD_DIM,) + (C_KV_GROUPS * HEAD_DIM,) * 6 + (3 * C_HEADS,)
              + (D_HEADS * HEAD_DIM,) * 3 + (D_HEADS, D_HEADS, D_HEADS * HEAD_DIM))
EVEN_COLS = sum(EVEN_SPLITS)
ODD_COLS = sum(ODD_SPLITS)

kernel_name = 'hybrid_swa_fox_nsa_gdn_convffn_trunk'


def rmsnorm(x, g):
    xf = x.astype(jnp.float32)
    y = xf * lax.rsqrt(jnp.mean(xf * xf, axis=-1, keepdims=True) + EPS)
    return (y * g.astype(jnp.float32)).astype(x.dtype)


def l2norm(x):
    return x * lax.rsqrt(jnp.sum(x * x, axis=-1, keepdims=True) + EPS)


def split_cols(x, sizes):
    cuts = [int(c) for c in np.cumsum(sizes)[:-1]]
    return jnp.split(x, cuts, axis=-1)


def causal_dwconv(x, w):
    width, t = w.shape[0], x.shape[1]
    xp = jnp.pad(x, ((0, 0), (width - 1, 0), (0, 0)))
    return sum(xp[:, j:j + t] * w[j] for j in range(width))


def masked_softmax(logits, mask):
    p = jax.nn.softmax(jnp.where(mask, logits, NEG_INF), axis=-1)
    return jnp.where(mask, p, 0.0)


def t5_bucket(dist):
    max_exact = NUM_BUCKETS // 2
    n = jnp.maximum(dist, 0)
    log_ratio = jnp.log(jnp.maximum(n, 1).astype(jnp.float32) / max_exact) / math.log(MAX_DISTANCE / max_exact)
    large = jnp.minimum(max_exact + (log_ratio * (NUM_BUCKETS - max_exact)).astype(jnp.int32), NUM_BUCKETS - 1)
    return jnp.where(n < max_exact, n, large)


def banded_blocks(x, window):
    bsz, t = x.shape[:2]
    nb, nprev = t // Q_BLOCK, window // Q_BLOCK
    xp = jnp.pad(x, ((0, 0), (window, 0), (0, 0), (0, 0))).reshape(bsz, nb + nprev, Q_BLOCK, *x.shape[2:])
    return jnp.concatenate([xp[:, s:s + nb] for s in range(nprev + 1)], axis=2)


def banded_mask_bias(rel_bias, window, nb):
    span = window + Q_BLOCK
    kl = jnp.arange(span)
    dist = jnp.arange(Q_BLOCK)[:, None] + window - kl[None, :]
    kpos = jnp.arange(nb)[:, None, None] * Q_BLOCK - window + kl
    mask = (dist >= 0) & (dist < window) & (kpos >= 0)
    bias = rel_bias[t5_bucket(dist)].transpose(2, 0, 1)
    return mask, bias


def swa_sink_attention(q, k, v, sinks, rel_bias):
    bsz, t, _ = q.shape
    nb = t // Q_BLOCK
    g, r = A_KV_HEADS, A_HEADS // A_KV_HEADS
    qb = q.reshape(bsz, nb, Q_BLOCK, g, r, HEAD_DIM)
    kb = banded_blocks(k.reshape(bsz, t, g, HEAD_DIM), A_WINDOW)
    vb = banded_blocks(v.reshape(bsz, t, g, HEAD_DIM), A_WINDOW)
    mask, bias = banded_mask_bias(rel_bias, A_WINDOW, nb)
    logits = (jnp.einsum('bnqgrd,bnkgd->bgrnqk', qb, kb).astype(jnp.float32) * SCALE
              + bias.reshape(g, r, 1, Q_BLOCK, -1).astype(jnp.float32))
    logits = jnp.where(mask, logits, NEG_INF)
    sink = sinks.astype(jnp.float32).reshape(g, r, 1, 1, 1)
    m = jnp.maximum(logits.max(axis=-1, keepdims=True), sink)
    e = jnp.where(mask, jnp.exp(logits - m), 0.0)
    p = e / (e.sum(axis=-1, keepdims=True) + jnp.exp(sink - m))
    o = jnp.einsum('bgrnqk,bnkgd->bnqgrd', p.astype(v.dtype), vb)
    return o.reshape(bsz, t, A_HEADS * HEAD_DIM)


def forgetting_attention(q, k, v, f_logit):
    bsz, t, _ = q.shape
    nb = t // Q_BLOCK
    heads = lambda a: a.reshape(bsz, t, B_HEADS, HEAD_DIM).transpose(0, 2, 1, 3)
    q, k, v = heads(q), heads(k), heads(v)
    c = jnp.cumsum(jax.nn.log_sigmoid(f_logit.astype(jnp.float32)), axis=1).transpose(0, 2, 1)
    qb = jnp.moveaxis(q.reshape(bsz, B_HEADS, nb, Q_BLOCK, HEAD_DIM), 2, 0)
    cb = jnp.moveaxis(c.reshape(bsz, B_HEADS, nb, Q_BLOCK), 2, 0)
    kpos = jnp.arange(t)

    def block(args):
        i, qi, ci = args
        qpos = i * Q_BLOCK + jnp.arange(Q_BLOCK)
        logits = (jnp.einsum('bhqd,bhkd->bhqk', qi, k).astype(jnp.float32) * SCALE
                  + ci[..., None] - c[:, :, None, :])
        p = masked_softmax(logits, kpos[None, :] <= qpos[:, None])
        return jnp.einsum('bhqk,bhkd->bhqd', p.astype(v.dtype), v)

    o = lax.map(block, (jnp.arange(nb), qb, cb))
    return o.transpose(1, 0, 3, 2, 4).reshape(bsz, t, B_HEADS * HEAD_DIM)


def compress_tokens(x, pe, w1, w2):
    bsz, t, g, d = x.shape
    ratio = CMP_BLOCK // CMP_STRIDE
    n_cmp = t // CMP_STRIDE - ratio + 1
    chunks = x.reshape(bsz, t // CMP_STRIDE, CMP_STRIDE, g, d)
    blocks = jnp.concatenate([chunks[:, m:m + n_cmp] for m in range(ratio)], axis=2) + pe[:, None, :]
    flat = blocks.transpose(0, 1, 3, 2, 4).reshape(bsz, n_cmp, g, CMP_BLOCK * d)
    return jax.nn.gelu(flat @ w1) @ w2


def nsa_attention(q, k_cmp, v_cmp, k_sel, v_sel, k_win, v_win, gate_logits, cmp_pos, cmp_w1, cmp_w2, rel_bias):
    bsz, t, _ = q.shape
    g, r = C_KV_GROUPS, C_HEADS // C_KV_GROUPS
    nb = t // Q_BLOCK
    kv = lambda a: a.reshape(bsz, t, g, HEAD_DIM)
    kc = compress_tokens(kv(k_cmp), cmp_pos[0], cmp_w1[0], cmp_w2[0])
    vc = compress_tokens(kv(v_cmp), cmp_pos[1], cmp_w1[1], cmp_w2[1])
    cmp_end = jnp.arange(kc.shape[1]) * CMP_STRIDE + CMP_BLOCK - 1
    n_sb = t // SEL_BLOCK
    n_sel = min(N_SELECT, n_sb)
    ks = kv(k_sel).reshape(bsz, n_sb, SEL_BLOCK, g, HEAD_DIM).transpose(0, 3, 1, 2, 4)
    vs = kv(v_sel).reshape(bsz, n_sb, SEL_BLOCK, g, HEAD_DIM).transpose(0, 3, 1, 2, 4)
    kw = banded_blocks(kv(k_win), C_WINDOW)
    vw = banded_blocks(kv(v_win), C_WINDOW)
    mask_w, bias_w = banded_mask_bias(rel_bias, C_WINDOW, nb)
    bias_w = bias_w.reshape(g, r, Q_BLOCK, -1).astype(jnp.float32)
    tab = rel_bias.T.reshape(g, r, NUM_BUCKETS).astype(jnp.float32)
    gates = jax.nn.sigmoid(gate_logits.astype(jnp.float32)).reshape(bsz, nb, Q_BLOCK, 3, g, r)
    qb = q.reshape(bsz, nb, Q_BLOCK, g, r, HEAD_DIM)
    b_ar = jnp.arange(bsz)[:, None, None, None]
    g_ar = jnp.arange(g)[None, :, None, None]
    ratio = CMP_BLOCK // CMP_STRIDE
    n_chunk = t // CMP_STRIDE
    sel_ids = jnp.arange(n_sb)

    def block(args):
        i, qi, kwi, vwi, mwi, gi = args
        qpos = i * Q_BLOCK + jnp.arange(Q_BLOCK)
        lc = jnp.einsum('bqgrd,bcgd->bgrqc', qi, kc).astype(jnp.float32) * SCALE
        pc = masked_softmax(lc, cmp_end[None, :] <= qpos[:, None])
        o_cmp = jnp.einsum('bgrqc,bcgd->bqgrd', pc.astype(vc.dtype), vc)
        imp = jnp.pad(pc.sum(axis=2), ((0, 0), (0, 0), (0, 0), (ratio - 1, ratio - 1)))
        chunk = sum(imp[..., m:m + n_chunk] for m in range(ratio))
        blk = chunk.reshape(bsz, g, Q_BLOCK, n_sb, SEL_BLOCK // CMP_STRIDE).sum(-1)
        cur = (qpos // SEL_BLOCK)[:, None]
        forced = (sel_ids == 0) | (sel_ids == cur) | (sel_ids == cur - 1)
        score = jnp.where(forced, FORCE_SCORE, jnp.where(sel_ids > cur, -FORCE_SCORE, blk))
        _, idx = lax.top_k(score, n_sel)
        k_g = ks[b_ar, g_ar, idx].reshape(bsz, g, Q_BLOCK, n_sel * SEL_BLOCK, HEAD_DIM)
        v_g = vs[b_ar, g_ar, idx].reshape(bsz, g, Q_BLOCK, n_sel * SEL_BLOCK, HEAD_DIM)
        kpos = (idx[..., None] * SEL_BLOCK + jnp.arange(SEL_BLOCK)).reshape(bsz, g, Q_BLOCK, -1)
        dist = qpos[:, None] - kpos
        bias_s = jnp.moveaxis(tab[g_ar, :, t5_bucket(dist)], -1, 2)
        ls = jnp.einsum('bqgrd,bgqkd->bgrqk', qi, k_g).astype(jnp.float32) * SCALE + bias_s
        ps = masked_softmax(ls, (dist >= 0)[:, :, None])
        o_sel = jnp.einsum('bgrqk,bgqkd->bqgrd', ps.astype(v_g.dtype), v_g)
        lw = jnp.einsum('bqgrd,bkgd->bgrqk', qi, kwi).astype(jnp.float32) * SCALE + bias_w
        pw = masked_softmax(lw, mwi)
        o_win = jnp.einsum('bgrqk,bkgd->bqgrd', pw.astype(vwi.dtype), vwi)
        out = (gi[:, :, 0, :, :, None] * o_cmp + gi[:, :, 1, :, :, None] * o_sel
               + gi[:, :, 2, :, :, None] * o_win)
        return out.astype(q.dtype)

    mv = lambda a: jnp.moveaxis(a, 1, 0)
    o = lax.map(block, (jnp.arange(nb), mv(qb), mv(kw), mv(vw), mask_w, mv(gates)))
    return jnp.moveaxis(o, 0, 1).reshape(bsz, t, C_HEADS * HEAD_DIM)


def gated_deltanet(q, k, v, beta_logit, a, z, conv_w, a_log, dt_bias, norm_g):
    dtype = q.dtype
    bsz, t, _ = q.shape
    h, d, c = D_HEADS, HEAD_DIM, GDN_CHUNK
    n = t // c
    f32 = jnp.float32
    qkv = jax.nn.silu(causal_dwconv(jnp.concatenate([q, k, v], axis=-1), conv_w)).astype(f32)
    q, k, v = jnp.split(qkv, 3, axis=-1)
    chunked = lambda x: x.reshape(bsz, n, c, h, d).transpose(0, 3, 1, 2, 4)
    q = l2norm(chunked(q)) * SCALE
    k = l2norm(chunked(k))
    v = chunked(v)
    beta = jax.nn.sigmoid(beta_logit.astype(f32)).reshape(bsz, n, c, h).transpose(0, 3, 1, 2)
    g = -jnp.exp(a_log.astype(f32)) * jax.nn.softplus(a.astype(f32) + dt_bias.astype(f32))
    gam = jnp.cumsum(g.reshape(bsz, n, c, h).transpose(0, 3, 1, 2), axis=-1)
    causal = jnp.tril(jnp.ones((c, c), bool))
    strict = jnp.tril(jnp.ones((c, c), bool), -1)
    diff = gam[..., :, None] - gam[..., None, :]
    decay = jnp.where(causal, jnp.exp(jnp.where(causal, diff, 0.0)), 0.0)
    k_beta = k * beta[..., None]
    m = jnp.eye(c, dtype=f32) + jnp.where(strict, jnp.einsum('bhnid,bhnjd->bhnij', k_beta, k) * decay, 0.0)
    u = lax.linalg.triangular_solve(m, v * beta[..., None], left_side=True, lower=True, unit_diagonal=True)
    w = lax.linalg.triangular_solve(m, k_beta * jnp.exp(gam)[..., None], left_side=True, lower=True, unit_diagonal=True)

    def step(state, inp):
        qc, kc, uc, wc, dc, gc = inp
        v_new = uc - jnp.einsum('bhid,bhde->bhie', wc, state)
        o = (jnp.einsum('bhid,bhde->bhie', qc * jnp.exp(gc)[..., None], state)
             + jnp.einsum('bhij,bhje->bhie', jnp.einsum('bhid,bhjd->bhij', qc, kc) * dc, v_new))
        g_last = gc[..., -1:]
        state = (state * jnp.exp(g_last)[..., None]
                 + jnp.einsum('bhjd,bhje->bhde', kc * jnp.exp(g_last - gc)[..., None], v_new))
        return state, o

    xs = tuple(jnp.moveaxis(arr, 2, 0) for arr in (q, k, u, w, decay, gam))
    _, o = lax.scan(step, jnp.zeros((bsz, h, d, d), f32), xs)
    o = o.transpose(1, 0, 3, 2, 4).reshape(bsz, t, h, d)
    o = rmsnorm(o, norm_g) * jax.nn.silu(z.astype(f32).reshape(bsz, t, h, d))
    return o.reshape(bsz, t, h * d).astype(dtype)


def even_mixer(h, w_in, b_forget, sinks, w_out, rel_bias):
    qa, ka, va, qb, kb, vb, f = split_cols(h @ w_in, EVEN_SPLITS)
    o_a = swa_sink_attention(qa, ka, va, sinks, rel_bias)
    o_b = forgetting_attention(qb, kb, vb, f + b_forget)
    return jnp.concatenate([o_a, o_b.astype(o_a.dtype)], axis=-1) @ w_out


def odd_mixer(h, w_in, cmp_pos, cmp_w1, cmp_w2, conv_w, a_log, dt_bias, gdn_norm, w_out, rel_bias):
    (qc, kcmp, vcmp, ksel, vsel, kwin, vwin, gates,
     qd, kd, vd, beta, a, z) = split_cols(h @ w_in, ODD_SPLITS)
    o_c = nsa_attention(qc, kcmp, vcmp, ksel, vsel, kwin, vwin, gates, cmp_pos, cmp_w1, cmp_w2, rel_bias)
    o_d = gated_deltanet(qd, kd, vd, beta, a, z, conv_w, a_log, dt_bias, gdn_norm)
    return jnp.concatenate([o_c, o_d.astype(o_c.dtype)], axis=-1) @ w_out


def conv_ffn(h, w_up, conv_w, conv_b, w_down):
    u, g = jnp.split(h @ w_up, 2, axis=-1)
    g = causal_dwconv(g, conv_w) + conv_b
    return (jax.nn.silu(g) * u) @ w_down


def setup_inputs(seed: int = 0) -> dict:
    key = jax.random.key(seed)
    ks = jax.random.split(key, 22)
    n_ev, n_od = (DEPTH + 1) // 2, DEPTH // 2
    f32 = jnp.float32

    def nrm(k, shape, scale):
        return scale * jax.random.normal(k, shape, f32)

    def gain(k, shape):
        return 1.0 + 0.02 * jax.random.normal(k, shape, f32)

    dt = jnp.exp(jax.random.uniform(ks[15], (n_od, D_HEADS), f32, math.log(1e-3), math.log(1e-1)))
    return {
        'x': nrm(ks[0], (BATCH, SEQ, D_MODEL), 1.0),
        'rel_bias': nrm(ks[1], (NUM_BUCKETS, REL_HEADS), 0.5),
        'norm_mix': gain(ks[2], (DEPTH, D_MODEL)),
        'norm_ffn': gain(ks[3], (DEPTH, D_MODEL)),
        'norm_final': gain(ks[4], (D_MODEL,)),
        'ev_w_in': nrm(ks[5], (n_ev, D_MODEL, EVEN_COLS), D_MODEL ** -0.5),
        'ev_b_forget': 2.0 + nrm(ks[6], (n_ev, B_HEADS), 0.5),
        'ev_sinks': nrm(ks[7], (n_ev, A_HEADS), 0.5),
        'ev_w_out': nrm(ks[8], (n_ev, EVEN_WIDTH, D_MODEL), EVEN_WIDTH ** -0.5),
        'od_w_in': nrm(ks[9], (n_od, D_MODEL, ODD_COLS), D_MODEL ** -0.5),
        'od_cmp_pos': nrm(ks[10], (n_od, 2, CMP_BLOCK, HEAD_DIM), 0.1),
        'od_cmp_w1': nrm(ks[11], (n_od, 2, CMP_BLOCK * HEAD_DIM, CMP_HIDDEN), (CMP_BLOCK * HEAD_DIM) ** -0.5),
        'od_cmp_w2': nrm(ks[12], (n_od, 2, CMP_HIDDEN, HEAD_DIM), CMP_HIDDEN ** -0.5),
        'od_conv_w': nrm(ks[13], (n_od, D_CONV, 3 * D_HEADS * HEAD_DIM), D_CONV ** -0.5),
        'od_a_log': jnp.log(jax.random.uniform(ks[14], (n_od, D_HEADS), f32, 1.0, 16.0)),
        'od_dt_bias': dt + jnp.log(-jnp.expm1(-dt)),
        'od_gdn_norm': gain(ks[16], (n_od, HEAD_DIM)),
        'od_w_out': nrm(ks[17], (n_od, ODD_WIDTH, D_MODEL), ODD_WIDTH ** -0.5),
        'ffn_w_up': nrm(ks[18], (DEPTH, D_MODEL, 2 * D_FF), D_MODEL ** -0.5),
        'ffn_conv_w': nrm(ks[19], (DEPTH, FFN_CONV, D_FF), FFN_CONV ** -0.5),
        'ffn_conv_b': nrm(ks[20], (DEPTH, D_FF), 0.02),
        'ffn_w_down': nrm(ks[21], (DEPTH, D_FF, D_MODEL), D_FF ** -0.5),
    }


def reference(x, rel_bias, norm_mix, norm_ffn, norm_final,
              ev_w_in, ev_b_forget, ev_sinks, ev_w_out,
              od_w_in, od_cmp_pos, od_cmp_w1, od_cmp_w2, od_conv_w, od_a_log, od_dt_bias, od_gdn_norm, od_w_out,
              ffn_w_up, ffn_conv_w, ffn_conv_b, ffn_w_down):
    h = x
    for layer in range(DEPTH):
        j = layer // 2
        hn = rmsnorm(h, norm_mix[layer])
        if layer % 2 == 0:
            mix = even_mixer(hn, ev_w_in[j], ev_b_forget[j], ev_sinks[j], ev_w_out[j], rel_bias)
        else:
            mix = odd_mixer(hn, od_w_in[j], od_cmp_pos[j], od_cmp_w1[j], od_cmp_w2[j], od_conv_w[j],
                            od_a_log[j], od_dt_bias[j], od_gdn_norm[j], od_w_out[j], rel_bias)
        h = h + mix.astype(h.dtype)
        h = h + conv_ffn(rmsnorm(h, norm_ffn[layer]), ffn_w_up[layer], ffn_conv_w[layer],
                         ffn_conv_b[layer], ffn_w_down[layer]).astype(h.dtype)
    return rmsnorm(h, norm_final)
```

```cpp
#define MIXERS 3
#define N_LAUNCH_MODE 1
#include <hip/hip_runtime.h>
#include <cstdio>
#include <cstdint>

#define LAS __attribute__((address_space(3)))
typedef unsigned short bf16_t;
typedef short bf16x8 __attribute__((ext_vector_type(8)));
typedef short s16x4 __attribute__((ext_vector_type(4)));
typedef float f32x2 __attribute__((ext_vector_type(2)));
typedef float f32x4 __attribute__((ext_vector_type(4)));
typedef float f32x16 __attribute__((ext_vector_type(16)));
typedef unsigned u32x2 __attribute__((ext_vector_type(2)));
typedef unsigned u32x4 __attribute__((ext_vector_type(4)));

constexpr int NB = 8, T = 4096, M = NB * T, D = 2048, HD = 128;
constexpr int EV_N = 4616, EV_NP = 4864, OD_N = 6696, OD_NP = 6912, FF = 5632, FF2 = 11264;
constexpr int MH = M / 2;
constexpr int NTHR = 512, NWAVE = 8;
constexpr int LDS_BYTES = 159744;
constexpr int LDS_BARW = LDS_BYTES - 16;
constexpr float EPS = 1e-6f;
constexpr float SCALE = 0.08838834764831845f;
constexpr float INV_SCALE = 11.313708498984761f;
constexpr float LOG2E = 1.4426950408889634f;

constexpr int EC_QA = 0, EC_QB = 1024, EC_KA = 2048, EC_VA = 2304, EC_KB = 2560, EC_VB = 3584, EC_F = 4608;
constexpr int OC_QC = 0, OC_QD = 1024, OC_KCMP = 2048, OC_VCMP = 2304, OC_KSEL = 2560, OC_VSEL = 2816, OC_KWIN = 3072, OC_VWIN = 3328,
              OC_KD = 3584, OC_VD = 4608, OC_Z = 5632, OC_GATE = 6656, OC_BETA = 6680, OC_A = 6688;

__host__ __device__ inline int ev_src(int n) {
    if (n < 1024) return n;
    if (n < 2048) return n - 1024 + 1536;
    if (n < 2304) return n - 2048 + 1024;
    if (n < 2560) return n - 2304 + 1280;
    if (n < 3584) return n - 2560 + 2560;
    if (n < 4608) return n - 3584 + 3584;
    if (n < 4616) return n;
    return -1;
}
__host__ __device__ inline int od_src(int n) {
    if (n < 1024) return n;
    if (n < 2048) return n - 1024 + 2584;
    if (n < 3584) return n - 2048 + 1024;
    if (n < 4608) return n - 3584 + 3608;
    if (n < 5632) return n - 4608 + 4632;
    if (n < 6656) return n - 5632 + 5672;
    if (n < 6680) return n - 6656 + 2560;
    if (n < 6688) return n - 6680 + 5656;
    if (n < 6696) return n - 6688 + 5664;
    return -1;
}

constexpr size_t al256(size_t x) { return (x + 255) & ~(size_t)255; }
constexpr size_t WS_CTL = 0, CTL_BYTES = 65536;
constexpr size_t SZ_W_EV_IN = (size_t)EV_NP * D * 2, SZ_W_OUT = (size_t)D * D * 2, SZ_W_OD_IN = (size_t)OD_NP * D * 2,
                 SZ_W_UP = (size_t)FF2 * D * 2, SZ_W_DN = (size_t)D * FF * 2, SZ_W_C1 = (size_t)256 * 4096 * 2, SZ_W_C2 = (size_t)256 * 256 * 2;
constexpr size_t WS_W_EV_IN = WS_CTL + CTL_BYTES;
constexpr size_t WS_W_EV_OUT = WS_W_EV_IN + 2 * SZ_W_EV_IN;
constexpr size_t WS_W_OD_IN = WS_W_EV_OUT + 2 * SZ_W_OUT;
constexpr size_t WS_W_OD_OUT = WS_W_OD_IN + 2 * SZ_W_OD_IN;
constexpr size_t WS_W_UP = WS_W_OD_OUT + 2 * SZ_W_OUT;
constexpr size_t WS_W_DN = WS_W_UP + 4 * SZ_W_UP;
constexpr size_t WS_W_C1 = WS_W_DN + 4 * SZ_W_DN;
constexpr size_t WS_W_C2 = WS_W_C1 + 4 * SZ_W_C1;
constexpr size_t WS_C1B = WS_W_C2 + 4 * SZ_W_C2;
constexpr size_t WS_HB = WS_C1B + 131072;
constexpr size_t WS_RES = WS_HB;
constexpr size_t SZ_HB = (size_t)M * D * 2;
constexpr size_t WS_R = WS_HB + SZ_HB;
constexpr size_t SZ_PROJ = (size_t)M * OD_NP * 2;
constexpr size_t WS_PROJ = WS_R;
constexpr size_t WS_R2 = WS_R + SZ_PROJ;
constexpr size_t WS_CF = WS_R2;
constexpr size_t SZ_CMPBUF = (size_t)(16 * T + 64) * 128 * 2;
constexpr size_t WS_KCMP = WS_R2, WS_VCMP = al256(WS_KCMP + SZ_CMPBUF);
constexpr int NCHUNK = NB * 8 * (T / 64);
constexpr size_t SZ_G16 = (size_t)NCHUNK * 64 * 128 * 2;
constexpr size_t WS_G_U = al256(WS_VCMP + SZ_CMPBUF), WS_G_W = WS_G_U + SZ_G16, WS_G_QG = WS_G_W + SZ_G16, WS_G_KT = WS_G_QG + SZ_G16;
constexpr size_t WS_G_ATT = WS_G_KT + SZ_G16;
constexpr size_t WS_G_GL = WS_G_ATT + (size_t)NCHUNK * 64 * 64 * 2;
constexpr size_t WS_CHID = al256(WS_G_GL + (size_t)NCHUNK * 4);
constexpr size_t WS_KC = WS_CHID + (size_t)2 * 4096 * 256 * 2;
constexpr size_t WS_NSAACC = WS_KC + (size_t)2 * 4096 * 256 * 2;
constexpr size_t WS_R_END_ODD = WS_NSAACC + (size_t)256 * 256 * 128 * 4;
constexpr size_t SZ_HALO = (size_t)(M / 256) * 2 * FF * 4;
constexpr size_t WS_ACT = WS_R, WS_TAIL = WS_ACT + (size_t)M * FF * 2, WS_HEADG = WS_TAIL + SZ_HALO, WS_HEADU = WS_HEADG + SZ_HALO, WS_R_END_FFN = WS_HEADU + SZ_HALO;
constexpr size_t WS_END = (WS_R_END_ODD > WS_R_END_FFN ? WS_R_END_ODD : WS_R_END_FFN);

constexpr int CW_BAR = 0;
constexpr int CW_QUEUE = 4096;
constexpr int CW_NORM = 8192;

typedef __bf16 bf16v2_ __attribute__((ext_vector_type(2)));
__device__ __forceinline__ unsigned cvt_pk_bf16(float lo, float hi) { const f32x2 v = {lo, hi}; const bf16v2_ r = __builtin_convertvector(v, bf16v2_); return __builtin_bit_cast(unsigned, r); }
__device__ __forceinline__ bf16_t f2bf(float f) { return (bf16_t)(cvt_pk_bf16(f, 0.f) & 0xffffu); }
__device__ __forceinline__ float bf2f(bf16_t b) { return __uint_as_float(((unsigned)b) << 16); }
__device__ __forceinline__ float bflo(unsigned w) { return __uint_as_float(w << 16); }
__device__ __forceinline__ float bfhi(unsigned w) { return __uint_as_float(w & 0xffff0000u); }
__device__ __forceinline__ int opaque_tid() { int t = threadIdx.x; asm volatile("" : "+v"(t)); return t; }
__device__ __forceinline__ int olane() { return opaque_tid() & 63; }
__device__ __forceinline__ float shx(float v, int m) { return __builtin_bit_cast(float, __builtin_amdgcn_ds_bpermute((olane() ^ m) << 2, __builtin_bit_cast(int, v))); }
__device__ __forceinline__ unsigned shx(unsigned v, int m) { return (unsigned)__builtin_amdgcn_ds_bpermute((olane() ^ m) << 2, (int)v); }
__device__ __forceinline__ float shu(float v, int d) { const int l = olane(), s = l - d; return __builtin_bit_cast(float, __builtin_amdgcn_ds_bpermute((s < 0 ? l : s) << 2, __builtin_bit_cast(int, v))); }
#define DPPF(x, ctrl) __builtin_bit_cast(float, __builtin_amdgcn_update_dpp(0, __builtin_bit_cast(int, (x)), (ctrl), 0xf, 0xf, true))
__device__ __forceinline__ float row16_sum(float x) { x += DPPF(x, 0x128); x += DPPF(x, 0x124); x += DPPF(x, 0x122); x += DPPF(x, 0x121); return x; }
__device__ __forceinline__ float row8_sum(float x) { x += DPPF(x, 0xB1); x += DPPF(x, 0x4E); x += DPPF(x, 0x141); return x; }
__device__ __forceinline__ float wave_sum(float v) { v = row16_sum(v); v += shx(v, 16); v += shx(v, 32); return v; }
__device__ __forceinline__ float sigmoidf_(float x) { return __builtin_amdgcn_rcpf(1.f + __expf(-x)); }
__device__ __forceinline__ float siluf_(float x) { return x * __builtin_amdgcn_rcpf(1.f + __expf(-x)); }

#define XB_TMO      128
#define XB_XCNT(j)  (256  + 64 * (j))
#define XB_XSUB(j)  (1280 + 64 * (j))
#define XB_XGEN(j)  (2304 + 64 * (j))
#define XB_TOP      3328
#define XB_TOPGEN   3392
#define XCD_BAR_WORDS 3456
#define XB_SPIN_CAP (1u << 24)

__device__ __forceinline__ unsigned xb_ld(unsigned* p)              { return __hip_atomic_load(p, __ATOMIC_RELAXED, __HIP_MEMORY_SCOPE_AGENT); }
__device__ __forceinline__ unsigned xb_add(unsigned* p, unsigned v) { return __hip_atomic_fetch_add(p, v, __ATOMIC_RELAXED, __HIP_MEMORY_SCOPE_AGENT); }
__device__ __forceinline__ unsigned xb_xcc_id() { return (unsigned)__builtin_amdgcn_s_getreg((3 << 11) | 20) & 0xFu; }
#define XB_SPIN(cond, bar) do { unsigned _sp = 0; while (cond) { __builtin_amdgcn_s_sleep(1); \
    if ((++_sp & 255u) == 0u) { if (xb_ld(&(bar)[XB_TMO])) break; if (_sp > XB_SPIN_CAP) { atomicAdd(&(bar)[XB_TMO], 1u); break; } } } } while (0)

struct XcdBarrier { unsigned* bar; unsigned x; volatile LAS unsigned* st; };

__device__ __forceinline__ XcdBarrier xcd_barrier_post(unsigned* bar, volatile LAS unsigned* st) {
    XcdBarrier b; b.bar = bar; b.x = xb_xcc_id(); b.st = st;
    if (threadIdx.x == 0) (void)xb_add(&bar[XB_XCNT(b.x)], 1u);
    return b;
}
__device__ __forceinline__ void xcd_barrier_complete(unsigned* bar, unsigned x, unsigned& nloc, unsigned& nx) {
    const unsigned G = gridDim.x * gridDim.y * gridDim.z;
    unsigned sum, cnt, mine, sp = 0u;
    for (;;) {
        sum = 0u; cnt = 0u; mine = 0u;
#pragma unroll
        for (unsigned j = 0; j < 16; ++j) { const unsigned c = xb_ld(&bar[XB_XCNT(j)]); sum += c; cnt += (c > 0u) ? 1u : 0u; mine = (j == x) ? c : mine; }
        if (sum == G) break;
        __builtin_amdgcn_s_sleep(1);
        if ((++sp & 255u) == 0u) { if (xb_ld(&bar[XB_TMO])) break; if (sp > XB_SPIN_CAP) { atomicAdd(&bar[XB_TMO], 1u); break; } }
    }
    nloc = mine > 0u ? mine : 1u; nx = cnt > 0u ? cnt : 1u;
}
__device__ __forceinline__ void xcd_barrier(const XcdBarrier& b) {
    asm volatile("s_waitcnt vmcnt(0)" ::: "memory");
    __syncthreads();
    if (threadIdx.x == 0) {
        unsigned* bar = b.bar;
        __builtin_amdgcn_s_waitcnt(0);
        unsigned nloc = b.st[0], nx = b.st[1];
        if (nloc == 0u) { xcd_barrier_complete(bar, b.x, nloc, nx); b.st[0] = nloc; b.st[1] = nx; }
        const unsigned old = xb_add(&bar[XB_XSUB(b.x)], 1u);
        const unsigned gen = old / nloc;
        if (old + 1u == (gen + 1u) * nloc) {
            __builtin_amdgcn_fence(__ATOMIC_RELEASE, "agent");
            asm volatile("s_waitcnt vmcnt(0)" ::: "memory");
            const unsigned og = xb_add(&bar[XB_TOP], 1u);
            const unsigned tg = og / nx;
            if (og + 1u == (tg + 1u) * nx) xb_add(&bar[XB_TOPGEN], 1u);
            else XB_SPIN(xb_ld(&bar[XB_TOPGEN]) == tg, bar);
            __builtin_amdgcn_fence(__ATOMIC_ACQUIRE, "agent");
            xb_add(&bar[XB_XGEN(b.x)], 1u);
            asm volatile("s_waitcnt vmcnt(0)" ::: "memory");
        } else {
            XB_SPIN(xb_ld(&bar[XB_XGEN(b.x)]) == gen, bar);
            __builtin_amdgcn_fence(__ATOMIC_ACQUIRE, "agent");
            asm volatile("s_waitcnt vmcnt(0)" ::: "memory");
        }
    }
    __syncthreads();
}

namespace pg8 {
constexpr int BM = 256, BK = 64, HALF = 128, HTB = HALF * BK * 2, STAGE_BYTES = 8 * HTB, NXCD = 8, WGM = 4;
__host__ __device__ __forceinline__ int lds_byte(int r, int c) { const int st = (r >> 4) * 2 + (c >> 5), rr = r & 15, cc = c & 31, ob = rr * 64 + cc * 2; return st * 1024 + (ob ^ (((ob >> 9) & 1) << 5)); }
__host__ __device__ __forceinline__ void stage_rc(int b, int& R, int& C) { const int st = b / 1024, sb = b % 1024, swz = sb ^ (((sb >> 9) & 1) << 5); R = (st >> 1) * 16 + swz / 64; C = (st & 1) * 32 + (swz % 64) / 2; }
__host__ __device__ __forceinline__ int perm32(int rho) { const int n = rho >> 4, i = rho & 15; return 8 * (i >> 2) + 4 * n + (i & 3); }

struct Unit { int pm, pn; };
struct Gemm { const bf16_t* A; const bf16_t* Bt; int M, N, K, lda; };

struct StaticOrder {
    int nM, nN, nwg, G, c;
    __host__ __device__ void init(int M_, int N_, int G_, int c_) { nM = M_ / BM; nN = N_ / BM; nwg = nM * nN; G = G_; c = c_; }
    __host__ __device__ bool next(int i, Unit& u) const {
        const long L = (long)i * G + c; if (L >= nwg) return false;
        int wgid = (int)L; { const int q = nwg / NXCD, r = nwg % NXCD, xcd = wgid % NXCD, off = wgid / NXCD; wgid = (xcd < r ? xcd * (q + 1) : r * (q + 1) + (xcd - r) * q) + off; }
        const int nig = WGM * nN, gid = wgid / nig, fm = gid * WGM, gsz = (nM - fm) < WGM ? (nM - fm) : WGM;
        u.pm = fm + ((wgid % nig) % gsz); u.pn = (wgid % nig) / gsz; return true;
    }
    __device__ __forceinline__ void a_ready(const Unit&) const {}
    __device__ __forceinline__ void done(const Unit&) const {}
};

constexpr int L_RSPF = 131072 + 4096;
__device__ __forceinline__ void rs_prefetch(const float* rs, int pm, int ui) {
    const int t = opaque_tid(), w = __builtin_amdgcn_readfirstlane(t >> 6);
    extern __shared__ __attribute__((aligned(16))) unsigned char lds_dyn_[];
    if (w < 4) __builtin_amdgcn_global_load_lds((const unsigned*)(rs + pm * BM + t), (LAS unsigned*)((LAS unsigned char*)lds_dyn_ + L_RSPF + (ui & 1) * 1024 + w * 256), 4, 0, 0);
}
__device__ __forceinline__ void rs_read(float (&r_)[2][4], int ui, int wr, int fr) {
    extern __shared__ __attribute__((aligned(16))) unsigned char lds_dyn_[];
    const LAS float* rl = (const LAS float*)((LAS unsigned char*)lds_dyn_ + L_RSPF + (ui & 1) * 1024) + wr * 64 + fr;
#pragma unroll
    for (int ai = 0; ai < 2; ++ai)
#pragma unroll
        for (int m = 0; m < 4; ++m) r_[ai][m] = rl[ai * HALF + m * 16];
}
struct EpiStoreBf16 {
    static constexpr bool PERM = true;
    bf16_t* O; int ldc; const float* rs;
    __device__ __forceinline__ void prefetch(const Unit& u, int ui) const { if (rs) rs_prefetch(rs, u.pm, ui); }
    __device__ __forceinline__ void operator()(const f32x4 (&acc)[2][2][4][2], const Unit& u, int wr, int wc, int ui, int) const {
        const int ol_ = opaque_tid() & 63, fr = ol_ & 15, fq = ol_ >> 4;
        const int row0 = u.pm * BM + wr * 64 + fr, col0 = u.pn * BM + wc * 32 + 8 * fq;
        float r_[2][4];
        if (rs) rs_read(r_, ui, wr, fr);
        else {
#pragma unroll
            for (int ai = 0; ai < 2; ++ai)
#pragma unroll
                for (int m = 0; m < 4; ++m) r_[ai][m] = 1.f;
        }
#pragma unroll
        for (int ai = 0; ai < 2; ++ai)
#pragma unroll
            for (int m = 0; m < 4; ++m) { bf16_t* rowp = O + (size_t)(row0 + ai * HALF + m * 16) * ldc + col0; const float r = r_[ai][m];
#pragma unroll
                for (int bj = 0; bj < 2; ++bj) { const f32x4 v0 = acc[ai][bj][m][0] * r, v1 = acc[ai][bj][m][1] * r;
                    u32x4 w; w.x = cvt_pk_bf16(v0[0], v0[1]); w.y = cvt_pk_bf16(v0[2], v0[3]); w.z = cvt_pk_bf16(v1[0], v1[1]); w.w = cvt_pk_bf16(v1[2], v1[3]);
                    *(u32x4*)(rowp + bj * HALF) = w; } }
    }
};
struct EpiAddRes {
    static constexpr bool PERM = true;
    bf16_t* C; int ldc;
    __device__ __forceinline__ void prefetch(const Unit&, int) const {}
    __device__ __forceinline__ void operator()(const f32x4 (&acc)[2][2][4][2], const Unit& u, int wr, int wc, int, int) const {
        const int ol_ = opaque_tid() & 63, fr = ol_ & 15, fq = ol_ >> 4;
        const int row0 = u.pm * BM + wr * 64 + fr, col0 = u.pn * BM + wc * 32 + 8 * fq;
        u32x4 cin[2][4][2];
#pragma unroll
        for (int ai = 0; ai < 2; ++ai)
#pragma unroll
            for (int m = 0; m < 4; ++m)
#pragma unroll
                for (int bj = 0; bj < 2; ++bj) cin[ai][m][bj] = *(const u32x4*)(C + (size_t)(row0 + ai * HALF + m * 16) * ldc + col0 + bj * HALF);
#pragma unroll
        for (int ai = 0; ai < 2; ++ai)
#pragma unroll
            for (int m = 0; m < 4; ++m)
#pragma unroll
                for (int bj = 0; bj < 2; ++bj) { const u32x4 c = cin[ai][m][bj]; const f32x4 v0 = acc[ai][bj][m][0], v1 = acc[ai][bj][m][1];
                    u32x4 w; w.x = cvt_pk_bf16(bflo(c.x) + v0[0], bfhi(c.x) + v0[1]); w.y = cvt_pk_bf16(bflo(c.y) + v0[2], bfhi(c.y) + v0[3]);
                    w.z = cvt_pk_bf16(bflo(c.z) + v1[0], bfhi(c.z) + v1[1]); w.w = cvt_pk_bf16(bflo(c.w) + v1[2], bfhi(c.w) + v1[3]);
                    *(u32x4*)(C + (size_t)(row0 + ai * HALF + m * 16) * ldc + col0 + bj * HALF) = w; }
    }
};
struct EpiFfnGate {
    static constexpr bool PERM = true;
    bf16_t* act; const float* cw; const float* cb; float* tail; float* headg; float* headu; LAS unsigned char* hl; const float* rs;
    __device__ __forceinline__ void prefetch(const Unit& u, int ui) const { rs_prefetch(rs, u.pm, ui); }
    __device__ __forceinline__ void operator()(f32x4 (&acc)[2][2][4][2], const Unit& u, int wr, int wc, int ui, int) const {
        const int ol_ = opaque_tid() & 63, fr = ol_ & 15, fq = ol_ >> 4;
        { float r_[2][4];
          rs_read(r_, ui, wr, fr);
#pragma unroll
          for (int ai = 0; ai < 2; ++ai)
#pragma unroll
              for (int bj = 0; bj < 2; ++bj)
#pragma unroll
                  for (int m = 0; m < 4; ++m) { acc[ai][bj][m][0] *= r_[ai][m]; acc[ai][bj][m][1] *= r_[ai][m]; } }
        const int col = u.pn * 128 + wc * 32 + 8 * fq;
        if (fr >= 14) {
#pragma unroll
            for (int ai = 0; ai < 2; ++ai) { LAS f32x4* s = (LAS f32x4*)(hl + ((((ai * 2 + wr) * 4 + wc) * 8 + fq * 2 + (fr - 14)) * 32));
                s[0] = acc[ai][1][3][0]; s[1] = acc[ai][1][3][1]; }
        }
        asm volatile("s_waitcnt lgkmcnt(0)" ::: "memory"); __builtin_amdgcn_s_barrier(); asm volatile("" ::: "memory");
        __builtin_amdgcn_s_barrier(); asm volatile("" ::: "memory");
        float w0[8], w1[8], w2[8], bb[8];
        { const f32x4 a0 = *(const f32x4*)(cw + col), a1 = *(const f32x4*)(cw + col + 4), b0 = *(const f32x4*)(cw + FF + col), b1 = *(const f32x4*)(cw + FF + col + 4),
                      c0 = *(const f32x4*)(cw + 2 * FF + col), c1 = *(const f32x4*)(cw + 2 * FF + col + 4), d0 = *(const f32x4*)(cb + col), d1 = *(const f32x4*)(cb + col + 4);
#pragma unroll
          for (int e = 0; e < 4; ++e) { w0[e] = a0[e] * -LOG2E; w0[4 + e] = a1[e] * -LOG2E; w1[e] = b0[e] * -LOG2E; w1[4 + e] = b1[e] * -LOG2E; w2[e] = c0[e] * -LOG2E; w2[4 + e] = c1[e] * -LOG2E; bb[e] = d0[e] * -LOG2E; bb[4 + e] = d1[e] * -LOG2E; } }
#pragma unroll
        for (int ai = 0; ai < 2; ++ai) {
            f32x4 hal[2] = {(f32x4){0.f, 0.f, 0.f, 0.f}, (f32x4){0.f, 0.f, 0.f, 0.f}};
            if (!(ai == 0 && wr == 0) && fr >= 14) {
                const int sai = (wr == 1) ? ai : 0, swr = (wr == 1) ? 0 : 1;
                const LAS f32x4* s = (const LAS f32x4*)(hl + ((((sai * 2 + swr) * 4 + wc) * 8 + fq * 2 + (fr - 14)) * 32));
                hal[0] = s[0]; hal[1] = s[1];
            }
#pragma unroll
            for (int m = 0; m < 4; ++m) {
                const int row = u.pm * BM + ai * HALF + wr * 64 + m * 16 + fr;
                float o[8];
#pragma unroll
                for (int n = 0; n < 2; ++n)
#pragma unroll
                    for (int e = 0; e < 4; ++e) {
                        const float gc = acc[ai][1][m][n][e], gp = (m == 0) ? hal[n][e] : acc[ai][1][m - 1][n][e], uv = acc[ai][0][m][n][e];
                        const int gci = __builtin_bit_cast(int, gc), gpi = __builtin_bit_cast(int, gp);
                        const int r1 = __builtin_amdgcn_update_dpp(0, gpi, 0x121, 0xf, 0xf, true), r2 = __builtin_amdgcn_update_dpp(0, gpi, 0x122, 0xf, 0xf, true);
                        const float g1 = __builtin_bit_cast(float, __builtin_amdgcn_update_dpp(r1, gci, 0x111, 0xf, 0xf, false));
                        const float g2 = __builtin_bit_cast(float, __builtin_amdgcn_update_dpp(r2, gci, 0x112, 0xf, 0xf, false));
                        const int k = n * 4 + e;
                        const float z = w0[k] * g2 + w1[k] * g1 + w2[k] * gc + bb[k];
                        o[k] = z * __builtin_amdgcn_rcpf(1.f + __builtin_amdgcn_exp2f(z)) * uv;
                    }
                u32x4 w; w.x = cvt_pk_bf16(o[0], o[1]); w.y = cvt_pk_bf16(o[2], o[3]); w.z = cvt_pk_bf16(o[4], o[5]); w.w = cvt_pk_bf16(o[6], o[7]);
                *(u32x4*)(act + (size_t)row * FF + col) = w;
            }
        }
        if (wr == 1 && fr >= 14) { float* t = tail + ((size_t)u.pm * 2 + (fr - 14)) * FF + col; *(f32x4*)t = acc[1][1][3][0]; *(f32x4*)(t + 4) = acc[1][1][3][1]; }
        if (wr == 0 && fr < 2) { float* hg = headg + ((size_t)u.pm * 2 + fr) * FF + col; *(f32x4*)hg = acc[0][1][0][0]; *(f32x4*)(hg + 4) = acc[0][1][0][1];
                                 float* hu = headu + ((size_t)u.pm * 2 + fr) * FF + col; *(f32x4*)hu = acc[0][0][0][0]; *(f32x4*)(hu + 4) = acc[0][0][0][1]; }
    }
};

template <class Epi, class Sched>
__device__ __forceinline__ void gemm_phase(LAS unsigned char* lds, const Gemm g, const Sched& S, const Epi& E) {
    const int tid = opaque_tid(), wid = __builtin_amdgcn_readfirstlane(tid >> 6), lane = tid & 63, wr = wid >> 2, wc = wid & 3, fr = lane & 15, fq = lane >> 4;
    const int K = g.K, nt = K / BK, lda = g.lda;
    unsigned voffA[2], voffB[2];
#pragma unroll
    for (int i = 0; i < 2; ++i) { int R, C; stage_rc(tid * 16 + i * 8192, R, C); const int Rb = Epi::PERM ? ((R & ~31) + perm32(R & 31)) : R;
        voffA[i] = (unsigned)(R * lda + C) * 2u; voffB[i] = (unsigned)(Rb * K + C) * 2u; }
    const size_t kstep = (size_t)(BK * 2);
    const size_t hstepA = (size_t)HALF * lda * 2, hstepB = (size_t)HALF * K * 2;
    const size_t tstepA = 2 * hstepA, tstepB = 2 * hstepB;
    const unsigned ldsw = (unsigned)wid * 1024u;
    const int aoff = lds_byte(wr * 64 + fr, fq * 8), boff = lds_byte(wc * 32 + fr, fq * 8);
#define PG8_SA(b, h) (((b) * 2 + (h)) * HTB)
#define PG8_SB(b, h) ((4 + (b) * 2 + (h)) * HTB)
#define PG8_STAGE(bufoff, gbase, voff) do { _Pragma("unroll") for (int _i = 0; _i < 2; ++_i) \
        __builtin_amdgcn_global_load_lds((const unsigned*)((const char*)(gbase) + (voff)[_i]), (LAS unsigned*)(lds + (bufoff) + ldsw + _i * 8192), 16, 0, 0); } while (0)
#define PG8_LDA(dst, b, h) do { _Pragma("unroll") for (int m = 0; m < 4; ++m) _Pragma("unroll") for (int k = 0; k < 2; ++k) dst[m][k] = *(const LAS bf16x8*)(lds + PG8_SA(b, h) + aoff + m * 2048 + k * 1024); } while (0)
#define PG8_LDB(dst, b, h) do { _Pragma("unroll") for (int n = 0; n < 2; ++n) _Pragma("unroll") for (int k = 0; k < 2; ++k) dst[n][k] = *(const LAS bf16x8*)(lds + PG8_SB(b, h) + boff + n * 2048 + k * 1024); } while (0)
#define PG8_MMA(ai, bj, At, Bt) do { __builtin_amdgcn_s_setprio(1); _Pragma("unroll") for (int m = 0; m < 4; ++m) _Pragma("unroll") for (int n = 0; n < 2; ++n) _Pragma("unroll") for (int k = 0; k < 2; ++k) \
        acc[ai][bj][m][n] = __builtin_amdgcn_mfma_f32_16x16x32_bf16(Bt[n][k], At[m][k], acc[ai][bj][m][n], 0, 0, 0); __builtin_amdgcn_s_setprio(0); } while (0)
#define PG8_WAIT_V(n) asm volatile("s_waitcnt vmcnt(" #n ")" ::: "memory")
#define PG8_WAIT_L(n) asm volatile("s_waitcnt lgkmcnt(" #n ")" ::: "memory")
#define PG8_BAR __builtin_amdgcn_s_barrier()
#define PG8_SCHED __builtin_amdgcn_sched_barrier(0)
    Unit cur, nxt; int ui = 0;
    if (!S.next(0, cur)) return;
    f32x4 acc[2][2][4][2];
#pragma unroll
    for (int a = 0; a < 2; ++a)
#pragma unroll
        for (int b = 0; b < 2; ++b)
#pragma unroll
            for (int m = 0; m < 4; ++m)
#pragma unroll
                for (int n = 0; n < 2; ++n) acc[a][b][m][n] = (f32x4){0.f, 0.f, 0.f, 0.f};
    bf16x8 At[4][2], B0[2][2], B1[2][2];
    const char* cA = (const char*)g.A + (size_t)cur.pm * tstepA; const char* cB = (const char*)g.Bt + (size_t)cur.pn * tstepB;
    S.a_ready(cur);
    PG8_STAGE(PG8_SB(0, 0), cB, voffB); PG8_STAGE(PG8_SA(0, 0), cA, voffA); PG8_STAGE(PG8_SB(0, 1), cB + hstepB, voffB); PG8_STAGE(PG8_SA(0, 1), cA + hstepA, voffA);
    if (wr == 1) PG8_BAR;
    PG8_WAIT_V(4); PG8_BAR;
    PG8_STAGE(PG8_SB(1, 0), cB + kstep, voffB); PG8_STAGE(PG8_SA(1, 0), cA + kstep, voffA); PG8_STAGE(PG8_SB(1, 1), cB + hstepB + kstep, voffB);
    PG8_WAIT_V(6); PG8_BAR;
    for (;;) {
        E.prefetch(cur, ui);
        const bool has_next = S.next(ui + 1, nxt);
        const char* nA = has_next ? (const char*)g.A + (size_t)nxt.pm * tstepA : cA; const char* nB = has_next ? (const char*)g.Bt + (size_t)nxt.pn * tstepB : cB;
        for (int t = 0; t < nt; t += 2) {
            const bool last = (t == nt - 2);
            const char* a1 = cA + (size_t)(t + 1) * kstep;
            const char* a2 = last ? nA : cA + (size_t)(t + 2) * kstep; const char* b2 = last ? nB : cB + (size_t)(t + 2) * kstep;
            const char* a3 = a2 + kstep; const char* b3 = b2 + kstep;
            if (last && has_next) S.a_ready(nxt);
            PG8_LDB(B0, 0, 0); PG8_SCHED; PG8_LDA(At, 0, 0); PG8_STAGE(PG8_SA(1, 1), a1 + hstepA, voffA);
            PG8_WAIT_L(8); PG8_BAR; PG8_WAIT_L(0); PG8_MMA(0, 0, At, B0); PG8_BAR; PG8_SCHED;
            PG8_LDB(B1, 0, 1); PG8_STAGE(PG8_SB(0, 0), b2, voffB);
            PG8_BAR; PG8_WAIT_L(0); PG8_MMA(0, 1, At, B1); PG8_BAR;
            PG8_LDA(At, 0, 1); PG8_STAGE(PG8_SA(0, 0), a2, voffA);
            PG8_BAR; PG8_WAIT_L(0); PG8_MMA(1, 0, At, B0); PG8_BAR; PG8_SCHED;
            PG8_STAGE(PG8_SB(0, 1), b2 + hstepB, voffB);
            PG8_WAIT_V(6); PG8_BAR; PG8_MMA(1, 1, At, B1); PG8_BAR;
            PG8_LDB(B0, 1, 0); PG8_SCHED; PG8_LDA(At, 1, 0); PG8_STAGE(PG8_SA(0, 1), a2 + hstepA, voffA);
            PG8_WAIT_L(8); PG8_BAR; PG8_WAIT_L(0); PG8_MMA(0, 0, At, B0); PG8_BAR; PG8_SCHED;
            PG8_LDB(B1, 1, 1); PG8_STAGE(PG8_SB(1, 0), b3, voffB);
            PG8_BAR; PG8_WAIT_L(0); PG8_MMA(0, 1, At, B1); PG8_BAR;
            PG8_LDA(At, 1, 1); PG8_STAGE(PG8_SA(1, 0), a3, voffA);
            PG8_BAR; PG8_WAIT_L(0); PG8_MMA(1, 0, At, B0); PG8_BAR; PG8_SCHED;
            PG8_STAGE(PG8_SB(1, 1), b3 + hstepB, voffB);
            PG8_WAIT_V(6); PG8_BAR; PG8_MMA(1, 1, At, B1); PG8_BAR;
        }
        E(acc, cur, wr, wc, ui, fq);
        S.done(cur);
        if (!has_next) break;
#pragma unroll
        for (int a = 0; a < 2; ++a)
#pragma unroll
            for (int b = 0; b < 2; ++b)
#pragma unroll
                for (int m = 0; m < 4; ++m)
#pragma unroll
                    for (int n = 0; n < 2; ++n) acc[a][b][m][n] = (f32x4){0.f, 0.f, 0.f, 0.f};
        cur = nxt; cA = nA; cB = nB; ++ui;
    }
    PG8_WAIT_V(0);
    if (wr == 0) PG8_BAR;
    PG8_BAR;
#undef PG8_SA
#undef PG8_SB
#undef PG8_STAGE
#undef PG8_LDA
#undef PG8_LDB
#undef PG8_MMA
#undef PG8_WAIT_V
#undef PG8_WAIT_L
#undef PG8_BAR
#undef PG8_SCHED
}
}
struct Frame {
    LAS unsigned char* lds; int G, bid;
    const float* const* in; float* out; unsigned char* ws; unsigned* ctl;
};
#define TID (opaque_tid())
#define LANE (opaque_tid() & 63)
#define WAVE (__builtin_amdgcn_readfirstlane(opaque_tid() >> 6))
enum { I_X = 0, I_RELB, I_NMIX, I_NFFN, I_NFIN, I_EV_WIN, I_EV_BF, I_EV_SINK, I_EV_WOUT, I_OD_WIN, I_OD_CPOS, I_OD_CW1, I_OD_CW2, I_OD_CONVW, I_OD_ALOG, I_OD_DTB,
       I_OD_GNORM, I_OD_WOUT, I_F_WUP, I_F_CONVW, I_F_CONVB, I_F_WDN };

template <int MAP>
__device__ __forceinline__ int cvt_map(int n, int srcN) {
    if (MAP == 0) return (n < srcN) ? n : -1;
    if (MAP == 1) return ev_src(n);
    if (MAP == 2) return od_src(n);
    return ((n & 255) < 128) ? (n >> 8) * 128 + (n & 127) : FF + (n >> 8) * 128 + (n & 127);
}
template <int MAP>
__device__ __forceinline__ void cvt_load(f32x4 (&v)[8], const float* __restrict__ src, int srcN, const float* __restrict__ gain, int k0, int n0, int tid) {
    const int n4 = (tid & 31) * 4, s = cvt_map<MAP>(n0 + n4, srcN);
    const int sc = s >= 0 ? s : 0;
    const float keep = (MAP == 3) ? ((((n0 + n4) & 255) < 128) ? -0.6931471805599453f : 1.f) : (s >= 0 ? 1.f : 0.f);
    float gv[8];
#pragma unroll
    for (int e = 0; e < 8; ++e) { const int kk = e * 16 + (tid >> 5);
        v[e] = *(const f32x4*)(src + (size_t)(k0 + kk) * srcN + sc);
        gv[e] = gain ? gain[k0 + kk] : 1.f; }
#pragma unroll
    for (int e = 0; e < 8; ++e) v[e] *= gv[e] * keep;
}
template <int MAP>
__device__ __forceinline__ void cvt_transpose(const Frame& F, const float* __restrict__ src, int srcN, int K, int Npad, const float* __restrict__ gain, bf16_t* __restrict__ dst) {
    LAS float* tile = (LAS float*)F.lds;
    const int tid = TID, tk = K / 128, tn = Npad / 128, ntile = tk * tn;
    int t = F.bid;
    f32x4 v[8];
    if (t < ntile) cvt_load<MAP>(v, src, srcN, gain, (t % tk) * 128, (t / tk) * 128, tid);
    for (; t < ntile; t += F.G) {
        const int k0 = (t % tk) * 128, n0 = (t / tk) * 128;
        __syncthreads();
#pragma unroll
        for (int e = 0; e < 8; ++e) *(LAS f32x4*)(tile + (e * 16 + (tid >> 5)) * 132 + (tid & 31) * 4) = v[e];
        __syncthreads();
        const int tnx = t + F.G;
        if (tnx < ntile) cvt_load<MAP>(v, src, srcN, gain, (tnx % tk) * 128, (tnx / tk) * 128, tid);
        { const int nn = tid & 127, kq = (tid >> 7) * 32;
          bf16_t* d = dst + (size_t)(n0 + nn) * K + k0 + kq;
#pragma unroll
          for (int q = 0; q < 4; ++q) { float x[8];
#pragma unroll
              for (int i = 0; i < 8; ++i) x[i] = tile[(kq + q * 8 + i) * 132 + nn];
              u32x4 w; w.x = cvt_pk_bf16(x[0], x[1]); w.y = cvt_pk_bf16(x[2], x[3]); w.z = cvt_pk_bf16(x[4], x[5]); w.w = cvt_pk_bf16(x[6], x[7]);
              *(u32x4*)(d + q * 8) = w; } }
    }
    __syncthreads();
}

__device__ __forceinline__ void rownorm_phase(const Frame& F, const float* __restrict__ src, bf16_t* __restrict__ cpy, float* __restrict__ rstd_out) {
    for (int row = F.bid * NWAVE + WAVE; row < M; row += F.G * NWAVE) {
        const float* p = src + (size_t)row * D + LANE * 4;
        f32x4 v[8]; float ss = 0.f;
        u32x2 c[8];
#pragma unroll
        for (int i = 0; i < 8; ++i) { v[i] = *(const f32x4*)(p + i * 256); c[i].x = cvt_pk_bf16(v[i][0], v[i][1]); c[i].y = cvt_pk_bf16(v[i][2], v[i][3]);
            ss += bflo(c[i].x) * bflo(c[i].x) + bfhi(c[i].x) * bfhi(c[i].x) + bflo(c[i].y) * bflo(c[i].y) + bfhi(c[i].y) * bfhi(c[i].y); }
        ss = wave_sum(ss);
        if (LANE == 0) rstd_out[row] = rsqrtf(ss * (1.f / D) + EPS);
#pragma unroll
        for (int i = 0; i < 8; ++i) *(u32x2*)(cpy + (size_t)row * D + LANE * 4 + i * 256) = c[i];
    }
}
__device__ __forceinline__ void rowstat_phase(const Frame& F, const bf16_t* __restrict__ res, float* __restrict__ rstd_out) {
    for (int row0 = (F.bid * NWAVE + WAVE) * 4; row0 < M; row0 += F.G * NWAVE * 4) {
        u32x4 v[4][4];
#pragma unroll
        for (int r = 0; r < 4; ++r)
#pragma unroll
            for (int i = 0; i < 4; ++i) v[r][i] = *(const u32x4*)(res + (size_t)(row0 + r) * D + LANE * 8 + i * 512);
        float ss[4];
#pragma unroll
        for (int r = 0; r < 4; ++r) { ss[r] = 0.f;
#pragma unroll
            for (int i = 0; i < 4; ++i) { const u32x4 x = v[r][i];
                ss[r] += bflo(x.x) * bflo(x.x) + bfhi(x.x) * bfhi(x.x) + bflo(x.y) * bflo(x.y) + bfhi(x.y) * bfhi(x.y) + bflo(x.z) * bflo(x.z) + bfhi(x.z) * bfhi(x.z) + bflo(x.w) * bflo(x.w) + bfhi(x.w) * bfhi(x.w); }
            ss[r] = wave_sum(ss[r]); }
        if (LANE < 4) rstd_out[row0 + LANE] = rsqrtf((LANE == 0 ? ss[0] : LANE == 1 ? ss[1] : LANE == 2 ? ss[2] : ss[3]) * (1.f / D) + EPS);
    }
}
__device__ __forceinline__ void rowstat_f_phase(const Frame& F, const bf16_t* __restrict__ res, float* __restrict__ rstd_out, const bf16_t* __restrict__ wf  , bf16_t* __restrict__ proj) {
    LAS unsigned char* lds = F.lds;
    __syncthreads();
    for (int i = TID; i < 8 * D / 8; i += NTHR) *(LAS u32x4*)(lds + i * 16) = *(const u32x4*)(wf + (size_t)i * 8);
    __syncthreads();
    const int l = LANE, r = l & 15, kq = l >> 4;
    for (int blk = F.bid * NWAVE + WAVE; blk < M / 16; blk += F.G * NWAVE) {
        const bf16_t* rowp = res + (size_t)(blk * 16 + r) * D + kq * 8;
        f32x4 acc = {0.f, 0.f, 0.f, 0.f}; float ss = 0.f;
#pragma unroll 1
        for (int s0 = 0; s0 < 64; s0 += 32) {
            u32x4 a[32];
#pragma unroll
            for (int s = 0; s < 32; ++s) a[s] = *(const u32x4*)(rowp + (s0 + s) * 32);
#pragma unroll
            for (int s = 0; s < 32; ++s) { const u32x4 x = a[s];
                ss += bflo(x.x) * bflo(x.x) + bfhi(x.x) * bfhi(x.x) + bflo(x.y) * bflo(x.y) + bfhi(x.y) * bfhi(x.y) + bflo(x.z) * bflo(x.z) + bfhi(x.z) * bfhi(x.z) + bflo(x.w) * bflo(x.w) + bfhi(x.w) * bfhi(x.w);
                u32x4 b = *(const LAS u32x4*)(lds + (r & 7) * 4096 + ((s0 + s) * 32 + kq * 8) * 2);
                if (r >= 8) b = (u32x4){0u, 0u, 0u, 0u};
                u32x4 xa = x;
                acc = __builtin_amdgcn_mfma_f32_16x16x32_bf16(*reinterpret_cast<bf16x8*>(&xa), *reinterpret_cast<bf16x8*>(&b), acc, 0, 0, 0); }
        }
        ss += shx(ss, 16); ss += shx(ss, 32);
        const float rstd = rsqrtf(ss * (1.f / D) + EPS);
        if (kq == 0) rstd_out[blk * 16 + r] = rstd;
#pragma unroll
        for (int reg = 0; reg < 4; ++reg) { const float rr = __builtin_bit_cast(float, __builtin_amdgcn_ds_bpermute((4 * kq + reg) << 2, __builtin_bit_cast(int, rstd)));
            if (r < 8) proj[(size_t)(blk * 16 + 4 * kq + reg) * EV_NP + EC_F + r] = f2bf(acc[reg] * rr); }
    }
    __syncthreads();
}
__device__ __forceinline__ void final_norm_phase(const Frame& F, const bf16_t* __restrict__ res, float* __restrict__ out, const float* __restrict__ g) {
    for (int row0 = (F.bid * NWAVE + WAVE) * 2; row0 < M; row0 += F.G * NWAVE * 2) {
        u32x4 v[2][4];
#pragma unroll
        for (int r = 0; r < 2; ++r)
#pragma unroll
            for (int i = 0; i < 4; ++i) v[r][i] = *(const u32x4*)(res + (size_t)(row0 + r) * D + LANE * 8 + i * 512);
#pragma unroll
        for (int r = 0; r < 2; ++r) {
            float ss = 0.f;
#pragma unroll
            for (int i = 0; i < 4; ++i) { const u32x4 x = v[r][i];
                ss += bflo(x.x) * bflo(x.x) + bfhi(x.x) * bfhi(x.x) + bflo(x.y) * bflo(x.y) + bfhi(x.y) * bfhi(x.y) + bflo(x.z) * bflo(x.z) + bfhi(x.z) * bfhi(x.z) + bflo(x.w) * bflo(x.w) + bfhi(x.w) * bfhi(x.w); }
            ss = wave_sum(ss);
            const float rstd = rsqrtf(ss * (1.f / D) + EPS);
#pragma unroll
            for (int i = 0; i < 4; ++i) { const u32x4 x = v[r][i];
                const f32x4 g0 = *(const f32x4*)(g + LANE * 8 + i * 512), g1 = *(const f32x4*)(g + LANE * 8 + i * 512 + 4);
                float* o = out + (size_t)(row0 + r) * D + LANE * 8 + i * 512;
                *(f32x4*)o = (f32x4){bflo(x.x), bfhi(x.x), bflo(x.y), bfhi(x.y)} * rstd * g0;
                *(f32x4*)(o + 4) = (f32x4){bflo(x.z), bfhi(x.z), bflo(x.w), bfhi(x.w)} * rstd * g1; }
        }
    }
}

__device__ __forceinline__ void ffn_fixup_phase(const Frame& F, bf16_t* __restrict__ act, const float* __restrict__ tail, const float* __restrict__ headg, const float* __restrict__ headu,
                                                const float* __restrict__ cw, const float* __restrict__ cb) {
    constexpr int C4 = FF / 4, NPM = M / 256;
    for (int idx = F.bid * NTHR + TID; idx < NPM * 2 * C4; idx += F.G * NTHR) {
        const int c = (idx % C4) * 4, r = (idx / C4) & 1, pm = idx / (2 * C4);
        if ((pm & 15) == 0) continue;
        const f32x4 t0 = *(const f32x4*)(tail + ((size_t)(pm - 1) * 2 + 0) * FF + c), t1 = *(const f32x4*)(tail + ((size_t)(pm - 1) * 2 + 1) * FF + c);
        const f32x4 h0 = *(const f32x4*)(headg + ((size_t)pm * 2 + 0) * FF + c), h1 = *(const f32x4*)(headg + ((size_t)pm * 2 + 1) * FF + c);
        const f32x4 uu = *(const f32x4*)(headu + ((size_t)pm * 2 + r) * FF + c);
        const f32x4 gm2 = r == 0 ? t0 : t1, gm1 = r == 0 ? t1 : h0, g0 = r == 0 ? h0 : h1;
        const f32x4 w0 = *(const f32x4*)(cw + c), w1 = *(const f32x4*)(cw + FF + c), w2 = *(const f32x4*)(cw + 2 * FF + c), bb = *(const f32x4*)(cb + c);
        float o[4];
#pragma unroll
        for (int e = 0; e < 4; ++e) { const float z = w0[e] * gm2[e] + w1[e] * gm1[e] + w2[e] * g0[e] + bb[e]; o[e] = siluf_(z) * (uu[e] * -LOG2E); }
        u32x2 w; w.x = cvt_pk_bf16(o[0], o[1]); w.y = cvt_pk_bf16(o[2], o[3]);
        *(u32x2*)(act + (size_t)(pm * 256 + r) * FF + c) = w;
    }
}

__device__ __forceinline__ void p0_prologue(const Frame& F) {
    unsigned char* ws = F.ws;
    for (int j = 0; j < 2; ++j) {
        cvt_transpose<1>(F, F.in[I_EV_WIN] + (size_t)j * D * EV_N, EV_N, D, EV_NP, F.in[I_NMIX] + (size_t)(2 * j) * D, (bf16_t*)(ws + WS_W_EV_IN + j * SZ_W_EV_IN));
        cvt_transpose<0>(F, F.in[I_EV_WOUT] + (size_t)j * D * D, D, D, D, nullptr, (bf16_t*)(ws + WS_W_EV_OUT + j * SZ_W_OUT));
        cvt_transpose<2>(F, F.in[I_OD_WIN] + (size_t)j * D * OD_N, OD_N, D, OD_NP, F.in[I_NMIX] + (size_t)(2 * j + 1) * D, (bf16_t*)(ws + WS_W_OD_IN + j * SZ_W_OD_IN));
        cvt_transpose<0>(F, F.in[I_OD_WOUT] + (size_t)j * D * D, D, D, D, nullptr, (bf16_t*)(ws + WS_W_OD_OUT + j * SZ_W_OUT));
        for (int kv = 0; kv < 2; ++kv) {
            cvt_transpose<0>(F, F.in[I_OD_CW1] + (size_t)(j * 2 + kv) * 4096 * 256, 256, 4096, 256, nullptr, (bf16_t*)(ws + WS_W_C1 + (j * 2 + kv) * SZ_W_C1));
            cvt_transpose<0>(F, F.in[I_OD_CW2] + (size_t)(j * 2 + kv) * 256 * 128, 128, 256, 256, nullptr, (bf16_t*)(ws + WS_W_C2 + (j * 2 + kv) * SZ_W_C2));
        }
    }
    for (int l = 0; l < 4; ++l) {
        cvt_transpose<3>(F, F.in[I_F_WUP] + (size_t)l * D * FF2, FF2, D, FF2, F.in[I_NFFN] + (size_t)l * D, (bf16_t*)(ws + WS_W_UP + l * SZ_W_UP));
        cvt_transpose<0>(F, F.in[I_F_WDN] + (size_t)l * FF * D, D, FF, D, nullptr, (bf16_t*)(ws + WS_W_DN + l * SZ_W_DN));
    }
    if (F.bid < 64) {
        const int tid = TID, jk = F.bid >> 4, part = (F.bid & 15) * 2 + (tid >> 8), n = tid & 255;
        const float* pe = F.in[I_OD_CPOS] + (size_t)jk * 4096 + part * 128; const float* w1 = F.in[I_OD_CW1] + ((size_t)jk * 4096 + part * 128) * 256 + n;
        float s = 0.f;
        for (int i0 = 0; i0 < 128; i0 += 16) {
            float a[16], b[16];
#pragma unroll
            for (int u = 0; u < 16; ++u) { a[u] = pe[i0 + u]; b[u] = w1[(size_t)(i0 + u) * 256]; }
#pragma unroll
            for (int u = 0; u < 16; ++u) s += a[u] * b[u];
        }
        ((float*)(ws + WS_C1B))[(jk * 32 + part) * 256 + n] = s;
    }
    rownorm_phase(F, F.in[I_X], (bf16_t*)(ws + WS_RES), F.out + (size_t)M * D / 2);
}
namespace att {
constexpr int KVBLK = 64, SHM_K = KVBLK * 128 * 2, SHM_V = KVBLK * 128 * 2;
constexpr int KVBUF = SHM_V + SHM_K;
constexpr int L_V = 0, L_K = SHM_V;
constexpr int EL_WS = 4 * KVBUF, EL_CFR = EL_WS + 2048, EL_TAB = EL_CFR + 8192  , EL_MISC = EL_TAB + 4096, EL_END = EL_MISC + 256;
static_assert(EL_END <= LDS_BARW, "even attention lds");
#define KSWZ_F(row) (((row) & 7) | ((((row) >> 4) & 1) << 3))
#define KSWZ(row, colB) ((row) * 256 + ((colB) ^ (KSWZ_F(row) << 4)))
#define SBAR() __builtin_amdgcn_sched_barrier(0)
__device__ __forceinline__ int v_st(int k, int c) { const int kk = (k & ~0xC) | ((k & 4) << 1) | ((k & 8) >> 1); return ((kk >> 3) * 4 + (c >> 5)) * 512 + ((kk & 7) * 32 + (c & 31)) * 2; }
__device__ __forceinline__ int v_rd_base(int lane) { return ((lane & 3) << 3) | (((lane >> 2) & 3) << 6) | (((lane >> 4) & 1) << 5) | (((lane >> 5) & 1) << 8); }
constexpr int v_rd_off(int d0, int ks, int half) { return d0 * 512 + ks * 4096 + half * 2048; }
__device__ __forceinline__ int crow(int r, int hi) { return (r & 3) + 8 * (r >> 2) + 4 * hi; }
constexpr float C2 = LOG2E * SCALE;

struct KvOff { unsigned k, v; };
__device__ __forceinline__ KvOff kv_dma_off(int tid, int ld) {
    const int row = tid >> 4, cch = (tid & 15) ^ KSWZ_F(row);
    const int kk = ((tid >> 7) << 3) | ((tid >> 2) & 7), key = (kk & ~0xC) | ((kk & 4) << 1) | ((kk & 8) >> 1), col = ((tid >> 5) & 3) * 32 + (tid & 3) * 8;
    KvOff o; o.k = (unsigned)(row * ld + cch * 8) * 2u; o.v = (unsigned)(key * ld + col) * 2u; return o;
}
__device__ __forceinline__ void kv_dma(LAS unsigned char* buf, const bf16_t* __restrict__ Kg, const bf16_t* __restrict__ Vg, int ld, KvOff o, int wid) {
    const char* k0 = (const char*)Kg; const char* k1 = (const char*)(Kg + (size_t)32 * ld);
    const char* v0 = (const char*)Vg; const char* v1 = (const char*)(Vg + (size_t)32 * ld);
    LAS unsigned char* l = buf + wid * 1024;
    __builtin_amdgcn_global_load_lds((const unsigned*)(k0 + o.k), (LAS unsigned*)(l + L_K), 16, 0, 0);
    __builtin_amdgcn_global_load_lds((const unsigned*)(k1 + o.k), (LAS unsigned*)(l + L_K + 8192), 16, 0, 0);
    __builtin_amdgcn_global_load_lds((const unsigned*)(v0 + o.v), (LAS unsigned*)(l + L_V), 16, 0, 0);
    __builtin_amdgcn_global_load_lds((const unsigned*)(v1 + o.v), (LAS unsigned*)(l + L_V + 8192), 16, 0, 0);
}
template <int NI> __device__ __forceinline__ void dma_wait(int ahead) {
    if (ahead >= 2) { if (NI == 4) asm volatile("s_waitcnt vmcnt(8)" ::: "memory"); else asm volatile("s_waitcnt vmcnt(10)" ::: "memory"); }
    else if (ahead == 1) { if (NI == 4) asm volatile("s_waitcnt vmcnt(4)" ::: "memory"); else asm volatile("s_waitcnt vmcnt(5)" ::: "memory"); }
    else asm volatile("s_waitcnt vmcnt(0)" ::: "memory");
}
#define RING_BAR() do { asm volatile("s_waitcnt lgkmcnt(0)" ::: "memory"); __builtin_amdgcn_s_barrier(); asm volatile("" ::: "memory"); } while (0)
template <int NSET = 4>
__device__ __forceinline__ void qkt(f32x16& p0, f32x16& p1, LAS unsigned char* lds, int r32, int hi, const bf16x8* qr) {
    p0 = f32x16{}; p1 = f32x16{};
    int ad[4];
#pragma unroll
    for (int dd = 0; dd < 4; ++dd) ad[dd] = (int)(uintptr_t)(lds + L_K + KSWZ(r32, (dd * 16 + hi * 8) * 2));
    bf16x8 k0[NSET], k1[NSET];
#define KRD(dst, a_, off_) asm volatile("ds_read_b128 %0, %1 offset:%2" : "=&v"(dst) : "v"(a_), "i"(off_) : "memory")
#define KWAIT(n_, x_, y_) asm volatile("s_waitcnt lgkmcnt(" #n_ ")" : "+v"(x_), "+v"(y_) :: "memory")
#define KISSUE(d_) do { if ((d_) < 4) { KRD(k0[(d_) % NSET], ad[(d_) & 3], 0); KRD(k1[(d_) % NSET], ad[(d_) & 3], 32 * 256); } \
                        else { const int a2_ = ad[(d_) & 3] ^ 128;         \
                               KRD(k0[(d_) % NSET], a2_, 0); KRD(k1[(d_) % NSET], a2_, 32 * 256); } } while (0)
#pragma unroll
    for (int d0 = 0; d0 < NSET; ++d0) KISSUE(d0);
#define KWAITN(n_, x_, y_) do { if ((n_) == 6) KWAIT(6, x_, y_); else if ((n_) == 4) KWAIT(4, x_, y_); else if ((n_) == 2) KWAIT(2, x_, y_); else KWAIT(0, x_, y_); } while (0)
#define QK_STEP(d0_) do { constexpr int inflight_ = ((8 - (d0_)) < NSET ? (8 - (d0_)) : NSET) - 1; KWAITN(2 * inflight_, k0[(d0_) % NSET], k1[(d0_) % NSET]); \
        p0 = __builtin_amdgcn_mfma_f32_32x32x16_bf16(k0[(d0_) % NSET], qr[d0_], p0, 0, 0, 0); p1 = __builtin_amdgcn_mfma_f32_32x32x16_bf16(k1[(d0_) % NSET], qr[d0_], p1, 0, 0, 0); \
        if ((d0_) + NSET < 8) KISSUE((d0_) + NSET); } while (0)
    QK_STEP(0); QK_STEP(1); QK_STEP(2); QK_STEP(3); QK_STEP(4); QK_STEP(5); QK_STEP(6); QK_STEP(7);
#undef KWAITN
#undef QK_STEP
#undef KISSUE
#undef KWAIT
#undef KRD
}
__device__ __forceinline__ void partialSM(f32x16& p0, f32x16& p1, float& m_reg, float& mn, float& alpha) {
    float mx[4] = {p0[0], p0[1], p0[2], p0[3]};
#pragma unroll
    for (int r = 4; r < 16; ++r) mx[r & 3] = fmaxf(mx[r & 3], p0[r]);
#pragma unroll
    for (int r = 0; r < 16; ++r) mx[r & 3] = fmaxf(mx[r & 3], p1[r]);
    float pmax = fmaxf(fmaxf(mx[0], mx[1]), fmaxf(mx[2], mx[3]));
    { auto rr = __builtin_amdgcn_permlane32_swap(__float_as_uint(pmax), __float_as_uint(pmax), false, false);
      pmax = fmaxf(__uint_as_float(rr[0]), __uint_as_float(rr[1])); }
    if (__any((pmax - m_reg) * C2 > 8.f)) { mn = fmaxf(m_reg, pmax); alpha = __builtin_amdgcn_exp2f((m_reg - mn) * C2); m_reg = mn; }
    else { mn = m_reg; alpha = 1.f; }
    const float mnL = -mn * C2;
#pragma unroll
    for (int r = 0; r < 16; ++r) p0[r] = __builtin_amdgcn_exp2f(fmaf(p0[r], C2, mnL));
#pragma unroll
    for (int r = 0; r < 16; ++r) p1[r] = __builtin_amdgcn_exp2f(fmaf(p1[r], C2, mnL));
}
__device__ __forceinline__ void pack_p(const f32x16& p0, const f32x16& p1, bf16x8& pa0, bf16x8& pa1, bf16x8& pa2, bf16x8& pa3) {
#define PK4(P, B_, OUT) do { unsigned a0 = cvt_pk_bf16(P[B_+0], P[B_+1]), a1 = cvt_pk_bf16(P[B_+2], P[B_+3]);                          \
        unsigned b0 = cvt_pk_bf16(P[B_+4], P[B_+5]), b1 = cvt_pk_bf16(P[B_+6], P[B_+7]);                                             \
        auto r0 = __builtin_amdgcn_permlane32_swap(a0, b0, false, false); auto r1 = __builtin_amdgcn_permlane32_swap(a1, b1, false, false); \
        u32x4 w = {r0[0], r1[0], r0[1], r1[1]}; OUT = *reinterpret_cast<bf16x8*>(&w); } while (0)
    PK4(p0, 0, pa0); PK4(p0, 8, pa1); PK4(p1, 0, pa2); PK4(p1, 8, pa3);
#undef PK4
}
__device__ __forceinline__ float row_sum(const f32x16& p0, const f32x16& p1) {
    float sm[4] = {0.f, 0.f, 0.f, 0.f};
#pragma unroll
    for (int r = 0; r < 16; ++r) sm[r & 3] += p0[r] + p1[r];
    const float ps = (sm[0] + sm[1]) + (sm[2] + sm[3]);
    auto rr = __builtin_amdgcn_permlane32_swap(__float_as_uint(ps), __float_as_uint(ps), false, false);
    return __uint_as_float(rr[0]) + __uint_as_float(rr[1]);
}
__device__ __forceinline__ void pv_tile(f32x16* o, int vb0, bf16x8 pa0, bf16x8 pa1, bf16x8 pa2, bf16x8 pa3) {
#define TRRD(dst, off) asm volatile("ds_read_b64_tr_b16 %0, %1 offset:%2" : "=&v"(dst) : "v"(vb0), "i"(off) : "memory")
    s16x4 l[2][4], h[2][4];
#define PV_RD(d0, st) do { constexpr int b_ = L_V + v_rd_off(d0, 0, 0); \
        TRRD(l[st][0], b_); TRRD(h[st][0], b_ + 2048); TRRD(l[st][1], b_ + 4096); TRRD(h[st][1], b_ + 6144); TRRD(l[st][2], b_ + 8192); TRRD(h[st][2], b_ + 10240); TRRD(l[st][3], b_ + 12288); TRRD(h[st][3], b_ + 14336); } while (0)
#define PV_WAIT(n_, st) asm volatile("s_waitcnt lgkmcnt(" #n_ ")" : "+v"(l[st][0]), "+v"(h[st][0]), "+v"(l[st][1]), "+v"(h[st][1]), "+v"(l[st][2]), "+v"(h[st][2]), "+v"(l[st][3]), "+v"(h[st][3]) :: "memory")
#define PV_MM(d0, st) do { \
        o[d0] = __builtin_amdgcn_mfma_f32_32x32x16_bf16(pa0, (bf16x8){l[st][0][0], l[st][0][1], l[st][0][2], l[st][0][3], h[st][0][0], h[st][0][1], h[st][0][2], h[st][0][3]}, o[d0], 0, 0, 0);   \
        o[d0] = __builtin_amdgcn_mfma_f32_32x32x16_bf16(pa1, (bf16x8){l[st][1][0], l[st][1][1], l[st][1][2], l[st][1][3], h[st][1][0], h[st][1][1], h[st][1][2], h[st][1][3]}, o[d0], 0, 0, 0);   \
        o[d0] = __builtin_amdgcn_mfma_f32_32x32x16_bf16(pa2, (bf16x8){l[st][2][0], l[st][2][1], l[st][2][2], l[st][2][3], h[st][2][0], h[st][2][1], h[st][2][2], h[st][2][3]}, o[d0], 0, 0, 0);   \
        o[d0] = __builtin_amdgcn_mfma_f32_32x32x16_bf16(pa3, (bf16x8){l[st][3][0], l[st][3][1], l[st][3][2], l[st][3][3], h[st][3][0], h[st][3][1], h[st][3][2], h[st][3][3]}, o[d0], 0, 0, 0); } while (0)
    PV_RD(0, 0); PV_RD(1, 1);
    PV_WAIT(8, 0); PV_MM(0, 0); PV_RD(2, 0);
    PV_WAIT(8, 1); PV_MM(1, 1); PV_RD(3, 1);
    PV_WAIT(8, 0); PV_MM(2, 0);
    PV_WAIT(0, 1); PV_MM(3, 1);
#undef PV_MM
#undef PV_WAIT
#undef PV_RD
#undef TRRD
}
__device__ __forceinline__ void rescale_o(f32x16* o, float alpha, LAS float* al_l, int r32, int hi) {
    if (__any(alpha < 1.f)) {
        if (hi == 0) al_l[r32] = alpha;
        asm volatile("s_waitcnt lgkmcnt(0)" ::: "memory");
#pragma unroll
        for (int r = 0; r < 16; ++r) { const float a = al_l[crow(r, hi)];
#pragma unroll
            for (int d = 0; d < 4; ++d) o[d][r] *= a; }
        asm volatile("s_waitcnt lgkmcnt(0)" ::: "memory");
    }
}
__device__ __forceinline__ void sm_pv_step(f32x16& p0, f32x16& p1, f32x16* o, float& m_reg, float& l_reg, LAS float* al_l, int vb0, int r32, int hi) {
    float mn, alpha;
    partialSM(p0, p1, m_reg, mn, alpha);
    rescale_o(o, alpha, al_l, r32, hi);
    l_reg = l_reg * alpha + row_sum(p0, p1);
    bf16x8 pa0, pa1, pa2, pa3; pack_p(p0, p1, pa0, pa1, pa2, pa3);
    pv_tile(o, vb0, pa0, pa1, pa2, pa3);
}
__device__ __forceinline__ void lanes_to_rows(float x, float* vals, LAS float* xl, int r32, int hi) {
    if (hi == 0) xl[r32] = x;
    asm volatile("s_waitcnt lgkmcnt(0)" ::: "memory");
#pragma unroll
    for (int r = 0; r < 16; ++r) vals[r] = xl[crow(r, hi)];
    asm volatile("s_waitcnt lgkmcnt(0)" ::: "memory");
}
template <int NI, class Issue, class Active, class Fixup>
__device__ __forceinline__ void pingpong_attn(int nT, int wid, LAS unsigned char* lds, int vb0, const bf16x8* qr, f32x16* o, float& m_reg, float& l_reg, LAS float* al_l, int r32, int hi,
                                              Issue issue, Active active, Fixup fixup) {
    const bool grpB = wid >= 4;
    issue(0); if (nT > 1) issue(1);
    dma_wait<NI>(nT > 1 ? 1 : 0);
    RING_BAR();
    if (grpB) RING_BAR();
    bf16x8 pa0 = {}, pa1 = {}, pa2 = {}, pa3 = {}; bool act_prev = false;
    f32x16 p0 = {}, p1 = {};
    for (int s = 0; s <= nT; ++s) {
        if (s + 2 < nT) issue(s + 2);
        if (act_prev) pv_tile(o, vb0 + ((s - 1) & 3) * KVBUF, pa0, pa1, pa2, pa3);
        bool act = false;
        if (s < nT) { act = active(s); if (act) qkt(p0, p1, lds + (s & 3) * KVBUF, r32, hi, qr); }
        if (s + 1 < nT) dma_wait<NI>(s + 2 < nT ? 1 : 0);
        RING_BAR();
        if (s < nT) {
            if (act) { fixup(s, p0, p1); float mn, alpha; partialSM(p0, p1, m_reg, mn, alpha); rescale_o(o, alpha, al_l, r32, hi); l_reg = l_reg * alpha + row_sum(p0, p1);
                       pack_p(p0, p1, pa0, pa1, pa2, pa3); }
            act_prev = act;
            RING_BAR();
        }
    }
    if (!grpB) RING_BAR();
}
template <int NI, int NSET, class Issue, class Active, class Fixup>
__device__ __forceinline__ void dual_attn(int nT, int wid, LAS unsigned char* lds, int vb0, const bf16x8* qr, f32x16* o, float& m_reg, float& l_reg, LAS float* al_l, int r32, int hi,
                                          Issue issue, Active active, Fixup fixup) {
    const int nS = (nT + 1) >> 1;
    issue(0); if (nT > 1) issue(1);
    for (int s = 0; s < nS; ++s) {
        asm volatile("s_waitcnt vmcnt(0)" ::: "memory");
        RING_BAR();
        if (2 * s + 2 < nT) issue(2 * s + 2);
        if (2 * s + 3 < nT) issue(2 * s + 3);
        const int sa = (2 * s) & 3;
        const float NEGI = -__builtin_inff();
        f32x16 p0, p1, p2, p3;
        const bool acta = active(2 * s);
        if (acta) { qkt<NSET>(p0, p1, lds + sa * KVBUF, r32, hi, qr); fixup(2 * s, p0, p1); }
        else {
#pragma unroll
            for (int r = 0; r < 16; ++r) { p0[r] = NEGI; p1[r] = NEGI; } }
        if (NSET == 2) __builtin_amdgcn_sched_barrier(0);
        bool actb = false;
        if (2 * s + 1 < nT) actb = active(2 * s + 1);
        if (actb) { qkt<NSET>(p2, p3, lds + (sa + 1) * KVBUF, r32, hi, qr); fixup(2 * s + 1, p2, p3); }
        else {
#pragma unroll
            for (int r = 0; r < 16; ++r) { p2[r] = NEGI; p3[r] = NEGI; } }
        if (!acta && !actb) continue;
        float mx[4] = {p0[0], p0[1], p0[2], p0[3]};
#pragma unroll
        for (int r = 4; r < 16; ++r) mx[r & 3] = fmaxf(mx[r & 3], p0[r]);
#pragma unroll
        for (int r = 0; r < 16; ++r) mx[r & 3] = fmaxf(mx[r & 3], fmaxf(p1[r], fmaxf(p2[r], p3[r])));
        float pmax = fmaxf(fmaxf(mx[0], mx[1]), fmaxf(mx[2], mx[3]));
        { auto rr = __builtin_amdgcn_permlane32_swap(__float_as_uint(pmax), __float_as_uint(pmax), false, false);
          pmax = fmaxf(__uint_as_float(rr[0]), __uint_as_float(rr[1])); }
        float mn = m_reg, alpha = 1.f;
        if (__any((pmax - m_reg) * C2 > 8.f)) { mn = fmaxf(m_reg, pmax); alpha = __builtin_amdgcn_exp2f((m_reg - mn) * C2); m_reg = mn; }
        const float mnL = -mn * C2;
#pragma unroll
        for (int r = 0; r < 16; ++r) { p0[r] = __builtin_amdgcn_exp2f(fmaf(p0[r], C2, mnL)); p1[r] = __builtin_amdgcn_exp2f(fmaf(p1[r], C2, mnL));
                                       p2[r] = __builtin_amdgcn_exp2f(fmaf(p2[r], C2, mnL)); p3[r] = __builtin_amdgcn_exp2f(fmaf(p3[r], C2, mnL)); }
        rescale_o(o, alpha, al_l, r32, hi);
        { float sm[4] = {0.f, 0.f, 0.f, 0.f};
#pragma unroll
          for (int r = 0; r < 16; ++r) sm[r & 3] += (p0[r] + p1[r]) + (p2[r] + p3[r]);
          const float ps = (sm[0] + sm[1]) + (sm[2] + sm[3]);
          auto rr = __builtin_amdgcn_permlane32_swap(__float_as_uint(ps), __float_as_uint(ps), false, false);
          l_reg = l_reg * alpha + (__uint_as_float(rr[0]) + __uint_as_float(rr[1])); }
        if (acta) { bf16x8 a0, a1, a2, a3; pack_p(p0, p1, a0, a1, a2, a3); pv_tile(o, vb0 + sa * KVBUF, a0, a1, a2, a3); }
        if (actb) { bf16x8 b0, b1, b2, b3; pack_p(p2, p3, b0, b1, b2, b3); pv_tile(o, vb0 + (sa + 1) * KVBUF, b0, b1, b2, b3); }
    }
}
__device__ __forceinline__ void store_o_bf16(const f32x16* o, const float* rs, bf16_t* __restrict__ Ow, int ldo, int r32, int hi) {
    unsigned w[16][4];
#pragma unroll
    for (int r = 0; r < 16; ++r)
#pragma unroll
        for (int d0 = 0; d0 < 4; ++d0) { const float v = o[d0][r] * rs[r]; const float vn = DPPF(v, 0xB1); w[r][d0] = cvt_pk_bf16(v, vn); }
    if ((r32 & 1) == 0) {
#pragma unroll
        for (int r = 0; r < 16; ++r)
#pragma unroll
            for (int d0 = 0; d0 < 4; ++d0) *(unsigned*)(Ow + (size_t)crow(r, hi) * ldo + d0 * 32 + r32) = w[r][d0];
    }
}
__device__ __forceinline__ int t5_bucket(int n) {
    if (n < 16) return n;
    const float lr = logf((float)n / 16.f) / 2.0794415416798357f;
    const int v = 16 + (int)(lr * 16.f);
    return v < 31 ? v : 31;
}
}

__device__ __forceinline__ void fox_norm_phase(const Frame& F, const bf16_t* __restrict__ proj, unsigned* __restrict__ nrm) {
    const int tid = TID, sub = tid & 15, rl = tid >> 4;
    for (int it = F.bid; it < 256; it += F.G) {
        const int bh = it >> 2, qtr = it & 3, b = bh >> 3, h = bh & 7;
        float mq = 0.f, mk = 0.f;
        for (int r0 = 0; r0 < 1024; r0 += 128) {
            u32x4 qv[4], kv[4];
#pragma unroll
            for (int u = 0; u < 4; ++u) { const size_t row = (size_t)(b * T + qtr * 1024 + r0 + u * 32 + rl) * EV_NP;
                qv[u] = *(const u32x4*)(proj + row + EC_QB + h * 128 + sub * 8); kv[u] = *(const u32x4*)(proj + row + EC_KB + h * 128 + sub * 8); }
#pragma unroll
            for (int u = 0; u < 4; ++u) { const u32x4 q = qv[u], k = kv[u];
                float sq = bflo(q.x) * bflo(q.x) + bfhi(q.x) * bfhi(q.x) + bflo(q.y) * bflo(q.y) + bfhi(q.y) * bfhi(q.y) + bflo(q.z) * bflo(q.z) + bfhi(q.z) * bfhi(q.z) + bflo(q.w) * bflo(q.w) + bfhi(q.w) * bfhi(q.w);
                float sk = bflo(k.x) * bflo(k.x) + bfhi(k.x) * bfhi(k.x) + bflo(k.y) * bflo(k.y) + bfhi(k.y) * bfhi(k.y) + bflo(k.z) * bflo(k.z) + bfhi(k.z) * bfhi(k.z) + bflo(k.w) * bflo(k.w) + bfhi(k.w) * bfhi(k.w);
                sq = row16_sum(sq); sk = row16_sum(sk);
                mq = fmaxf(mq, sq); mk = fmaxf(mk, sk); }
        }
#pragma unroll
        for (int o = 16; o < 64; o <<= 1) { mq = fmaxf(mq, shx(mq, o)); mk = fmaxf(mk, shx(mk, o)); }
        if ((tid & 63) == 0) { atomicMax(nrm + bh * 2, __float_as_uint(mq)); atomicMax(nrm + bh * 2 + 1, __float_as_uint(mk)); }
    }
}
__device__ __forceinline__ void fscan_phase(const Frame& F, const bf16_t* __restrict__ proj, const float* __restrict__ bforget, float* __restrict__ cf) {
    LAS float* red = (LAS float*)F.lds;
    const int tid = TID;
    for (int it = F.bid; it < NB * 8; it += F.G) {
        const int b = it >> 3, h = it & 7; const float bf = bforget[h];
        float v[8]; float s = 0.f;
#pragma unroll
        for (int i = 0; i < 8; ++i) { const int t = tid * 8 + i; const float x = bf2f(proj[(size_t)(b * T + t) * EV_NP + EC_F + h]) + bf;
            const float ls = fminf(x, 0.f) - log1pf(__expf(-fabsf(x))); s += ls; v[i] = s; }
        __syncthreads();
        red[tid] = s;
        __syncthreads();
        if (tid < 64) { float a = 0.f;
            float loc[8];
#pragma unroll
            for (int i = 0; i < 8; ++i) { a += red[tid * 8 + i]; loc[i] = a; }
            float incl = a;
#pragma unroll
            for (int o = 1; o < 64; o <<= 1) { const float n = shu(incl, o); if (tid >= o) incl += n; }
            const float excl = incl - a;
#pragma unroll
            for (int i = 0; i < 8; ++i) red[tid * 8 + i] = excl + loc[i];
        }
        __syncthreads();
        const float base = tid > 0 ? red[tid - 1] : 0.f;
#pragma unroll
        for (int i = 0; i < 8; ++i) cf[(size_t)it * T + tid * 8 + i] = base + v[i];
    }
    __syncthreads();
}

__device__ __forceinline__ void even_attn_phase(const Frame& F, const bf16_t* __restrict__ proj, bf16_t* __restrict__ mix, const float* __restrict__ cf, const float* __restrict__ relb, const float* __restrict__ sinks, const unsigned* __restrict__ nrm, unsigned* __restrict__ qhead) {
    using namespace att;
    LAS unsigned char* lds = F.lds;
    const int tid = opaque_tid(), wid = __builtin_amdgcn_readfirstlane(tid >> 6), lane = tid & 63, r32 = lane & 31, hi = lane >> 5;
    LAS float* al_l = (LAS float*)(lds + EL_WS) + wid * 64;
    LAS float* cfr = (LAS float*)(lds + EL_CFR) + wid * 64;
    LAS float* tab = (LAS float*)(lds + EL_TAB);
    constexpr int LD = EV_NP;
    LAS int* qi = (LAS int*)(lds + EL_MISC);
    for (int i = tid; i < 1024; i += NTHR) tab[i] = relb[t5_bucket(i & 127) * 8 + (i >> 7)] * INV_SCALE;
    for (;;) {
        __syncthreads();
        if (threadIdx.x == 0) *qi = (int)__hip_atomic_fetch_add(qhead, 1u, __ATOMIC_RELAXED, __HIP_MEMORY_SCOPE_AGENT);
        __syncthreads();
        const int it = __builtin_amdgcn_readfirstlane(*qi);
        if (it >= 2048) break;
        const int tid = opaque_tid(), lane = tid & 63, r32 = lane & 31, hi = lane >> 5;
        const int vb0 = (int)(uintptr_t)(lds + L_V) + v_rd_base(lane);
        const KvOff ko = kv_dma_off(tid, LD);
        if (it < 1024) {
            const int qb = 15 - (it >> 6), bh = it & 63;
            const int b = bh >> 3, h = bh & 7, P0 = qb * 256, qpos0 = P0 + wid * 32;
            const bf16_t* Qg = proj + (size_t)(b * T + qpos0 + r32) * LD + EC_QB + h * 128;
            const bf16_t* Kg = proj + (size_t)(b * T) * LD + EC_KB + h * 128;
            const bf16_t* Vg = proj + (size_t)(b * T) * LD + EC_VB + h * 128;
            const float* cfh = cf + (size_t)(b * 8 + h) * T;
            bf16x8 qr[8];
#pragma unroll
            for (int d0 = 0; d0 < 8; ++d0) qr[d0] = *(const bf16x8*)(Qg + d0 * 16 + hi * 8);
            const float crefS = cfh[P0 + 255] * INV_SCALE;
            float m_reg = -1e30f, l_reg = 0.f; f32x16 o[4] = {};
            const int ntile = 4 * qb + 4;
            int jlo;
            { const float bnd = 2.f * sqrtf(__uint_as_float(nrm[(b * 8 + h) * 2]) * __uint_as_float(nrm[(b * 8 + h) * 2 + 1])) * SCALE * 1.02f + cfh[P0];
              const bool keep = (lane >= 4 * qb) || (bnd - cfh[lane * 64 + 63] >= -36.f);
              jlo = __builtin_amdgcn_readfirstlane(__builtin_ctzll(__ballot(keep))); }
            const int nT = ntile - jlo;
#define FOX_ISSUE(k_) do { const int t_ = jlo + (k_), s_ = (k_) & 3; kv_dma(lds + s_ * KVBUF, Kg + (size_t)(t_ * 64) * LD, Vg + (size_t)(t_ * 64) * LD, LD, ko, wid); \
                __builtin_amdgcn_global_load_lds((const unsigned*)(cfh + t_ * 64 + lane), (LAS unsigned*)(cfr + s_ * 512), 4, 0, 0); } while (0)
            __syncthreads();
            int kb = 0; const LAS float* kbb = cfr;
            pingpong_attn<5>(nT, wid, lds, vb0, qr, o, m_reg, l_reg, al_l, r32, hi,
                [&](int k) { FOX_ISSUE(k); },
                [&](int s) { kb = (jlo + s) * 64; kbb = cfr + (s & 3) * 512; return kb <= qpos0 + 31; },
                [&](int, f32x16& p0, f32x16& p1) {
#pragma unroll
                    for (int g4 = 0; g4 < 4; ++g4) { const f32x4 b0 = *(const LAS f32x4*)(kbb + 8 * g4 + 4 * hi), b1 = *(const LAS f32x4*)(kbb + 32 + 8 * g4 + 4 * hi);
#pragma unroll
                        for (int i = 0; i < 4; ++i) { p0[4 * g4 + i] += fmaf(b0[i], -INV_SCALE, crefS); p1[4 * g4 + i] += fmaf(b1[i], -INV_SCALE, crefS); } }
                    if (kb + 63 > qpos0) {
                        const int dq = qpos0 + r32 - kb - 4 * hi; const float NEG = -__builtin_inff();
#pragma unroll
                        for (int r = 0; r < 16; ++r) { const int c = (r & 3) + 8 * (r >> 2); if (dq - c < 0) p0[r] = NEG; if (dq - c - 32 < 0) p1[r] = NEG; }
                    }
                });
#undef FOX_ISSUE
            float rs[16]; lanes_to_rows(__builtin_amdgcn_rcpf(l_reg), rs, al_l, r32, hi);
            store_o_bf16(o, rs, mix + (size_t)(b * T + qpos0) * D + 1024 + h * 128, D, r32, hi);
        } else {
            const int i2 = it - 1024, qb = i2 & 63, bg = i2 >> 6, b = bg >> 1, g = bg & 1;
            const int hl = wid >> 1, head = g * 4 + hl, P0 = qb * 64, qpos0 = P0 + (wid & 1) * 32;
            const bf16_t* Qg = proj + (size_t)(b * T + qpos0 + r32) * LD + EC_QA + head * 128;
            const bf16_t* Kg = proj + (size_t)(b * T) * LD + EC_KA + g * 128;
            const bf16_t* Vg = proj + (size_t)(b * T) * LD + EC_VA + g * 128;
            bf16x8 qr[8];
#pragma unroll
            for (int d0 = 0; d0 < 8; ++d0) qr[d0] = *(const bf16x8*)(Qg + d0 * 16 + hi * 8);
            float m_reg = sinks[head] * INV_SCALE, l_reg = 1.f; f32x16 o[4] = {};
            const LAS float* tb = tab + head * 128;
            const int jt0 = (qb >= 2 ? qb - 2 : 0), nT = qb - jt0 + 1;
            __syncthreads();
            int kb = 0;
            pingpong_attn<4>(nT, wid, lds, vb0, qr, o, m_reg, l_reg, al_l, r32, hi,
                [&](int k) { kv_dma(lds + (k & 3) * KVBUF, Kg + (size_t)((jt0 + k) * 64) * LD, Vg + (size_t)((jt0 + k) * 64) * LD, LD, ko, wid); },
                [&](int s) { kb = (jt0 + s) * 64; return kb <= qpos0 + 31 && kb + 63 >= qpos0 - 127; },
                [&](int, f32x16& p0, f32x16& p1) {
                    const int dq = qpos0 + r32 - kb - 4 * hi; const float NEG = -__builtin_inff();
#pragma unroll
                    for (int r = 0; r < 16; ++r) { const int c = (r & 3) + 8 * (r >> 2); const int d0_ = dq - c, d1_ = dq - c - 32;
                        float t0 = tb[d0_ & 127], t1 = tb[d1_ & 127];
                        asm("" : "+v"(t0), "+v"(t1));
                        p0[r] = ((unsigned)d0_ < 128u) ? p0[r] + t0 : NEG; p1[r] = ((unsigned)d1_ < 128u) ? p1[r] + t1 : NEG; }
                });
            float rs[16]; lanes_to_rows(__builtin_amdgcn_rcpf(l_reg), rs, al_l, r32, hi);
            store_o_bf16(o, rs, mix + (size_t)(b * T + qpos0) * D + head * 128, D, r32, hi);
        }
    }
    __syncthreads();
}

#define N_EVEN_PHASES 5
#define even_mixer_phases \
    PH_BEGIN { pg8::Gemm g{RES, (const bf16_t*)(ws + WS_W_EV_IN + j * SZ_W_EV_IN), M, EC_F, D, D}; pg8::StaticOrder S; S.init(M, EC_F, F.G, F.bid);     \
               pg8::EpiStoreBf16 E{PROJ, EV_NP, RSTD}; pg8::gemm_phase(F.lds, g, S, E); } PH_END \
    PH_BEGIN fscan_phase(F, PROJ, F.in[I_EV_BF] + j * 8, (float*)(ws + WS_CF)); fox_norm_phase(F, PROJ, F.ctl + CW_NORM + j * 128); PH_END \
    PH_BEGIN even_attn_phase(F, PROJ, HB, (const float*)(ws + WS_CF), F.in[I_RELB], F.in[I_EV_SINK] + j * 8, F.ctl + CW_NORM + j * 128, F.ctl + CW_QUEUE + 64 * (4 + j)); PH_END \
    PH_BEGIN { pg8::Gemm g{HB, (const bf16_t*)(ws + WS_W_EV_OUT + j * SZ_W_OUT), M, D, D, D}; pg8::StaticOrder S; S.init(M, D, F.G, F.bid); \
               pg8::EpiAddRes E{RES, D}; pg8::gemm_phase(F.lds, g, S, E); } PH_END \
    PH_BEGIN rowstat_phase(F, RES, RSTD); PH_END
namespace gdn {
constexpr int RLD = 260, AMLD = 68;
constexpr int L_R = 0, L_KB16 = 64 * RLD * 4, L_QB16 = L_KB16 + 64 * 272, L_AM = L_QB16 + 64 * 272, L_GAM = L_AM + 64 * AMLD * 4, L_BETA = L_GAM + 256, L_BEG = L_BETA + 256, L_END = L_BEG + 256, L_WL = L_END + 16  , L_END2 = L_WL + 3 * 4 * 128 * 4;
static_assert(L_END2 <= LDS_BARW && (L_KB16 % 16) == 0 && (L_AM % 16) == 0 && (L_WL % 16) == 0, "gdn lds");
constexpr int RS16 = 272;

__device__ __forceinline__ void chunk_phase(const Frame& F, const bf16_t* __restrict__ proj, const float* __restrict__ convw, const float* __restrict__ alog, const float* __restrict__ dtb, unsigned* __restrict__ qhead) {
    LAS unsigned char* lds = F.lds;
    unsigned char* ws = F.ws;
    bf16_t* Ug = (bf16_t*)(ws + WS_G_U); bf16_t* Wg = (bf16_t*)(ws + WS_G_W); bf16_t* QGg = (bf16_t*)(ws + WS_G_QG); bf16_t* KTg = (bf16_t*)(ws + WS_G_KT);
    bf16_t* ATg = (bf16_t*)(ws + WS_G_ATT); float* GLg = (float*)(ws + WS_G_GL);
    LAS float* R = (LAS float*)(lds + L_R);
    LAS float* AM = (LAS float*)(lds + L_AM); LAS float* GAM = (LAS float*)(lds + L_GAM); LAS float* BETA = (LAS float*)(lds + L_BETA); LAS float* BEG = (LAS float*)(lds + L_BEG);
    LAS int* qi = (LAS int*)(lds + L_END);
    unsigned pend = 0u;
    if (threadIdx.x == 0) pend = __hip_atomic_fetch_add(qhead, 1u, __ATOMIC_RELAXED, __HIP_MEMORY_SCOPE_AGENT);
    for (;;) {
        __syncthreads();
        if (threadIdx.x == 0) { *qi = (int)pend; pend = __hip_atomic_fetch_add(qhead, 1u, __ATOMIC_RELAXED, __HIP_MEMORY_SCOPE_AGENT); }
        __syncthreads();
        const int ci = __builtin_amdgcn_readfirstlane(*qi);
        if (ci >= NCHUNK) break;
        const int n = ci & 63, bh = ci >> 6, b = bh >> 3, h = bh & 7, t0 = n * 64;
        const int tl = opaque_tid(), c0 = (tl & 15) * 8, i0 = tl >> 4;
        u32x4 xv[3][2][4];
#pragma unroll
        for (int which = 0; which < 3; ++which) {
            const int pcol = (which == 0 ? OC_QD : which == 1 ? OC_KD : OC_VD) + h * 128;
#pragma unroll
            for (int e = 0; e < 2; ++e)
#pragma unroll
                for (int jj = 0; jj < 4; ++jj) { const int t = t0 + i0 + e * 32 - 3 + jj, tc = t < 0 ? 0 : t;
                    xv[which][e][jj] = *(const u32x4*)(proj + (size_t)(b * T + tc) * OD_NP + pcol + c0); }
        }
        f32x4 wld = (f32x4){0.f, 0.f, 0.f, 0.f};
        if (tl < 384) { const int wh = tl >> 7, jj = (tl & 127) >> 5, c4 = tl & 31; wld = *(const f32x4*)(convw + (size_t)jj * 3072 + wh * 1024 + h * 128 + c4 * 4); }
        float bl = 0.f, al = 0.f;
        if (tl < 64) { const size_t row = (size_t)(b * T + t0 + tl) * OD_NP; bl = bf2f(proj[row + OC_BETA + h]); al = bf2f(proj[row + OC_A + h]); }
        LAS float* WL = (LAS float*)(lds + L_WL);
        if (tl < 384) *(LAS f32x4*)(WL + ((tl >> 7) * 4 + ((tl & 127) >> 5)) * 128 + (tl & 31) * 4) = wld;
        if (tl < 64) {
            const float x = al + dtb[h];
            const float sp = fmaxf(x, 0.f) + log1pf(__expf(-fabsf(x)));
            float g = -__expf(alog[h]) * sp;
#pragma unroll
            for (int o = 1; o < 64; o <<= 1) { const float nb = shu(g, o); if (tl >= o) g += nb; }
            const float be = sigmoidf_(bl); GAM[tl] = g; BETA[tl] = be; BEG[tl] = be * __expf(g);
            if (tl == 63) GLg[ci] = __expf(g);
        }
        __syncthreads();
#pragma unroll
        for (int which = 0; which < 3; ++which) {
            f32x4 wa[4], wb[4];
#pragma unroll
            for (int jj = 0; jj < 4; ++jj) { wa[jj] = *(LAS f32x4*)(WL + (which * 4 + jj) * 128 + c0); wb[jj] = *(LAS f32x4*)(WL + (which * 4 + jj) * 128 + c0 + 4); }
#pragma unroll
            for (int e = 0; e < 2; ++e) {
                const int i = i0 + e * 32;
                float acc[8];
#pragma unroll
                for (int q = 0; q < 8; ++q) acc[q] = 0.f;
#pragma unroll
                for (int jj = 0; jj < 4; ++jj) {
                    const float vz = (t0 + i - 3 + jj >= 0) ? 1.f : 0.f; const u32x4 x = xv[which][e][jj];
                    const f32x4 a_ = wa[jj] * vz, b_ = wb[jj] * vz;
                    acc[0] += a_[0] * bflo(x.x); acc[1] += a_[1] * bfhi(x.x); acc[2] += a_[2] * bflo(x.y); acc[3] += a_[3] * bfhi(x.y);
                    acc[4] += b_[0] * bflo(x.z); acc[5] += b_[1] * bfhi(x.z); acc[6] += b_[2] * bflo(x.w); acc[7] += b_[3] * bfhi(x.w);
                }
                float ss = 0.f;
#pragma unroll
                for (int q = 0; q < 8; ++q) { acc[q] = siluf_(acc[q]); ss += acc[q] * acc[q]; }
                if (which < 2) {
                    ss = row16_sum(ss);
                    const float rn = rsqrtf(ss + EPS) * (which == 0 ? SCALE : 1.f);
#pragma unroll
                    for (int q = 0; q < 8; ++q) acc[q] *= rn;
                    u32x4 w; w.x = cvt_pk_bf16(acc[0], acc[1]); w.y = cvt_pk_bf16(acc[2], acc[3]); w.z = cvt_pk_bf16(acc[4], acc[5]); w.w = cvt_pk_bf16(acc[6], acc[7]);
                    *(LAS u32x4*)(lds + (which == 0 ? L_QB16 : L_KB16) + i * RS16 + c0 * 2) = w;
                }
                if (which >= 1) { const float sc = (which == 1) ? BEG[i] : BETA[i]; LAS float* dst = R + i * RLD + (which == 1 ? 128 : 0) + c0;
                    *(LAS f32x4*)dst = (f32x4){acc[0], acc[1], acc[2], acc[3]} * sc; *(LAS f32x4*)(dst + 4) = (f32x4){acc[4], acc[5], acc[6], acc[7]} * sc; }
            }
        }
        __syncthreads();
        {
            const int t2 = opaque_tid(), wid = __builtin_amdgcn_readfirstlane(t2 >> 6), lane = t2 & 63, r32 = lane & 31, hi = lane >> 5;
            const int mat = wid >> 2, ti = (wid >> 1) & 1, tj = wid & 1;
            f32x16 acc = {};
            if (!(ti == 0 && tj == 1)) {
                LAS unsigned char* xa = lds + (mat == 0 ? L_KB16 : L_QB16) + (32 * ti + r32) * RS16 + hi * 16;
                LAS unsigned char* xb = lds + L_KB16 + (32 * tj + r32) * RS16 + hi * 16;
#pragma unroll
                for (int ks = 0; ks < 8; ++ks) acc = __builtin_amdgcn_mfma_f32_32x32x16_bf16(*(LAS bf16x8*)(xa + ks * 32), *(LAS bf16x8*)(xb + ks * 32), acc, 0, 0, 0);
            }
            const int jc = 32 * tj + r32; const float gj = GAM[jc];
#pragma unroll
            for (int r = 0; r < 16; ++r) {
                const int i = 32 * ti + att::crow(r, hi);
                const float dec = __expf(fminf(GAM[i] - gj, 0.f));
                if (mat == 0) AM[i * AMLD + jc] = (jc < i) ? acc[r] * BETA[i] * dec : 0.f;
                else ATg[(size_t)ci * 4096 + i * 64 + jc] = f2bf((jc <= i) ? acc[r] * dec : 0.f);
            }
        }
        __syncthreads();
        const int tid3 = opaque_tid();
        {
            { const int i = tid3 >> 3, c0 = (tid3 & 7) * 16; const float eg = __expf(GAM[i]);
#pragma unroll
              for (int q8 = 0; q8 < 2; ++q8) { const u32x4 x = *(LAS u32x4*)(lds + L_QB16 + i * RS16 + (c0 + q8 * 8) * 2);
                  u32x4 w; w.x = cvt_pk_bf16(bflo(x.x) * eg, bfhi(x.x) * eg); w.y = cvt_pk_bf16(bflo(x.y) * eg, bfhi(x.y) * eg);
                  w.z = cvt_pk_bf16(bflo(x.z) * eg, bfhi(x.z) * eg); w.w = cvt_pk_bf16(bflo(x.w) * eg, bfhi(x.w) * eg);
                  *(u32x4*)(QGg + (size_t)ci * 8192 + i * 128 + c0 + q8 * 8) = w; } }
            { const int dk = tid3 >> 2, i0 = (tid3 & 3) * 16; const float gl = GAM[63];
#pragma unroll
              for (int q8 = 0; q8 < 2; ++q8) { float v[8];
#pragma unroll
                  for (int e = 0; e < 8; ++e) { const int i = i0 + q8 * 8 + e; v[e] = bf2f(*(LAS bf16_t*)(lds + L_KB16 + i * RS16 + dk * 2)) * __expf(gl - GAM[i]); }
                  u32x4 w; w.x = cvt_pk_bf16(v[0], v[1]); w.y = cvt_pk_bf16(v[2], v[3]); w.z = cvt_pk_bf16(v[4], v[5]); w.w = cvt_pk_bf16(v[6], v[7]);
                  *(u32x4*)(KTg + (size_t)ci * 8192 + dk * 64 + i0 + q8 * 8) = w; } }
        }
        {
            const int l3 = tid3 & 63, ln = l3 & 15, lk = l3 >> 4, w3 = __builtin_amdgcn_readfirstlane(tid3 >> 6);
            LAS float* Ro = R; LAS float* AMo = AM;
            asm volatile("" : "+v"(Ro), "+v"(AMo));
#pragma unroll
            for (int bb = 0; bb < 4; ++bb) {
                if (bb > 0) {
                    const int col0 = w3 * 32 + ln, col1 = col0 + 16;
                    f32x4 c0v, c1v;
#pragma unroll
                    for (int r = 0; r < 4; ++r) { c0v[r] = Ro[(16 * bb + 4 * lk + r) * RLD + col0]; c1v[r] = Ro[(16 * bb + 4 * lk + r) * RLD + col1]; }
#pragma unroll
                    for (int bp = 0; bp < bb; ++bp)
#pragma unroll
                        for (int s = 0; s < 4; ++s) {
                            const float am = -AMo[(16 * bb + ln) * AMLD + 16 * bp + 4 * s + lk];
                            const float x0 = Ro[(16 * bp + 4 * s + lk) * RLD + col0], x1 = Ro[(16 * bp + 4 * s + lk) * RLD + col1];
                            c0v = __builtin_amdgcn_mfma_f32_16x16x4f32(am, x0, c0v, 0, 0, 0);
                            c1v = __builtin_amdgcn_mfma_f32_16x16x4f32(am, x1, c1v, 0, 0, 0);
                        }
#pragma unroll
                    for (int r = 0; r < 4; ++r) { Ro[(16 * bb + 4 * lk + r) * RLD + col0] = c0v[r]; Ro[(16 * bb + 4 * lk + r) * RLD + col1] = c1v[r]; }
                    __syncthreads();
                }
                if (tid3 < 256) {
                    LAS float* rc = Ro + (16 * bb) * RLD + tid3;
                    float x[16];
#pragma unroll
                    for (int i = 0; i < 16; ++i) x[i] = rc[i * RLD];
#pragma unroll
                    for (int i = 1; i < 16; ++i) {
#pragma unroll
                        for (int j4 = 0; j4 < (i + 3) / 4; ++j4) {
                            const f32x4 am = *(LAS f32x4*)(AMo + (16 * bb + i) * AMLD + 16 * bb + j4 * 4);
#pragma unroll
                            for (int e = 0; e < 4; ++e) if (j4 * 4 + e < i) x[i] -= am[e] * x[j4 * 4 + e];
                        }
                    }
#pragma unroll
                    for (int i = 1; i < 16; ++i) rc[i * RLD] = x[i];
                }
                __syncthreads();
            }
        }
        {
            const int tid4 = opaque_tid();
#pragma unroll
            for (int e = 0; e < 4; ++e) { const int idx = tid4 + e * NTHR, i = idx >> 5, ch = idx & 31;
                const f32x4 a0 = *(LAS f32x4*)(R + i * RLD + ch * 8), a1 = *(LAS f32x4*)(R + i * RLD + ch * 8 + 4);
                const float sg = ch < 16 ? 1.f : -1.f;
                u32x4 w; w.x = cvt_pk_bf16(a0[0] * sg, a0[1] * sg); w.y = cvt_pk_bf16(a0[2] * sg, a0[3] * sg); w.z = cvt_pk_bf16(a1[0] * sg, a1[1] * sg); w.w = cvt_pk_bf16(a1[2] * sg, a1[3] * sg);
                *(u32x4*)((ch < 16 ? Ug : Wg) + (size_t)ci * 8192 + i * 128 + (ch & 15) * 8) = w; }
        }
    }
    __syncthreads();
}

__device__ __forceinline__ bf16x8 ld_afrag(const bf16_t* __restrict__ rowp, int hi) {
    const u32x2 a = *(const u32x2*)(rowp + 4 * hi), b = *(const u32x2*)(rowp + 8 + 4 * hi);
    u32x4 w = {a.x, a.y, b.x, b.y}; return *reinterpret_cast<bf16x8*>(&w);
}
__device__ __forceinline__ bf16x8 acc_bfrag(const f32x16& x, int s) {
    u32x4 w = {cvt_pk_bf16(x[8 * s + 0], x[8 * s + 1]), cvt_pk_bf16(x[8 * s + 2], x[8 * s + 3]), cvt_pk_bf16(x[8 * s + 4], x[8 * s + 5]), cvt_pk_bf16(x[8 * s + 6], x[8 * s + 7])};
    return *reinterpret_cast<bf16x8*>(&w);
}

constexpr int SL_W = 0, SL_QG = SL_W + 64 * 272, SL_KT = SL_QG + 64 * 272, SL_AT = SL_KT + 128 * 144, SL_U = SL_AT + 64 * 144, SL_OS = SL_U + 64 * 256, SL_END = SL_OS + 64 * 132 * 4;
static_assert(SL_END <= LDS_BARW, "scan lds");
__device__ __forceinline__ bf16x8 ld_afrag_lds(const LAS unsigned char* rowp, int hi) {
    const u32x2 a = *(const LAS u32x2*)(rowp + 8 * hi), b = *(const LAS u32x2*)(rowp + 16 + 8 * hi);
    u32x4 w = {a.x, a.y, b.x, b.y}; return *reinterpret_cast<bf16x8*>(&w);
}
__device__ __forceinline__ void scan_item(const Frame& F, int bh, const bf16_t* __restrict__ proj, bf16_t* __restrict__ mix, const float* __restrict__ gnorm) {
    LAS unsigned char* lds = F.lds;
    const int tid = opaque_tid(), wid = __builtin_amdgcn_readfirstlane(tid >> 6), lane = tid & 63, r32 = lane & 31, hi = lane >> 5;
    unsigned char* ws = F.ws;
    const bf16_t* Ug = (const bf16_t*)(ws + WS_G_U); const bf16_t* Wg = (const bf16_t*)(ws + WS_G_W); const bf16_t* QGg = (const bf16_t*)(ws + WS_G_QG); const bf16_t* KTg = (const bf16_t*)(ws + WS_G_KT);
    const bf16_t* ATg = (const bf16_t*)(ws + WS_G_ATT); const float* GLg = (const float*)(ws + WS_G_GL);
    LAS float* OS = (LAS float*)(lds + SL_OS);
    const int b = bh >> 3, h = bh & 7;
    const bool loader = wid >= 4;
    u32x4 st[18];
#define SCAN_LOAD(ci_) do { const size_t c_ = (size_t)(ci_); const int lt = opaque_tid() & 255;     \
        _Pragma("unroll") for (int e = 0; e < 4; ++e) { const int idx = lt + 256 * e; \
            st[e]      = *(const u32x4*)(Wg  + c_ * 8192 + (idx >> 4) * 128 + (idx & 15) * 8); \
            st[4 + e]  = *(const u32x4*)(QGg + c_ * 8192 + (idx >> 4) * 128 + (idx & 15) * 8); \
            st[8 + e]  = *(const u32x4*)(KTg + c_ * 8192 + (idx >> 3) * 64 + (idx & 7) * 8); \
            st[12 + e] = *(const u32x4*)(Ug  + c_ * 8192 + (idx >> 4) * 128 + (idx & 15) * 8); } \
        _Pragma("unroll") for (int e = 0; e < 2; ++e) { const int idx = lt + 256 * e; st[16 + e] = *(const u32x4*)(ATg + c_ * 4096 + (idx >> 3) * 64 + (idx & 7) * 8); } } while (0)
#define SCAN_STORE() do { const int lt = opaque_tid() & 255; \
        _Pragma("unroll") for (int e = 0; e < 4; ++e) { const int idx = lt + 256 * e; \
            *(LAS u32x4*)(lds + SL_W  + (idx >> 4) * 272 + (idx & 15) * 16) = st[e]; \
            *(LAS u32x4*)(lds + SL_QG + (idx >> 4) * 272 + (idx & 15) * 16) = st[4 + e]; \
            *(LAS u32x4*)(lds + SL_KT + (idx >> 3) * 144 + (idx & 7) * 16) = st[8 + e]; \
            *(LAS u32x4*)(lds + SL_U  + (idx >> 4) * 256 + (idx & 15) * 16) = st[12 + e]; } \
        _Pragma("unroll") for (int e = 0; e < 2; ++e) { const int idx = lt + 256 * e; *(LAS u32x4*)(lds + SL_AT + (idx >> 3) * 144 + (idx & 7) * 16) = st[16 + e]; } } while (0)
    const int ci0 = bh * 64;
    const int ni = tid >> 3, nc0 = (tid & 7) * 16;
    const bf16_t* zbase = proj + (size_t)(b * T + ni) * OD_NP + OC_Z + h * 128 + nc0;
    u32x4 z0 = *(const u32x4*)zbase, z1 = *(const u32x4*)(zbase + 8);
    float glv = GLg[ci0];
    if (loader) SCAN_LOAD(ci0);
    __syncthreads();
    if (loader) { SCAN_STORE(); SCAN_LOAD(ci0 + 1); }
    __syncthreads();
    f32x16 S[4] = {};
#pragma unroll 1
    for (int n = 0; n < 64; ++n) {
        if (!loader) {
            const int c0 = 32 * wid;
            bf16x8 vb[2][2];
#pragma unroll
            for (int mt = 0; mt < 2; ++mt) {
                f32x16 vn;
#pragma unroll
                for (int r = 0; r < 16; ++r) vn[r] = bf2f(*(const LAS bf16_t*)(lds + SL_U + (32 * mt + att::crow(r, hi)) * 256 + (c0 + r32) * 2));
                const LAS unsigned char* wrow = lds + SL_W + (32 * mt + r32) * 272;
#pragma unroll
                for (int kt = 0; kt < 4; ++kt)
#pragma unroll
                    for (int s = 0; s < 2; ++s) vn = __builtin_amdgcn_mfma_f32_32x32x16_bf16(ld_afrag_lds(wrow + (kt * 32 + s * 16) * 2, hi), acc_bfrag(S[kt], s), vn, 0, 0, 0);
                vb[mt][0] = acc_bfrag(vn, 0); vb[mt][1] = acc_bfrag(vn, 1);
            }
#pragma unroll
            for (int mt = 0; mt < 2; ++mt) {
                f32x16 oa = {};
                const LAS unsigned char* qrow = lds + SL_QG + (32 * mt + r32) * 272;
#pragma unroll
                for (int kt = 0; kt < 4; ++kt)
#pragma unroll
                    for (int s = 0; s < 2; ++s) oa = __builtin_amdgcn_mfma_f32_32x32x16_bf16(ld_afrag_lds(qrow + (kt * 32 + s * 16) * 2, hi), acc_bfrag(S[kt], s), oa, 0, 0, 0);
                const LAS unsigned char* arow = lds + SL_AT + (32 * mt + r32) * 144;
#pragma unroll
                for (int m2 = 0; m2 <= mt; ++m2)
#pragma unroll
                    for (int s = 0; s < 2; ++s) oa = __builtin_amdgcn_mfma_f32_32x32x16_bf16(ld_afrag_lds(arow + (m2 * 32 + s * 16) * 2, hi), vb[m2][s], oa, 0, 0, 0);
#pragma unroll
                for (int r = 0; r < 16; ++r) OS[(32 * mt + att::crow(r, hi)) * 132 + c0 + r32] = oa[r];
            }
#pragma unroll
            for (int kt = 0; kt < 4; ++kt) {
#pragma unroll
                for (int r = 0; r < 16; ++r) S[kt][r] *= glv;
                const LAS unsigned char* krow = lds + SL_KT + (32 * kt + r32) * 144;
#pragma unroll
                for (int m2 = 0; m2 < 2; ++m2)
#pragma unroll
                    for (int s = 0; s < 2; ++s) S[kt] = __builtin_amdgcn_mfma_f32_32x32x16_bf16(ld_afrag_lds(krow + (m2 * 32 + s * 16) * 2, hi), vb[m2][s], S[kt], 0, 0, 0);
            }
        }
        __syncthreads();
        {
            const int t = n * 64 + ni;
            float v[16]; float ss = 0.f;
#pragma unroll
            for (int q = 0; q < 4; ++q) { const f32x4 x = *(LAS f32x4*)(OS + ni * 132 + nc0 + q * 4); v[q * 4] = x[0]; v[q * 4 + 1] = x[1]; v[q * 4 + 2] = x[2]; v[q * 4 + 3] = x[3]; }
#pragma unroll
            for (int q = 0; q < 16; ++q) ss += v[q] * v[q];
            ss += shx(ss, 1); ss += shx(ss, 2); ss += shx(ss, 4);
            const float rn = rsqrtf(ss * (1.f / 128.f) + EPS);
            const float z[16] = {bflo(z0.x), bfhi(z0.x), bflo(z0.y), bfhi(z0.y), bflo(z0.z), bfhi(z0.z), bflo(z0.w), bfhi(z0.w),
                                 bflo(z1.x), bfhi(z1.x), bflo(z1.y), bfhi(z1.y), bflo(z1.z), bfhi(z1.z), bflo(z1.w), bfhi(z1.w)};
            float y[16];
#pragma unroll
            for (int q = 0; q < 16; ++q) y[q] = v[q] * rn * gnorm[nc0 + q] * siluf_(z[q]);
            u32x4 w0, w1;
            w0.x = cvt_pk_bf16(y[0], y[1]); w0.y = cvt_pk_bf16(y[2], y[3]); w0.z = cvt_pk_bf16(y[4], y[5]); w0.w = cvt_pk_bf16(y[6], y[7]);
            w1.x = cvt_pk_bf16(y[8], y[9]); w1.y = cvt_pk_bf16(y[10], y[11]); w1.z = cvt_pk_bf16(y[12], y[13]); w1.w = cvt_pk_bf16(y[14], y[15]);
            bf16_t* mrow = mix + (size_t)(b * T + t) * D + 1024 + h * 128 + nc0;
            *(u32x4*)mrow = w0; *(u32x4*)(mrow + 8) = w1;
            if (n + 1 < 64) { const bf16_t* zn = zbase + (size_t)((n + 1) * 64) * OD_NP; z0 = *(const u32x4*)zn; z1 = *(const u32x4*)(zn + 8); glv = GLg[ci0 + n + 1]; }
        }
        if (loader && n + 1 < 64) { SCAN_STORE(); if (n + 2 < 64) SCAN_LOAD(ci0 + n + 2); }
        __syncthreads();
    }
#undef SCAN_LOAD
#undef SCAN_STORE
}
}
namespace pg8 {
struct EpiProjOdd {
    static constexpr bool PERM = true;
    bf16_t* O; int ldc; bf16_t* kcmp; bf16_t* vcmp; const float* rs;
    __device__ __forceinline__ void prefetch(const Unit& u, int ui) const { rs_prefetch(rs, u.pm, ui); }
    __device__ __forceinline__ void operator()(const f32x4 (&acc)[2][2][4][2], const Unit& u, int wr, int wc, int ui, int) const {
        const int ol_ = opaque_tid() & 63, fr = ol_ & 15, fq = ol_ >> 4;
        const int row0 = u.pm * BM + wr * 64 + fr, col0 = u.pn * BM + wc * 32 + 8 * fq;
        const bool cmp = (u.pn == 8 || u.pn == 9);
        bf16_t* cb = (u.pn == 8) ? kcmp : vcmp;
        float r_[2][4];
        rs_read(r_, ui, wr, fr);
#pragma unroll
        for (int ai = 0; ai < 2; ++ai)
#pragma unroll
            for (int m = 0; m < 4; ++m) { const int row = row0 + ai * HALF + m * 16; const float r = r_[ai][m];
#pragma unroll
                for (int bj = 0; bj < 2; ++bj) { const f32x4 v0 = acc[ai][bj][m][0] * r, v1 = acc[ai][bj][m][1] * r;
                    u32x4 w; w.x = cvt_pk_bf16(v0[0], v0[1]); w.y = cvt_pk_bf16(v0[2], v0[3]); w.z = cvt_pk_bf16(v1[0], v1[1]); w.w = cvt_pk_bf16(v1[2], v1[3]);
                    bf16_t* p = cmp ? cb + ((size_t)((row / T) * 2 + bj) * T + (row % T)) * 128 + wc * 32 + 8 * fq
                                    : O + (size_t)row * ldc + col0 + bj * HALF;
                    *(u32x4*)p = w; } }
    }
};
__device__ __forceinline__ float gelu_tanh(float x) { const float y = 0.7978845608028654f * (x + 0.044715f * x * x * x); return x * __builtin_amdgcn_rcpf(1.f + __expf(-2.f * y)); }
struct EpiGeluBf16 {
    static constexpr bool PERM = true;
    bf16_t* O; int ldc; const float* bias;
    __device__ __forceinline__ void prefetch(const Unit&, int) const {}
    __device__ __forceinline__ void operator()(const f32x4 (&acc)[2][2][4][2], const Unit& u, int wr, int wc, int, int) const {
        const int ol_ = opaque_tid() & 63, fr = ol_ & 15, fq = ol_ >> 4;
        const int row0 = u.pm * BM + wr * 64 + fr, col0 = u.pn * BM + wc * 32 + 8 * fq;
#pragma unroll
        for (int bj = 0; bj < 2; ++bj) { f32x4 b0 = (f32x4){0.f, 0.f, 0.f, 0.f}, b1 = b0;
#pragma unroll 8
            for (int pp = 0; pp < 32; ++pp) { b0 += *(const f32x4*)(bias + pp * 256 + col0 + bj * HALF); b1 += *(const f32x4*)(bias + pp * 256 + col0 + bj * HALF + 4); }
#pragma unroll
            for (int ai = 0; ai < 2; ++ai)
#pragma unroll
                for (int m = 0; m < 4; ++m) { const f32x4 v0 = acc[ai][bj][m][0] + b0, v1 = acc[ai][bj][m][1] + b1;
                    u32x4 w; w.x = cvt_pk_bf16(gelu_tanh(v0[0]), gelu_tanh(v0[1])); w.y = cvt_pk_bf16(gelu_tanh(v0[2]), gelu_tanh(v0[3]));
                    w.z = cvt_pk_bf16(gelu_tanh(v1[0]), gelu_tanh(v1[1])); w.w = cvt_pk_bf16(gelu_tanh(v1[2]), gelu_tanh(v1[3]));
                    *(u32x4*)(O + (size_t)(row0 + ai * HALF + m * 16) * ldc + col0 + bj * HALF) = w; } }
    }
};
}

namespace nsa {
using namespace att;
constexpr int IMP_LD = 257, SC_LD = 65;
constexpr int L_IMP = 2 * att::KVBUF, L_SC = L_IMP + 64 * IMP_LD * 4  , L_WS = L_SC + 64 * SC_LD * 4, L_TAB = L_WS + 2048, L_BM = L_TAB + 8 * 129 * 4, L_QI = L_BM + 512, L_GATE = L_QI + 16  , L_ENDN = L_GATE + 4096;
static_assert(L_ENDN <= LDS_BARW && (L_IMP % 16) == 0 && L_IMP + 2 * att::KVBUF <= L_SC, "nsa lds");

template <int MODE>
__device__ __forceinline__ void branch_out(const f32x16* o, const float* rs, float* __restrict__ accw, bf16_t* __restrict__ Ow, int ldo, int, int) {
    const int l_ = opaque_tid() & 63, r32 = l_ & 31, hi = l_ >> 5;
    float* base = accw + 4 * hi * 128 + r32;
    float a[16][4];
    if (MODE != 0) {
#pragma unroll
        for (int r = 0; r < 16; ++r)
#pragma unroll
            for (int d0 = 0; d0 < 4; ++d0) a[r][d0] = base[((r & 3) + 8 * (r >> 2)) * 128 + d0 * 32];
    }
    if (MODE != 2) {
#pragma unroll
        for (int r = 0; r < 16; ++r)
#pragma unroll
            for (int d0 = 0; d0 < 4; ++d0) { const float v = o[d0][r] * rs[r]; base[((r & 3) + 8 * (r >> 2)) * 128 + d0 * 32] = (MODE == 0) ? v : a[r][d0] + v; }
    } else {
        unsigned w[16][4];
#pragma unroll
        for (int r = 0; r < 16; ++r)
#pragma unroll
            for (int d0 = 0; d0 < 4; ++d0) { const float v = o[d0][r] * rs[r] + a[r][d0]; const float vn = DPPF(v, 0xB1); w[r][d0] = cvt_pk_bf16(v, vn); }
        if ((r32 & 1) == 0) {
#pragma unroll
            for (int r = 0; r < 16; ++r) { const int orow = crow(r, hi);
#pragma unroll
                for (int d0 = 0; d0 < 4; ++d0) *(unsigned*)(Ow + (size_t)(orow >> 2) * ldo + (orow & 3) * 128 + d0 * 32 + r32) = w[r][d0]; }
        }
    }
}

__device__ __forceinline__ void nsa_item(const Frame& F, int item, const bf16_t* __restrict__ proj, bf16_t* __restrict__ mix, const float* __restrict__ relb) {
    LAS unsigned char* lds = F.lds;
    const int tid = opaque_tid(), wid = __builtin_amdgcn_readfirstlane(tid >> 6), lane = tid & 63, r32 = lane & 31, hi = lane >> 5;
    unsigned char* ws = F.ws;
    LAS float* al_l = (LAS float*)(lds + L_WS) + wid * 64;
    LAS float* tab = (LAS float*)(lds + L_TAB);
    LAS float* IMP = (LAS float*)(lds + L_IMP);
    LAS float* SC = (LAS float*)(lds + L_SC);
    LAS unsigned* BM = (LAS unsigned*)(lds + L_BM);
    const int vb0 = (int)(uintptr_t)(lds + L_V) + v_rd_base(lane);
    constexpr int LD = OD_NP;
    const int qb = 63 - (item >> 4), bg = item & 15, b = bg >> 1, g = bg & 1;
    const int P0 = qb * 64, qlo = P0 + wid * 8, qhi = qlo + 7, ql = wid * 8 + (r32 >> 2), hl = r32 & 3, head = g * 4 + hl, qpos = qlo + (r32 >> 2), cur = qb;
    float* accw = (float*)(ws + WS_NSAACC) + ((size_t)F.bid * 256 + wid * 32) * 128;
    __syncthreads();
    for (int i = tid; i < 64 * IMP_LD; i += NTHR) IMP[i] = 0.f;
    if (tid < 128) BM[tid] = 0u;
    const size_t qrow = (size_t)(b * T + qpos) * LD;
    bf16x8 qr[8];
#pragma unroll
    for (int d0 = 0; d0 < 8; ++d0) qr[d0] = *(const bf16x8*)(proj + qrow + OC_QC + head * 128 + d0 * 16 + hi * 8);
    { u32x2 gg; gg.x = (unsigned)proj[qrow + OC_GATE + head] | ((unsigned)proj[qrow + OC_GATE + 8 + head] << 16); gg.y = proj[qrow + OC_GATE + 16 + head];
      *(LAS u32x2*)(lds + L_GATE + tid * 8) = gg; }
#define gate01_ (((const LAS unsigned*)(lds + L_GATE))[opaque_tid() * 2])
#define gate2_  (((const LAS unsigned*)(lds + L_GATE))[opaque_tid() * 2 + 1])
#define NSA_GATE(br) sigmoidf_((br) == 0 ? bflo(gate01_) : (br) == 1 ? bfhi(gate01_) : bflo(gate2_))
    const LAS float* tb = tab + head * 129;
    const float NEG = -__builtin_inff();

    const bf16_t* KCg = (const bf16_t*)(ws + WS_KC) + (size_t)(bg * 256) * 256;
    const bf16_t* VCg = KCg + (size_t)4096 * 256;
    const int cmax = (qpos - 31) >> 4;
    const int cmax_wg = (P0 + 63 - 31) >> 4;
    const int nct = (cmax_wg >> 6) + 1;
    float m_reg = -1e30f, l_reg = 0.f;
    {
        const KvOff kc = kv_dma_off(tid, 256);
        kv_dma(lds, KCg, VCg, 256, kc, wid);
        float inv_l = 0.f, mL = 0.f;
        f32x16 o[4] = {};
        for (int s = 0; s < 2 * nct; ++s) {
            const int jt = s < nct ? s : s - nct, bo = (s & 1) * KVBUF;
            asm volatile("s_waitcnt vmcnt(0)" ::: "memory");
            RING_BAR();
            if (s + 1 < 2 * nct) { const int jn = (s + 1 < nct) ? s + 1 : s + 1 - nct; kv_dma(lds + (bo ^ KVBUF), KCg + (size_t)(jn * 64) * 256, VCg + (size_t)(jn * 64) * 256, 256, kc, wid); }
            if (s == nct) { inv_l = l_reg > 0.f ? 1.f / l_reg : 0.f; mL = -m_reg * C2; }
            f32x16 p0, p1; qkt(p0, p1, lds + bo, r32, hi, qr);
            if (s < nct) {
#pragma unroll
                for (int r = 0; r < 16; ++r) { const int c = jt * 64 + crow(r, hi); if (c > cmax) p0[r] = NEG; if (c + 32 > cmax) p1[r] = NEG; }
                float mn, alpha; partialSM(p0, p1, m_reg, mn, alpha);
                l_reg = l_reg * alpha + row_sum(p0, p1);
            } else {
                LAS float* ib = IMP + ql * IMP_LD + jt * 64 + 4 * hi;
#pragma unroll
                for (int r = 0; r < 16; ++r) { const int c = jt * 64 + crow(r, hi);
                    p0[r] = (c <= cmax) ? __builtin_amdgcn_exp2f(fmaf(p0[r], C2, mL)) * inv_l : 0.f;
                    p1[r] = (c + 32 <= cmax) ? __builtin_amdgcn_exp2f(fmaf(p1[r], C2, mL)) * inv_l : 0.f;
                    float s0 = p0[r], s1 = p1[r];
                    s0 += DPPF(s0, 0xB1); s1 += DPPF(s1, 0xB1); s0 += DPPF(s0, 0x4E); s1 += DPPF(s1, 0x4E);
                    if (hl == 0) { ib[(r & 3) + 8 * (r >> 2)] = s0; ib[(r & 3) + 8 * (r >> 2) + 32] = s1; } }
                bf16x8 pa0, pa1, pa2, pa3; pack_p(p0, p1, pa0, pa1, pa2, pa3);
                pv_tile(o, vb0 + bo, pa0, pa1, pa2, pa3);
            }
        }
        float rs[16]; lanes_to_rows(NSA_GATE(0), rs, al_l, r32, hi);
        branch_out<0>(o, rs, accw, nullptr, 0, r32, hi);
    }
    __syncthreads();
    {
        const int q = tid & 63, j0 = (tid >> 6) * 8;
        const LAS float* ip = IMP + q * IMP_LD;
#pragma unroll
        for (int e = 0; e < 8; ++e) { const int j = j0 + e;
            const float left = (j > 0) ? ip[4 * j - 1] : 0.f;
            const float blk = left + 2.f * (ip[4 * j] + ip[4 * j + 1] + ip[4 * j + 2]) + ip[4 * j + 3];
            const bool forced = (j == 0) || (j == cur) || (j == cur - 1);
            SC[q * SC_LD + j] = forced ? 1e9f : (j > cur ? -1e9f : blk); }
    }
    __syncthreads();
    {
        const int q = tid & 63, j0 = (tid >> 6) * 8;
        unsigned long long mine[8]; int rank[8];
#define NSA_KEY(sc_, j_) ((((unsigned long long)(__float_as_uint(sc_) ^ ((__float_as_uint(sc_) >> 31) ? 0xffffffffu : 0x80000000u))) << 6) | (unsigned)(63 - (j_)))
#pragma unroll
        for (int e = 0; e < 8; ++e) { const float v = SC[q * SC_LD + j0 + e]; mine[e] = NSA_KEY(v, j0 + e); rank[e] = 0; }
#pragma unroll 2
        for (int jj = 0; jj <= cur; ++jj) { const float sv = SC[q * SC_LD + jj]; const unsigned long long ks = NSA_KEY(sv, jj);
#pragma unroll
            for (int e = 0; e < 8; ++e) rank[e] += (ks > mine[e]) ? 1 : 0; }
#undef NSA_KEY
        unsigned bits = 0u;
#pragma unroll
        for (int e = 0; e < 8; ++e) if (rank[e] < 8 && (j0 + e) <= cur) bits |= 1u << e;
        if (bits) __hip_atomic_fetch_or(BM + q * 2 + (j0 >> 5), bits << (j0 & 31), __ATOMIC_RELAXED, __HIP_MEMORY_SCOPE_WORKGROUP);
    }
    __syncthreads();
    unsigned wu_lo, wu_hi, gu_lo, gu_hi;
    { unsigned a = BM[ql * 2], c = BM[ql * 2 + 1];
#pragma unroll
      for (int o_ = 1; o_ < 32; o_ <<= 1) { a |= shx(a, o_); c |= shx(c, o_); }
      wu_lo = __builtin_amdgcn_readfirstlane(a); wu_hi = __builtin_amdgcn_readfirstlane(c);
      unsigned a2 = BM[lane * 2], c2 = BM[lane * 2 + 1];
#pragma unroll
      for (int o_ = 1; o_ < 64; o_ <<= 1) { a2 |= shx(a2, o_); c2 |= shx(c2, o_); }
      gu_lo = __builtin_amdgcn_readfirstlane(a2); gu_hi = __builtin_amdgcn_readfirstlane(c2); }
    {
        const int tid = opaque_tid(), lane = tid & 63, r32 = lane & 31, hi = lane >> 5, qpos = qlo + (r32 >> 2), ql = wid * 8 + (r32 >> 2);
        const int vb0 = (int)(uintptr_t)(lds + L_V) + v_rd_base(lane);
        const KvOff ko = kv_dma_off(tid, LD);
        const bf16_t* Kg = proj + (size_t)(b * T) * LD + OC_KSEL + g * 128;
        const bf16_t* Vg = proj + (size_t)(b * T) * LD + OC_VSEL + g * 128;
        m_reg = -1e30f; l_reg = 0.f; f32x16 o[4] = {};
        unsigned long long remI = ((unsigned long long)gu_hi << 32) | gu_lo, remC = remI;
        const int nT = __builtin_popcountll(remI);
#define SEL_ISSUE(k_) do { const int jn = __builtin_ctzll(remI); remI &= remI - 1; kv_dma(lds + ((k_) & 3) * KVBUF, Kg + (size_t)(jn * 64) * LD, Vg + (size_t)(jn * 64) * LD, LD, ko, wid); } while (0)
        int jt = 0, kb = 0;
        dual_attn<4, 4>(nT, wid, lds, vb0, qr, o, m_reg, l_reg, al_l, r32, hi,
            [&](int k) { SEL_ISSUE(k); },
            [&](int) { jt = __builtin_ctzll(remC); remC &= remC - 1; kb = jt * 64; return ((jt < 32 ? wu_lo >> jt : wu_hi >> (jt - 32)) & 1u) != 0u; },
            [&](int, f32x16& p0, f32x16& p1) {
                const bool mysel = ((BM[ql * 2 + (jt >> 5)] >> (jt & 31)) & 1u) != 0u;
                const int dq = qpos - kb - 4 * hi;
                if (qlo - kb >= 190) {
                    const float tc = tb[127];
#pragma unroll
                    for (int r = 0; r < 16; ++r) { p0[r] = mysel ? p0[r] + tc : NEG; p1[r] = mysel ? p1[r] + tc : NEG; }
                } else {
#pragma unroll
                for (int r = 0; r < 16; ++r) { const int c = (r & 3) + 8 * (r >> 2); const int d0_ = dq - c, d1_ = dq - c - 32;
                    float t0 = tb[min(max(d0_, 0), 127)], t1 = tb[min(max(d1_, 0), 127)];
                    asm("" : "+v"(t0), "+v"(t1));
                    p0[r] = (mysel && d0_ >= 0) ? p0[r] + t0 : NEG; p1[r] = (mysel && d1_ >= 0) ? p1[r] + t1 : NEG; }
                }
            });
#undef SEL_ISSUE
        float rs[16]; lanes_to_rows(l_reg > 0.f ? NSA_GATE(1) * __builtin_amdgcn_rcpf(l_reg) : 0.f, rs, al_l, r32, hi);
        branch_out<1>(o, rs, accw, nullptr, 0, r32, hi);
    }
    {
        const int tid = opaque_tid(), lane = tid & 63, r32 = lane & 31, hi = lane >> 5, qpos = qlo + (r32 >> 2);
        const int vb0 = (int)(uintptr_t)(lds + L_V) + v_rd_base(lane);
        const KvOff ko = kv_dma_off(tid, LD);
        const bf16_t* Kg = proj + (size_t)(b * T) * LD + OC_KWIN + g * 128;
        const bf16_t* Vg = proj + (size_t)(b * T) * LD + OC_VWIN + g * 128;
        m_reg = -1e30f; l_reg = 0.f; f32x16 o[4] = {};
        const int jt0 = (qb >= 8 ? qb - 8 : 0), nT = qb - jt0 + 1;
#define WIN_ISSUE(k_) kv_dma(lds + ((k_) & 3) * KVBUF, Kg + (size_t)((jt0 + (k_)) * 64) * LD, Vg + (size_t)((jt0 + (k_)) * 64) * LD, LD, ko, wid)
        __syncthreads();
        int kb = 0;
        dual_attn<4, 4>(nT, wid, lds, vb0, qr, o, m_reg, l_reg, al_l, r32, hi,
            [&](int k) { WIN_ISSUE(k); },
            [&](int s) { kb = (jt0 + s) * 64; return kb <= qhi && kb + 63 >= qlo - 511; },
            [&](int, f32x16& p0, f32x16& p1) {
                const int dq = qpos - kb - 4 * hi;
                if (qlo - kb >= 190 && qhi - kb <= 511) {
                    const float tc = tb[127];
#pragma unroll
                    for (int r = 0; r < 16; ++r) { p0[r] += tc; p1[r] += tc; }
                } else {
#pragma unroll
                for (int r = 0; r < 16; ++r) { const int c = (r & 3) + 8 * (r >> 2); const int d0_ = dq - c, d1_ = dq - c - 32;
                    float t0 = tb[min(max(d0_, 0), 127)], t1 = tb[min(max(d1_, 0), 127)];
                    asm("" : "+v"(t0), "+v"(t1));
                    p0[r] = ((unsigned)d0_ < 512u) ? p0[r] + t0 : NEG; p1[r] = ((unsigned)d1_ < 512u) ? p1[r] + t1 : NEG; }
                }
            });
#undef WIN_ISSUE
        float rs[16]; lanes_to_rows(l_reg > 0.f ? NSA_GATE(2) * __builtin_amdgcn_rcpf(l_reg) : 0.f, rs, al_l, r32, hi);
        branch_out<2>(o, rs, accw, mix + (size_t)(b * T + qlo) * D + g * 512, D, r32, hi);
    }
#undef NSA_GATE
#undef gate01_
#undef gate2_
}

__device__ __forceinline__ void odd_attn_phase(const Frame& F, const bf16_t* __restrict__ proj, bf16_t* __restrict__ mix, const float* __restrict__ relb, const float* __restrict__ gnorm, unsigned* __restrict__ qhead) {
    for (int bh = F.bid; bh < NB * 8; bh += F.G) gdn::scan_item(F, bh, proj, mix, gnorm);
    LAS int* qi = (LAS int*)(F.lds + L_QI);
    __syncthreads();
    for (int i = opaque_tid(); i < 8 * 129; i += NTHR) { const int hd = i / 129, dist = i - hd * 129; ((LAS float*)(F.lds + L_TAB))[i] = relb[att::t5_bucket(dist < 128 ? dist : 127) * 8 + hd] * INV_SCALE; }
    for (;;) {
        __syncthreads();
        if (threadIdx.x == 0) *qi = (int)__hip_atomic_fetch_add(qhead, 1u, __ATOMIC_RELAXED, __HIP_MEMORY_SCOPE_AGENT);
        __syncthreads();
        const int item = __builtin_amdgcn_readfirstlane(*qi);
        if (item >= 1024) break;
        nsa_item(F, item, proj, mix, relb);
    }
    __syncthreads();
}
}

#define N_ODD_PHASES 5
#define odd_mixer_phases \
    PH_BEGIN { pg8::Gemm g{RES, (const bf16_t*)(ws + WS_W_OD_IN + j * SZ_W_OD_IN), M, OD_NP, D, D}; pg8::StaticOrder S; S.init(M, OD_NP, F.G, F.bid); \
               pg8::EpiProjOdd E{PROJ, OD_NP, (bf16_t*)(ws + WS_KCMP), (bf16_t*)(ws + WS_VCMP), RSTD}; pg8::gemm_phase(F.lds, g, S, E); } PH_END \
    PH_BEGIN { for (int kv = 0; kv < 2; ++kv) { \
                 { pg8::Gemm g{(const bf16_t*)(ws + (kv ? WS_VCMP : WS_KCMP)), (const bf16_t*)(ws + WS_W_C1 + (j * 2 + kv) * SZ_W_C1), 4096, 256, 4096, 2048}; \
                   pg8::StaticOrder S; S.init(4096, 256, F.G, (F.bid + F.G - 16 * kv) % F.G); \
                   pg8::EpiGeluBf16 E{(bf16_t*)(ws + WS_CHID) + (size_t)kv * 4096 * 256, 256, (const float*)(ws + WS_C1B) + (j * 2 + kv) * 32 * 256}; pg8::gemm_phase(F.lds, g, S, E); } \
                 asm volatile("s_waitcnt vmcnt(0)" ::: "memory"); __syncthreads();     \
                 { pg8::Gemm g{(const bf16_t*)(ws + WS_CHID) + (size_t)kv * 4096 * 256, (const bf16_t*)(ws + WS_W_C2 + (j * 2 + kv) * SZ_W_C2), 4096, 256, 256, 256}; \
                   pg8::StaticOrder S; S.init(4096, 256, F.G, (F.bid + F.G - 16 * kv) % F.G); \
                   pg8::EpiStoreBf16 E{(bf16_t*)(ws + WS_KC) + (size_t)kv * 4096 * 256, 256, nullptr}; pg8::gemm_phase(F.lds, g, S, E); } } \
               gdn::chunk_phase(F, PROJ, F.in[I_OD_CONVW] + (size_t)j * 4 * 3072, F.in[I_OD_ALOG] + j * 8, F.in[I_OD_DTB] + j * 8, F.ctl + CW_QUEUE + 64 * (2 + j)); } PH_END \
    PH_BEGIN nsa::odd_attn_phase(F, PROJ, HB, F.in[I_RELB], F.in[I_OD_GNORM] + j * 128, F.ctl + CW_QUEUE + 64 * j); PH_END \
    PH_BEGIN { pg8::Gemm g{HB, (const bf16_t*)(ws + WS_W_OD_OUT + j * SZ_W_OUT), M, D, D, D}; pg8::StaticOrder S; S.init(M, D, F.G, F.bid); \
               pg8::EpiAddRes E{RES, D}; pg8::gemm_phase(F.lds, g, S, E); } PH_END \
    PH_BEGIN rowstat_phase(F, RES, RSTD); PH_END
struct Args { const float* in[22]; float* out; unsigned char* ws; int ph_lo, ph_hi; };

#ifndef MIXERS
#define MIXERS 3
#endif

__global__ void __launch_bounds__(NTHR, 2) mega(Args args) {
    extern __shared__ __attribute__((aligned(16))) unsigned char lds_raw[];
    Frame F;
    F.lds = (LAS unsigned char*)lds_raw;
    F.G = gridDim.x; F.bid = blockIdx.x;
    F.in = (const float* const*)__builtin_amdgcn_kernarg_segment_ptr();
    F.out = args.out; F.ws = args.ws; F.ctl = (unsigned*)(args.ws + WS_CTL);
    const int lo = args.ph_lo, hi = args.ph_hi;
    volatile LAS unsigned* barw = (volatile LAS unsigned*)(F.lds + LDS_BARW);
    if (TID < 4) barw[TID] = 0u;
    __syncthreads();
    XcdBarrier bar; bar.bar = F.ctl + CW_BAR; bar.x = 0; bar.st = barw;
    if (hi - lo > 1) bar = xcd_barrier_post(F.ctl + CW_BAR, barw);
    int ph = 0;
#define PH_BEGIN if (lo <= ph && ph < hi) {
#define PH_END   if (ph + 1 < hi) xcd_barrier(bar); } ++ph;
    unsigned char* ws = F.ws;
    bf16_t* HB = (bf16_t*)F.out;
    bf16_t* RES = (bf16_t*)(ws + WS_RES);
    float* RSTD = F.out + (size_t)M * D / 2;
    bf16_t* PROJ = (bf16_t*)(ws + WS_PROJ);

    PH_BEGIN p0_prologue(F); PH_END
    PH_BEGIN rowstat_f_phase(F, RES, RSTD, (const bf16_t*)(ws + WS_W_EV_IN) + (size_t)EC_F * D, PROJ); PH_END

    for (int layer = 0; layer < 4; ++layer) {
        const int j = layer >> 1;
        if ((layer & 1) == 0) {
#if (MIXERS & 1)
            even_mixer_phases
#endif
        } else {
#if (MIXERS & 2)
            odd_mixer_phases
#endif
        }
        PH_BEGIN {
            pg8::Gemm g{RES, (const bf16_t*)(ws + WS_W_UP + layer * SZ_W_UP), M, FF2, D, D};
            pg8::StaticOrder S; S.init(M, FF2, F.G, F.bid);
            pg8::EpiFfnGate E{(bf16_t*)(ws + WS_ACT), F.in[I_F_CONVW] + (size_t)layer * 3 * FF, F.in[I_F_CONVB] + (size_t)layer * FF,
                              (float*)(ws + WS_TAIL), (float*)(ws + WS_HEADG), (float*)(ws + WS_HEADU), F.lds + 131072, RSTD};
            pg8::gemm_phase(F.lds, g, S, E);
        } PH_END
        PH_BEGIN
            ffn_fixup_phase(F, (bf16_t*)(ws + WS_ACT), (const float*)(ws + WS_TAIL), (const float*)(ws + WS_HEADG), (const float*)(ws + WS_HEADU),
                            F.in[I_F_CONVW] + (size_t)layer * 3 * FF, F.in[I_F_CONVB] + (size_t)layer * FF);
        PH_END
        PH_BEGIN {
            pg8::Gemm g{(const bf16_t*)(ws + WS_ACT), (const bf16_t*)(ws + WS_W_DN + layer * SZ_W_DN), M, D, FF, FF};
            pg8::StaticOrder S; S.init(M, D, F.G, F.bid);
            pg8::EpiAddRes E{RES, D};
            pg8::gemm_phase(F.lds, g, S, E);
        } PH_END
        if (layer == 1) { PH_BEGIN rowstat_f_phase(F, RES, RSTD, (const bf16_t*)(ws + WS_W_EV_IN + SZ_W_EV_IN) + (size_t)EC_F * D, PROJ); PH_END }
        else if (layer < 3) { PH_BEGIN rowstat_phase(F, RES, RSTD); PH_END }
        else { PH_BEGIN final_norm_phase(F, RES, F.out, F.in[I_NFIN]); PH_END }
    }
#undef PH_BEGIN
#undef PH_END
}

static int count_phases() {
    int ph = 2;
    for (int layer = 0; layer < 4; ++layer) {
        if ((layer & 1) == 0) { if (MIXERS & 1) ph += N_EVEN_PHASES; } else { if (MIXERS & 2) ph += N_ODD_PHASES; }
        ph += 3; ph += 1;
    }
    return ph;
}

#ifndef N_LAUNCH_MODE
#define N_LAUNCH_MODE 0
#endif

extern "C" void kernel_launch(void* const* d_in, const int* in_sizes, int n_in, void* d_out, int out_size, void* d_ws, size_t ws_size, hipStream_t stream) {
    static int grid = 0;
    if (grid == 0) {
        if (n_in != 22 || out_size != M * D || ws_size < WS_END) { fprintf(stderr, "kernel_launch: unexpected shapes (n_in %d out %d ws %zu need %zu)\n", n_in, out_size, ws_size, (size_t)WS_END); grid = -1; return; }
        int dev = 0, cus = 0, per_cu = 0;
        if (hipGetDevice(&dev) != hipSuccess || hipDeviceGetAttribute(&cus, hipDeviceAttributeMultiprocessorCount, dev) != hipSuccess) { grid = -1; return; }
        if (hipFuncSetAttribute((const void*)mega, hipFuncAttributeMaxDynamicSharedMemorySize, LDS_BYTES) != hipSuccess) { fprintf(stderr, "kernel_launch: hipFuncSetAttribute failed\n"); grid = -1; return; }
        if (hipOccupancyMaxActiveBlocksPerMultiprocessor(&per_cu, (const void*)mega, NTHR, LDS_BYTES) != hipSuccess || per_cu < 1) { fprintf(stderr, "kernel_launch: occupancy query says %d\n", per_cu); }
        (void)hipGetLastError();
        grid = cus;
    }
    if (grid < 0) return;
    (void)hipMemsetAsync((char*)d_ws + WS_CTL, 0, CTL_BYTES, stream);
    Args a{};
    for (int i = 0; i < 22; ++i) a.in[i] = (const float*)d_in[i];
    a.out = (float*)d_out; a.ws = (unsigned char*)d_ws;
    const int nph = count_phases();
#if N_LAUNCH_MODE == 1
    a.ph_lo = 0; a.ph_hi = nph;
    hipLaunchKernelGGL(mega, dim3(grid), dim3(NTHR), LDS_BYTES, stream, a);
#else
    for (int p = 0; p < nph; ++p) { a.ph_lo = p; a.ph_hi = p + 1; hipLaunchKernelGGL(mega, dim3(grid), dim3(NTHR), LDS_BYTES, stream, a); }
#endif
}
```

```cpp
#define MIXERS 3
#define N_LAUNCH_MODE 1
#include <hip/hip_runtime.h>
#include <cstdio>
#include <cstdint>

#define LAS __attribute__((address_space(3)))
typedef unsigned short bf16_t;
typedef short bf16x8 __attribute__((ext_vector_type(8)));
typedef short s16x4 __attribute__((ext_vector_type(4)));
typedef float f32x2 __attribute__((ext_vector_type(2)));
typedef float f32x4 __attribute__((ext_vector_type(4)));
typedef float f32x16 __attribute__((ext_vector_type(16)));
typedef unsigned u32x2 __attribute__((ext_vector_type(2)));
typedef unsigned u32x4 __attribute__((ext_vector_type(4)));

constexpr int NB = 8, T = 4096, M = NB * T, D = 2048, HD = 128;
constexpr int EV_N = 4616, EV_NP = 4864, OD_N = 6696, OD_NP = 6912, FF = 5632, FF2 = 11264;
constexpr int MH = M / 2;
constexpr int NTHR = 512, NWAVE = 8;
constexpr int LDS_BYTES = 159744;
constexpr int LDS_BARW = LDS_BYTES - 16;
constexpr float EPS = 1e-6f;
constexpr float SCALE = 0.08838834764831845f;
constexpr float INV_SCALE = 11.313708498984761f;
constexpr float LOG2E = 1.4426950408889634f;

constexpr int EC_QA = 0, EC_QB = 1024, EC_KA = 2048, EC_VA = 2304, EC_KB = 2560, EC_VB = 3584, EC_F = 4608;
constexpr int OC_QC = 0, OC_QD = 1024, OC_KCMP = 2048, OC_VCMP = 2304, OC_KSEL = 2560, OC_VSEL = 2816, OC_KWIN = 3072, OC_VWIN = 3328,
              OC_KD = 3584, OC_VD = 4608, OC_Z = 5632, OC_GATE = 6656, OC_BETA = 6680, OC_A = 6688;

__host__ __device__ inline int ev_src(int n) {
    if (n < 1024) return n;
    if (n < 2048) return n - 1024 + 1536;
    if (n < 2304) return n - 2048 + 1024;
    if (n < 2560) return n - 2304 + 1280;
    if (n < 3584) return n - 2560 + 2560;
    if (n < 4608) return n - 3584 + 3584;
    if (n < 4616) return n;
    return -1;
}
__host__ __device__ inline int od_src(int n) {
    if (n < 1024) return n;
    if (n < 2048) return n - 1024 + 2584;
    if (n < 3584) return n - 2048 + 1024;
    if (n < 4608) return n - 3584 + 3608;
    if (n < 5632) return n - 4608 + 4632;
    if (n < 6656) return n - 5632 + 5672;
    if (n < 6680) return n - 6656 + 2560;
    if (n < 6688) return n - 6680 + 5656;
    if (n < 6696) return n - 6688 + 5664;
    return -1;
}

constexpr size_t al256(size_t x) { return (x + 255) & ~(size_t)255; }
constexpr size_t WS_CTL = 0, CTL_BYTES = 65536;
constexpr size_t SZ_W_EV_IN = (size_t)EV_NP * D * 2, SZ_W_OUT = (size_t)D * D * 2, SZ_W_OD_IN = (size_t)OD_NP * D * 2,
                 SZ_W_UP = (size_t)FF2 * D * 2, SZ_W_DN = (size_t)D * FF * 2, SZ_W_C1 = (size_t)256 * 4096 * 2, SZ_W_C2 = (size_t)256 * 256 * 2;
constexpr size_t WS_W_EV_IN = WS_CTL + CTL_BYTES;
constexpr size_t WS_W_EV_OUT = WS_W_EV_IN + 2 * SZ_W_EV_IN;
constexpr size_t WS_W_OD_IN = WS_W_EV_OUT + 2 * SZ_W_OUT;
constexpr size_t WS_W_OD_OUT = WS_W_OD_IN + 2 * SZ_W_OD_IN;
constexpr size_t WS_W_UP = WS_W_OD_OUT + 2 * SZ_W_OUT;
constexpr size_t WS_W_DN = WS_W_UP + 4 * SZ_W_UP;
constexpr size_t WS_W_C1 = WS_W_DN + 4 * SZ_W_DN;
constexpr size_t WS_W_C2 = WS_W_C1 + 4 * SZ_W_C1;
constexpr size_t WS_C1B = WS_W_C2 + 4 * SZ_W_C2;
constexpr size_t WS_HB = WS_C1B + 131072;
constexpr size_t WS_RES = WS_HB;
constexpr size_t SZ_HB = (size_t)M * D * 2;
constexpr size_t WS_R = WS_HB + SZ_HB;
constexpr size_t SZ_PROJ = (size_t)M * OD_NP * 2;
constexpr size_t WS_PROJ = WS_R;
constexpr size_t WS_R2 = WS_R + SZ_PROJ;
constexpr size_t WS_CF = WS_R2;
constexpr size_t SZ_CMPBUF = (size_t)(16 * T + 64) * 128 * 2;
constexpr size_t WS_KCMP = WS_R2, WS_VCMP = al256(WS_KCMP + SZ_CMPBUF);
constexpr int NCHUNK = NB * 8 * (T / 64);
constexpr size_t SZ_G16 = (size_t)NCHUNK * 64 * 128 * 2;
constexpr size_t WS_G_U = al256(WS_VCMP + SZ_CMPBUF), WS_G_W = WS_G_U + SZ_G16, WS_G_QG = WS_G_W + SZ_G16, WS_G_KT = WS_G_QG + SZ_G16;
constexpr size_t WS_G_ATT = WS_G_KT + SZ_G16;
constexpr size_t WS_G_GL = WS_G_ATT + (size_t)NCHUNK * 64 * 64 * 2;
constexpr size_t WS_CHID = al256(WS_G_GL + (size_t)NCHUNK * 4);
constexpr size_t WS_KC = WS_CHID + (size_t)2 * 4096 * 256 * 2;
constexpr size_t WS_NSAACC = WS_KC + (size_t)2 * 4096 * 256 * 2;
constexpr size_t WS_R_END_ODD = WS_NSAACC + (size_t)256 * 256 * 128 * 4;
constexpr size_t SZ_HALO = (size_t)(M / 256) * 2 * FF * 4;
constexpr size_t WS_ACT = WS_R, WS_TAIL = WS_ACT + (size_t)M * FF * 2, WS_HEADG = WS_TAIL + SZ_HALO, WS_HEADU = WS_HEADG + SZ_HALO, WS_R_END_FFN = WS_HEADU + SZ_HALO;
constexpr size_t WS_END = (WS_R_END_ODD > WS_R_END_FFN ? WS_R_END_ODD : WS_R_END_FFN);

constexpr int CW_BAR = 0;
constexpr int CW_QUEUE = 4096;
constexpr int CW_NORM = 8192;

typedef __bf16 bf16v2_ __attribute__((ext_vector_type(2)));
__device__ __forceinline__ unsigned cvt_pk_bf16(float lo, float hi) { const f32x2 v = {lo, hi}; const bf16v2_ r = __builtin_convertvector(v, bf16v2_); return __builtin_bit_cast(unsigned, r); }
__device__ __forceinline__ bf16_t f2bf(float f) { return (bf16_t)(cvt_pk_bf16(f, 0.f) & 0xffffu); }
__device__ __forceinline__ float bf2f(bf16_t b) { return __uint_as_float(((unsigned)b) << 16); }
__device__ __forceinline__ float bflo(unsigned w) { return __uint_as_float(w << 16); }
__device__ __forceinline__ float bfhi(unsigned w) { return __uint_as_float(w & 0xffff0000u); }
__device__ __forceinline__ int opaque_tid() { int t = threadIdx.x; asm volatile("" : "+v"(t)); return t; }
__device__ __forceinline__ int olane() { return opaque_tid() & 63; }
__device__ __forceinline__ float shx(float v, int m) { return __builtin_bit_cast(float, __builtin_amdgcn_ds_bpermute((olane() ^ m) << 2, __builtin_bit_cast(int, v))); }
__device__ __forceinline__ unsigned shx(unsigned v, int m) { return (unsigned)__builtin_amdgcn_ds_bpermute((olane() ^ m) << 2, (int)v); }
__device__ __forceinline__ float shu(float v, int d) { const int l = olane(), s = l - d; return __builtin_bit_cast(float, __builtin_amdgcn_ds_bpermute((s < 0 ? l : s) << 2, __builtin_bit_cast(int, v))); }
#define DPPF(x, ctrl) __builtin_bit_cast(float, __builtin_amdgcn_update_dpp(0, __builtin_bit_cast(int, (x)), (ctrl), 0xf, 0xf, true))
__device__ __forceinline__ float row16_sum(float x) { x += DPPF(x, 0x128); x += DPPF(x, 0x124); x += DPPF(x, 0x122); x += DPPF(x, 0x121); return x; }
__device__ __forceinline__ float row8_sum(float x) { x += DPPF(x, 0xB1); x += DPPF(x, 0x4E); x += DPPF(x, 0x141); return x; }
__device__ __forceinline__ float wave_sum(float v) { v = row16_sum(v); v += shx(v, 16); v += shx(v, 32); return v; }
__device__ __forceinline__ float sigmoidf_(float x) { return __builtin_amdgcn_rcpf(1.f + __expf(-x)); }
__device__ __forceinline__ float siluf_(float x) { return x * __builtin_amdgcn_rcpf(1.f + __expf(-x)); }

#define XB_TMO      128
#define XB_XCNT(j)  (256  + 64 * (j))
#define XB_XSUB(j)  (1280 + 64 * (j))
#define XB_XGEN(j)  (2304 + 64 * (j))
#define XB_TOP      3328
#define XB_TOPGEN   3392
#define XCD_BAR_WORDS 3456
#define XB_SPIN_CAP (1u << 24)

__device__ __forceinline__ unsigned xb_ld(unsigned* p)              { return __hip_atomic_load(p, __ATOMIC_RELAXED, __HIP_MEMORY_SCOPE_AGENT); }
__device__ __forceinline__ unsigned xb_add(unsigned* p, unsigned v) { return __hip_atomic_fetch_add(p, v, __ATOMIC_RELAXED, __HIP_MEMORY_SCOPE_AGENT); }
__device__ __forceinline__ unsigned xb_xcc_id() { return (unsigned)__builtin_amdgcn_s_getreg((3 << 11) | 20) & 0xFu; }
#define XB_SPIN(cond, bar) do { unsigned _sp = 0; while (cond) { __builtin_amdgcn_s_sleep(1); \
    if ((++_sp & 255u) == 0u) { if (xb_ld(&(bar)[XB_TMO])) break; if (_sp > XB_SPIN_CAP) { atomicAdd(&(bar)[XB_TMO], 1u); break; } } } } while (0)

struct XcdBarrier { unsigned* bar; unsigned x; volatile LAS unsigned* st; };

__device__ __forceinline__ XcdBarrier xcd_barrier_post(unsigned* bar, volatile LAS unsigned* st) {
    XcdBarrier b; b.bar = bar; b.x = xb_xcc_id(); b.st = st;
    if (threadIdx.x == 0) (void)xb_add(&bar[XB_XCNT(b.x)], 1u);
    return b;
}
__device__ __forceinline__ void xcd_barrier_complete(unsigned* bar, unsigned x, unsigned& nloc, unsigned& nx) {
    const unsigned G = gridDim.x * gridDim.y * gridDim.z;
    unsigned sum, cnt, mine, sp = 0u;
    for (;;) {
        sum = 0u; cnt = 0u; mine = 0u;
#pragma unroll
        for (unsigned j = 0; j < 16; ++j) { const unsigned c = xb_ld(&bar[XB_XCNT(j)]); sum += c; cnt += (c > 0u) ? 1u : 0u; mine = (j == x) ? c : mine; }
        if (sum == G) break;
        __builtin_amdgcn_s_sleep(1);
        if ((++sp & 255u) == 0u) { if (xb_ld(&bar[XB_TMO])) break; if (sp > XB_SPIN_CAP) { atomicAdd(&bar[XB_TMO], 1u); break; } }
    }
    nloc = mine > 0u ? mine : 1u; nx = cnt > 0u ? cnt : 1u;
}
__device__ __forceinline__ void xcd_barrier(const XcdBarrier& b) {
    asm volatile("s_waitcnt vmcnt(0)" ::: "memory");
    __syncthreads();
    if (threadIdx.x == 0) {
        unsigned* bar = b.bar;
        __builtin_amdgcn_s_waitcnt(0);
        unsigned nloc = b.st[0], nx = b.st[1];
        if (nloc == 0u) { xcd_barrier_complete(bar, b.x, nloc, nx); b.st[0] = nloc; b.st[1] = nx; }
        const unsigned old = xb_add(&bar[XB_XSUB(b.x)], 1u);
        const unsigned gen = old / nloc;
        if (old + 1u == (gen + 1u) * nloc) {
            __builtin_amdgcn_fence(__ATOMIC_RELEASE, "agent");
            asm volatile("s_waitcnt vmcnt(0)" ::: "memory");
            const unsigned og = xb_add(&bar[XB_TOP], 1u);
            const unsigned tg = og / nx;
            if (og + 1u == (tg + 1u) * nx) xb_add(&bar[XB_TOPGEN], 1u);
            else XB_SPIN(xb_ld(&bar[XB_TOPGEN]) == tg, bar);
            __builtin_amdgcn_fence(__ATOMIC_ACQUIRE, "agent");
            xb_add(&bar[XB_XGEN(b.x)], 1u);
            asm volatile("s_waitcnt vmcnt(0)" ::: "memory");
        } else {
            XB_SPIN(xb_ld(&bar[XB_XGEN(b.x)]) == gen, bar);
            __builtin_amdgcn_fence(__ATOMIC_ACQUIRE, "agent");
            asm volatile("s_waitcnt vmcnt(0)" ::: "memory");
        }
    }
    __syncthreads();
}

namespace pg8 {
constexpr int BM = 256, BK = 64, HALF = 128, HTB = HALF * BK * 2, STAGE_BYTES = 8 * HTB, NXCD = 8, WGM = 4;
__host__ __device__ __forceinline__ int lds_byte(int r, int c) { const int st = (r >> 4) * 2 + (c >> 5), rr = r & 15, cc = c & 31, ob = rr * 64 + cc * 2; return st * 1024 + (ob ^ (((ob >> 9) & 1) << 5)); }
__host__ __device__ __forceinline__ void stage_rc(int b, int& R, int& C) { const int st = b / 1024, sb = b % 1024, swz = sb ^ (((sb >> 9) & 1) << 5); R = (st >> 1) * 16 + swz / 64; C = (st & 1) * 32 + (swz % 64) / 2; }
__host__ __device__ __forceinline__ int perm32(int rho) { const int n = rho >> 4, i = rho & 15; return 8 * (i >> 2) + 4 * n + (i & 3); }

struct Unit { int pm, pn; };
struct Gemm { const bf16_t* A; const bf16_t* Bt; int M, N, K, lda; };

struct StaticOrder {
    int nM, nN, nwg, G, c;
    __host__ __device__ void init(int M_, int N_, int G_, int c_) { nM = M_ / BM; nN = N_ / BM; nwg = nM * nN; G = G_; c = c_; }
    __host__ __device__ bool next(int i, Unit& u) const {
        const long L = (long)i * G + c; if (L >= nwg) return false;
        int wgid = (int)L; { const int q = nwg / NXCD, r = nwg % NXCD, xcd = wgid % NXCD, off = wgid / NXCD; wgid = (xcd < r ? xcd * (q + 1) : r * (q + 1) + (xcd - r) * q) + off; }
        const int nig = WGM * nN, gid = wgid / nig, fm = gid * WGM, gsz = (nM - fm) < WGM ? (nM - fm) : WGM;
        u.pm = fm + ((wgid % nig) % gsz); u.pn = (wgid % nig) / gsz; return true;
    }
    __device__ __forceinline__ void a_ready(const Unit&) const {}
    __device__ __forceinline__ void done(const Unit&) const {}
};

constexpr int L_RSPF = 131072 + 4096;
__device__ __forceinline__ void rs_prefetch(const float* rs, int pm, int ui) {
    const int t = opaque_tid(), w = __builtin_amdgcn_readfirstlane(t >> 6);
    extern __shared__ __attribute__((aligned(16))) unsigned char lds_dyn_[];
    if (w < 4) __builtin_amdgcn_global_load_lds((const unsigned*)(rs + pm * BM + t), (LAS unsigned*)((LAS unsigned char*)lds_dyn_ + L_RSPF + (ui & 1) * 1024 + w * 256), 4, 0, 0);
}
__device__ __forceinline__ void rs_read(float (&r_)[2][4], int ui, int wr, int fr) {
    extern __shared__ __attribute__((aligned(16))) unsigned char lds_dyn_[];
    const LAS float* rl = (const LAS float*)((LAS unsigned char*)lds_dyn_ + L_RSPF + (ui & 1) * 1024) + wr * 64 + fr;
#pragma unroll
    for (int ai = 0; ai < 2; ++ai)
#pragma unroll
        for (int m = 0; m < 4; ++m) r_[ai][m] = rl[ai * HALF + m * 16];
}
struct EpiStoreBf16 {
    static constexpr bool PERM = true;
    bf16_t* O; int ldc; const float* rs;
    __device__ __forceinline__ void prefetch(const Unit& u, int ui) const { if (rs) rs_prefetch(rs, u.pm, ui); }
    __device__ __forceinline__ void operator()(const f32x4 (&acc)[2][2][4][2], const Unit& u, int wr, int wc, int ui, int) const {
        const int ol_ = opaque_tid() & 63, fr = ol_ & 15, fq = ol_ >> 4;
        const int row0 = u.pm * BM + wr * 64 + fr, col0 = u.pn * BM + wc * 32 + 8 * fq;
        float r_[2][4];
        if (rs) rs_read(r_, ui, wr, fr);
        else {
#pragma unroll
            for (int ai = 0; ai < 2; ++ai)
#pragma unroll
                for (int m = 0; m < 4; ++m) r_[ai][m] = 1.f;
        }
#pragma unroll
        for (int ai = 0; ai < 2; ++ai)
#pragma unroll
            for (int m = 0; m < 4; ++m) { bf16_t* rowp = O + (size_t)(row0 + ai * HALF + m * 16) * ldc + col0; const float r = r_[ai][m];
#pragma unroll
                for (int bj = 0; bj < 2; ++bj) { const f32x4 v0 = acc[ai][bj][m][0] * r, v1 = acc[ai][bj][m][1] * r;
                    u32x4 w; w.x = cvt_pk_bf16(v0[0], v0[1]); w.y = cvt_pk_bf16(v0[2], v0[3]); w.z = cvt_pk_bf16(v1[0], v1[1]); w.w = cvt_pk_bf16(v1[2], v1[3]);
                    *(u32x4*)(rowp + bj * HALF) = w; } }
    }
};
struct EpiAddRes {
    static constexpr bool PERM = true;
    bf16_t* C; int ldc;
    __device__ __forceinline__ void prefetch(const Unit&, int) const {}
    __device__ __forceinline__ void operator()(const f32x4 (&acc)[2][2][4][2], const Unit& u, int wr, int wc, int, int) const {
        const int ol_ = opaque_tid() & 63, fr = ol_ & 15, fq = ol_ >> 4;
        const int row0 = u.pm * BM + wr * 64 + fr, col0 = u.pn * BM + wc * 32 + 8 * fq;
        u32x4 cin[2][4][2];
#pragma unroll
        for (int ai = 0; ai < 2; ++ai)
#pragma unroll
            for (int m = 0; m < 4; ++m)
#pragma unroll
                for (int bj = 0; bj < 2; ++bj) cin[ai][m][bj] = *(const u32x4*)(C + (size_t)(row0 + ai * HALF + m * 16) * ldc + col0 + bj * HALF);
#pragma unroll
        for (int ai = 0; ai < 2; ++ai)
#pragma unroll
            for (int m = 0; m < 4; ++m)
#pragma unroll
                for (int bj = 0; bj < 2; ++bj) { const u32x4 c = cin[ai][m][bj]; const f32x4 v0 = acc[ai][bj][m][0], v1 = acc[ai][bj][m][1];
                    u32x4 w; w.x = cvt_pk_bf16(bflo(c.x) + v0[0], bfhi(c.x) + v0[1]); w.y = cvt_pk_bf16(bflo(c.y) + v0[2], bfhi(c.y) + v0[3]);
                    w.z = cvt_pk_bf16(bflo(c.z) + v1[0], bfhi(c.z) + v1[1]); w.w = cvt_pk_bf16(bflo(c.w) + v1[2], bfhi(c.w) + v1[3]);
                    *(u32x4*)(C + (size_t)(row0 + ai * HALF + m * 16) * ldc + col0 + bj * HALF) = w; }
    }
};
struct EpiFfnGate {
    static constexpr bool PERM = true;
    bf16_t* act; const float* cw; const float* cb; float* tail; float* headg; float* headu; LAS unsigned char* hl; const float* rs;
    __device__ __forceinline__ void prefetch(const Unit& u, int ui) const { rs_prefetch(rs, u.pm, ui); }
    __device__ __forceinline__ void operator()(f32x4 (&acc)[2][2][4][2], const Unit& u, int wr, int wc, int ui, int) const {
        const int ol_ = opaque_tid() & 63, fr = ol_ & 15, fq = ol_ >> 4;
        { float r_[2][4];
          rs_read(r_, ui, wr, fr);
#pragma unroll
          for (int ai = 0; ai < 2; ++ai)
#pragma unroll
              for (int bj = 0; bj < 2; ++bj)
#pragma unroll
                  for (int m = 0; m < 4; ++m) { acc[ai][bj][m][0] *= r_[ai][m]; acc[ai][bj][m][1] *= r_[ai][m]; } }
        const int col = u.pn * 128 + wc * 32 + 8 * fq;
        if (fr >= 14) {
#pragma unroll
            for (int ai = 0; ai < 2; ++ai) { LAS f32x4* s = (LAS f32x4*)(hl + ((((ai * 2 + wr) * 4 + wc) * 8 + fq * 2 + (fr - 14)) * 32));
                s[0] = acc[ai][1][3][0]; s[1] = acc[ai][1][3][1]; }
        }
        asm volatile("s_waitcnt lgkmcnt(0)" ::: "memory"); __builtin_amdgcn_s_barrier(); asm volatile("" ::: "memory");
        __builtin_amdgcn_s_barrier(); asm volatile("" ::: "memory");
        float w0[8], w1[8], w2[8], bb[8];
        { const f32x4 a0 = *(const f32x4*)(cw + col), a1 = *(const f32x4*)(cw + col + 4), b0 = *(const f32x4*)(cw + FF + col), b1 = *(const f32x4*)(cw + FF + col + 4),
                      c0 = *(const f32x4*)(cw + 2 * FF + col), c1 = *(const f32x4*)(cw + 2 * FF + col + 4), d0 = *(const f32x4*)(cb + col), d1 = *(const f32x4*)(cb + col + 4);
#pragma unroll
          for (int e = 0; e < 4; ++e) { w0[e] = a0[e] * -LOG2E; w0[4 + e] = a1[e] * -LOG2E; w1[e] = b0[e] * -LOG2E; w1[4 + e] = b1[e] * -LOG2E; w2[e] = c0[e] * -LOG2E; w2[4 + e] = c1[e] * -LOG2E; bb[e] = d0[e] * -LOG2E; bb[4 + e] = d1[e] * -LOG2E; } }
#pragma unroll
        for (int ai = 0; ai < 2; ++ai) {
            f32x4 hal[2] = {(f32x4){0.f, 0.f, 0.f, 0.f}, (f32x4){0.f, 0.f, 0.f, 0.f}};
            if (!(ai == 0 && wr == 0) && fr >= 14) {
                const int sai = (wr == 1) ? ai : 0, swr = (wr == 1) ? 0 : 1;
                const LAS f32x4* s = (const LAS f32x4*)(hl + ((((sai * 2 + swr) * 4 + wc) * 8 + fq * 2 + (fr - 14)) * 32));
                hal[0] = s[0]; hal[1] = s[1];
            }
#pragma unroll
            for (int m = 0; m < 4; ++m) {
                const int row = u.pm * BM + ai * HALF + wr * 64 + m * 16 + fr;
                float o[8], z[8], g1[8], g2[8];
#pragma unroll
                for (int k = 0; k < 8; ++k) { const int n = k >> 2, e = k & 3;
                    const float gc = acc[ai][1][m][n][e], gp = (m == 0) ? hal[n][e] : acc[ai][1][m - 1][n][e];
                    const int gci = __builtin_bit_cast(int, gc), gpi = __builtin_bit_cast(int, gp);
                    const int r1 = __builtin_amdgcn_update_dpp(0, gpi, 0x121, 0xf, 0xf, true), r2 = __builtin_amdgcn_update_dpp(0, gpi, 0x122, 0xf, 0xf, true);
                    g1[k] = __builtin_bit_cast(float, __builtin_amdgcn_update_dpp(r1, gci, 0x111, 0xf, 0xf, false));
                    g2[k] = __builtin_bit_cast(float, __builtin_amdgcn_update_dpp(r2, gci, 0x112, 0xf, 0xf, false)); }
#pragma unroll
                for (int k = 0; k < 8; ++k) z[k] = w0[k] * g2[k] + bb[k];
#pragma unroll
                for (int k = 0; k < 8; ++k) z[k] += w1[k] * g1[k];
#pragma unroll
                for (int k = 0; k < 8; ++k) z[k] += w2[k] * acc[ai][1][m][k >> 2][k & 3];
#pragma unroll
                for (int k = 0; k < 8; ++k) o[k] = __builtin_amdgcn_exp2f(z[k]);
#pragma unroll
                for (int k = 0; k < 8; ++k) o[k] += 1.f;
#pragma unroll
                for (int k = 0; k < 8; ++k) o[k] = __builtin_amdgcn_rcpf(o[k]);
#pragma unroll
                for (int k = 0; k < 8; ++k) z[k] *= acc[ai][0][m][k >> 2][k & 3];
#pragma unroll
                for (int k = 0; k < 8; ++k) o[k] *= z[k];
                u32x4 w; w.x = cvt_pk_bf16(o[0], o[1]); w.y = cvt_pk_bf16(o[2], o[3]); w.z = cvt_pk_bf16(o[4], o[5]); w.w = cvt_pk_bf16(o[6], o[7]);
                *(u32x4*)(act + (size_t)row * FF + col) = w;
            }
        }
        if (wr == 1 && fr >= 14) { float* t = tail + ((size_t)u.pm * 2 + (fr - 14)) * FF + col; *(f32x4*)t = acc[1][1][3][0]; *(f32x4*)(t + 4) = acc[1][1][3][1]; }
        if (wr == 0 && fr < 2) { float* hg = headg + ((size_t)u.pm * 2 + fr) * FF + col; *(f32x4*)hg = acc[0][1][0][0]; *(f32x4*)(hg + 4) = acc[0][1][0][1];
                                 float* hu = headu + ((size_t)u.pm * 2 + fr) * FF + col; *(f32x4*)hu = acc[0][0][0][0]; *(f32x4*)(hu + 4) = acc[0][0][0][1]; }
    }
};

template <class Epi, class Sched>
__device__ __forceinline__ void gemm_phase(LAS unsigned char* lds, const Gemm g, const Sched& S, const Epi& E) {
    const int tid = opaque_tid(), wid = __builtin_amdgcn_readfirstlane(tid >> 6), lane = tid & 63, wr = wid >> 2, wc = wid & 3, fr = lane & 15, fq = lane >> 4;
    const int K = g.K, nt = K / BK, lda = g.lda;
    unsigned voffA[2], voffB[2];
#pragma unroll
    for (int i = 0; i < 2; ++i) { int R, C; stage_rc(tid * 16 + i * 8192, R, C); const int Rb = Epi::PERM ? ((R & ~31) + perm32(R & 31)) : R;
        voffA[i] = (unsigned)(R * lda + C) * 2u; voffB[i] = (unsigned)(Rb * K + C) * 2u; }
    const size_t kstep = (size_t)(BK * 2);
    const size_t hstepA = (size_t)HALF * lda * 2, hstepB = (size_t)HALF * K * 2;
    const size_t tstepA = 2 * hstepA, tstepB = 2 * hstepB;
    const unsigned ldsw = (unsigned)wid * 1024u;
    const int aoff = lds_byte(wr * 64 + fr, fq * 8), boff = lds_byte(wc * 32 + fr, fq * 8);
#define PG8_SA(b, h) (((b) * 2 + (h)) * HTB)
#define PG8_SB(b, h) ((4 + (b) * 2 + (h)) * HTB)
#define PG8_STAGE(bufoff, gbase, voff) do { _Pragma("unroll") for (int _i = 0; _i < 2; ++_i) \
        __builtin_amdgcn_global_load_lds((const unsigned*)((const char*)(gbase) + (voff)[_i]), (LAS unsigned*)(lds + (bufoff) + ldsw + _i * 8192), 16, 0, 0); } while (0)
#define PG8_LDA(dst, b, h) do { _Pragma("unroll") for (int m = 0; m < 4; ++m) _Pragma("unroll") for (int k = 0; k < 2; ++k) dst[m][k] = *(const LAS bf16x8*)(lds + PG8_SA(b, h) + aoff + m * 2048 + k * 1024); } while (0)
#define PG8_LDB(dst, b, h) do { _Pragma("unroll") for (int n = 0; n < 2; ++n) _Pragma("unroll") for (int k = 0; k < 2; ++k) dst[n][k] = *(const LAS bf16x8*)(lds + PG8_SB(b, h) + boff + n * 2048 + k * 1024); } while (0)
#define PG8_MMA(ai, bj, At, Bt) do { __builtin_amdgcn_s_setprio(1); _Pragma("unroll") for (int m = 0; m < 4; ++m) _Pragma("unroll") for (int n = 0; n < 2; ++n) _Pragma("unroll") for (int k = 0; k < 2; ++k) \
        acc[ai][bj][m][n] = __builtin_amdgcn_mfma_f32_16x16x32_bf16(Bt[n][k], At[m][k], acc[ai][bj][m][n], 0, 0, 0); __builtin_amdgcn_s_setprio(0); } while (0)
#define PG8_WAIT_V(n) asm volatile("s_waitcnt vmcnt(" #n ")" ::: "memory")
#define PG8_WAIT_L(n) asm volatile("s_waitcnt lgkmcnt(" #n ")" ::: "memory")
#define PG8_BAR __builtin_amdgcn_s_barrier()
#define PG8_SCHED __builtin_amdgcn_sched_barrier(0)
    Unit cur, nxt; int ui = 0;
    if (!S.next(0, cur)) return;
    f32x4 acc[2][2][4][2];
#pragma unroll
    for (int a = 0; a < 2; ++a)
#pragma unroll
        for (int b = 0; b < 2; ++b)
#pragma unroll
            for (int m = 0; m < 4; ++m)
#pragma unroll
                for (int n = 0; n < 2; ++n) acc[a][b][m][n] = (f32x4){0.f, 0.f, 0.f, 0.f};
    bf16x8 At[4][2], B0[2][2], B1[2][2];
    const char* cA = (const char*)g.A + (size_t)cur.pm * tstepA; const char* cB = (const char*)g.Bt + (size_t)cur.pn * tstepB;
    S.a_ready(cur);
    PG8_STAGE(PG8_SB(0, 0), cB, voffB); PG8_STAGE(PG8_SA(0, 0), cA, voffA); PG8_STAGE(PG8_SB(0, 1), cB + hstepB, voffB); PG8_STAGE(PG8_SA(0, 1), cA + hstepA, voffA);
    if (wr == 1) PG8_BAR;
    PG8_WAIT_V(4); PG8_BAR;
    PG8_STAGE(PG8_SB(1, 0), cB + kstep, voffB); PG8_STAGE(PG8_SA(1, 0), cA + kstep, voffA); PG8_STAGE(PG8_SB(1, 1), cB + hstepB + kstep, voffB);
    PG8_WAIT_V(6); PG8_BAR;
    for (;;) {
        E.prefetch(cur, ui);
        const bool has_next = S.next(ui + 1, nxt);
        const char* nA = has_next ? (const char*)g.A + (size_t)nxt.pm * tstepA : cA; const char* nB = has_next ? (const char*)g.Bt + (size_t)nxt.pn * tstepB : cB;
        for (int t = 0; t < nt; t += 2) {
            const bool last = (t == nt - 2);
            const char* a1 = cA + (size_t)(t + 1) * kstep;
            const char* a2 = last ? nA : cA + (size_t)(t + 2) * kstep; const char* b2 = last ? nB : cB + (size_t)(t + 2) * kstep;
            const char* a3 = a2 + kstep; const char* b3 = b2 + kstep;
            if (last && has_next) S.a_ready(nxt);
            PG8_LDB(B0, 0, 0); PG8_SCHED; PG8_LDA(At, 0, 0); PG8_STAGE(PG8_SA(1, 1), a1 + hstepA, voffA);
            PG8_WAIT_L(8); PG8_BAR; PG8_WAIT_L(0); PG8_MMA(0, 0, At, B0); PG8_BAR; PG8_SCHED;
            PG8_LDB(B1, 0, 1); PG8_STAGE(PG8_SB(0, 0), b2, voffB);
            PG8_BAR; PG8_WAIT_L(0); PG8_MMA(0, 1, At, B1); PG8_BAR;
            PG8_LDA(At, 0, 1); PG8_STAGE(PG8_SA(0, 0), a2, voffA);
            PG8_BAR; PG8_WAIT_L(0); PG8_MMA(1, 0, At, B0); PG8_BAR; PG8_SCHED;
            PG8_STAGE(PG8_SB(0, 1), b2 + hstepB, voffB);
            PG8_WAIT_V(6); PG8_BAR; PG8_MMA(1, 1, At, B1); PG8_BAR;
            PG8_LDB(B0, 1, 0); PG8_SCHED; PG8_LDA(At, 1, 0); PG8_STAGE(PG8_SA(0, 1), a2 + hstepA, voffA);
            PG8_WAIT_L(8); PG8_BAR; PG8_WAIT_L(0); PG8_MMA(0, 0, At, B0); PG8_BAR; PG8_SCHED;
            PG8_LDB(B1, 1, 1); PG8_STAGE(PG8_SB(1, 0), b3, voffB);
            PG8_BAR; PG8_WAIT_L(0); PG8_MMA(0, 1, At, B1); PG8_BAR;
            PG8_LDA(At, 1, 1); PG8_STAGE(PG8_SA(1, 0), a3, voffA);
            PG8_BAR; PG8_WAIT_L(0); PG8_MMA(1, 0, At, B0); PG8_BAR; PG8_SCHED;
            PG8_STAGE(PG8_SB(1, 1), b3 + hstepB, voffB);
            PG8_WAIT_V(6); PG8_BAR; PG8_MMA(1, 1, At, B1); PG8_BAR;
        }
        E(acc, cur, wr, wc, ui, fq);
        S.done(cur);
        if (!has_next) break;
#pragma unroll
        for (int a = 0; a < 2; ++a)
#pragma unroll
            for (int b = 0; b < 2; ++b)
#pragma unroll
                for (int m = 0; m < 4; ++m)
#pragma unroll
                    for (int n = 0; n < 2; ++n) acc[a][b][m][n] = (f32x4){0.f, 0.f, 0.f, 0.f};
        cur = nxt; cA = nA; cB = nB; ++ui;
    }
    PG8_WAIT_V(0);
    if (wr == 0) PG8_BAR;
    PG8_BAR;
#undef PG8_SA
#undef PG8_SB
#undef PG8_STAGE
#undef PG8_LDA
#undef PG8_LDB
#undef PG8_MMA
#undef PG8_WAIT_V
#undef PG8_WAIT_L
#undef PG8_BAR
#undef PG8_SCHED
}
}
struct Frame {
    LAS unsigned char* lds; int G, bid;
    const float* const* in; float* out; unsigned char* ws; unsigned* ctl;
};
#define TID (opaque_tid())
#define LANE (opaque_tid() & 63)
#define WAVE (__builtin_amdgcn_readfirstlane(opaque_tid() >> 6))
enum { I_X = 0, I_RELB, I_NMIX, I_NFFN, I_NFIN, I_EV_WIN, I_EV_BF, I_EV_SINK, I_EV_WOUT, I_OD_WIN, I_OD_CPOS, I_OD_CW1, I_OD_CW2, I_OD_CONVW, I_OD_ALOG, I_OD_DTB,
       I_OD_GNORM, I_OD_WOUT, I_F_WUP, I_F_CONVW, I_F_CONVB, I_F_WDN };

template <int MAP>
__device__ __forceinline__ int cvt_map(int n, int srcN) {
    if (MAP == 0) return (n < srcN) ? n : -1;
    if (MAP == 1) return ev_src(n);
    if (MAP == 2) return od_src(n);
    return ((n & 255) < 128) ? (n >> 8) * 128 + (n & 127) : FF + (n >> 8) * 128 + (n & 127);
}
template <int MAP>
__device__ __forceinline__ void cvt_load(f32x4 (&v)[8], const float* __restrict__ src, int srcN, const float* __restrict__ gain, int k0, int n0, int tid) {
    const int n4 = (tid & 31) * 4, s = cvt_map<MAP>(n0 + n4, srcN);
    const int sc = s >= 0 ? s : 0;
    const float keep = (MAP == 3) ? ((((n0 + n4) & 255) < 128) ? -0.6931471805599453f : 1.f) : (s >= 0 ? 1.f : 0.f);
    float gv[8];
#pragma unroll
    for (int e = 0; e < 8; ++e) { const int kk = e * 16 + (tid >> 5);
        v[e] = *(const f32x4*)(src + (size_t)(k0 + kk) * srcN + sc);
        gv[e] = gain ? gain[k0 + kk] : 1.f; }
#pragma unroll
    for (int e = 0; e < 8; ++e) v[e] *= gv[e] * keep;
}
template <int MAP>
__device__ __forceinline__ void cvt_transpose(const Frame& F, const float* __restrict__ src, int srcN, int K, int Npad, const float* __restrict__ gain, bf16_t* __restrict__ dst) {
    LAS float* tile = (LAS float*)F.lds;
    const int tid = TID, tk = K / 128, tn = Npad / 128, ntile = tk * tn;
    int t = F.bid;
    f32x4 v[8];
    if (t < ntile) cvt_load<MAP>(v, src, srcN, gain, (t % tk) * 128, (t / tk) * 128, tid);
    for (; t < ntile; t += F.G) {
        const int k0 = (t % tk) * 128, n0 = (t / tk) * 128;
        __syncthreads();
#pragma unroll
        for (int e = 0; e < 8; ++e) *(LAS f32x4*)(tile + (e * 16 + (tid >> 5)) * 132 + (tid & 31) * 4) = v[e];
        __syncthreads();
        const int tnx = t + F.G;
        if (tnx < ntile) cvt_load<MAP>(v, src, srcN, gain, (tnx % tk) * 128, (tnx / tk) * 128, tid);
        { const int nn = tid & 127, kq = (tid >> 7) * 32;
          bf16_t* d = dst + (size_t)(n0 + nn) * K + k0 + kq;
#pragma unroll
          for (int q = 0; q < 4; ++q) { float x[8];
#pragma unroll
              for (int i = 0; i < 8; ++i) x[i] = tile[(kq + q * 8 + i) * 132 + nn];
              u32x4 w; w.x = cvt_pk_bf16(x[0], x[1]); w.y = cvt_pk_bf16(x[2], x[3]); w.z = cvt_pk_bf16(x[4], x[5]); w.w = cvt_pk_bf16(x[6], x[7]);
              *(u32x4*)(d + q * 8) = w; } }
    }
    __syncthreads();
}

__device__ __forceinline__ void rownorm_phase(const Frame& F, const float* __restrict__ src, bf16_t* __restrict__ cpy, float* __restrict__ rstd_out) {
    for (int row = F.bid * NWAVE + WAVE; row < M; row += F.G * NWAVE) {
        const float* p = src + (size_t)row * D + LANE * 4;
        f32x4 v[8]; float ss = 0.f;
        u32x2 c[8];
#pragma unroll
        for (int i = 0; i < 8; ++i) { v[i] = *(const f32x4*)(p + i * 256); c[i].x = cvt_pk_bf16(v[i][0], v[i][1]); c[i].y = cvt_pk_bf16(v[i][2], v[i][3]);
            ss += bflo(c[i].x) * bflo(c[i].x) + bfhi(c[i].x) * bfhi(c[i].x) + bflo(c[i].y) * bflo(c[i].y) + bfhi(c[i].y) * bfhi(c[i].y); }
        ss = wave_sum(ss);
        if (LANE == 0) rstd_out[row] = rsqrtf(ss * (1.f / D) + EPS);
#pragma unroll
        for (int i = 0; i < 8; ++i) *(u32x2*)(cpy + (size_t)row * D + LANE * 4 + i * 256) = c[i];
    }
}
__device__ __forceinline__ void rowstat_phase(const Frame& F, const bf16_t* __restrict__ res, float* __restrict__ rstd_out) {
    for (int row0 = (F.bid * NWAVE + WAVE) * 4; row0 < M; row0 += F.G * NWAVE * 4) {
        u32x4 v[4][4];
#pragma unroll
        for (int r = 0; r < 4; ++r)
#pragma unroll
            for (int i = 0; i < 4; ++i) v[r][i] = *(const u32x4*)(res + (size_t)(row0 + r) * D + LANE * 8 + i * 512);
        float ss[4];
#pragma unroll
        for (int r = 0; r < 4; ++r) { ss[r] = 0.f;
#pragma unroll
            for (int i = 0; i < 4; ++i) { const u32x4 x = v[r][i];
                ss[r] += bflo(x.x) * bflo(x.x) + bfhi(x.x) * bfhi(x.x) + bflo(x.y) * bflo(x.y) + bfhi(x.y) * bfhi(x.y) + bflo(x.z) * bflo(x.z) + bfhi(x.z) * bfhi(x.z) + bflo(x.w) * bflo(x.w) + bfhi(x.w) * bfhi(x.w); }
            ss[r] = wave_sum(ss[r]); }
        if (LANE < 4) rstd_out[row0 + LANE] = rsqrtf((LANE == 0 ? ss[0] : LANE == 1 ? ss[1] : LANE == 2 ? ss[2] : ss[3]) * (1.f / D) + EPS);
    }
}
__device__ __forceinline__ void rowstat_f_phase(const Frame& F, const bf16_t* __restrict__ res, float* __restrict__ rstd_out, const bf16_t* __restrict__ wf  , bf16_t* __restrict__ proj) {
    LAS unsigned char* lds = F.lds;
    __syncthreads();
    for (int i = TID; i < 8 * D / 8; i += NTHR) *(LAS u32x4*)(lds + i * 16) = *(const u32x4*)(wf + (size_t)i * 8);
    __syncthreads();
    const int l = LANE, r = l & 15, kq = l >> 4;
    for (int blk = F.bid * NWAVE + WAVE; blk < M / 16; blk += F.G * NWAVE) {
        const bf16_t* rowp = res + (size_t)(blk * 16 + r) * D + kq * 8;
        f32x4 acc = {0.f, 0.f, 0.f, 0.f}; float ss = 0.f;
#pragma unroll 1
        for (int s0 = 0; s0 < 64; s0 += 32) {
            u32x4 a[32];
#pragma unroll
            for (int s = 0; s < 32; ++s) a[s] = *(const u32x4*)(rowp + (s0 + s) * 32);
#pragma unroll
            for (int s = 0; s < 32; ++s) { const u32x4 x = a[s];
                ss += bflo(x.x) * bflo(x.x) + bfhi(x.x) * bfhi(x.x) + bflo(x.y) * bflo(x.y) + bfhi(x.y) * bfhi(x.y) + bflo(x.z) * bflo(x.z) + bfhi(x.z) * bfhi(x.z) + bflo(x.w) * bflo(x.w) + bfhi(x.w) * bfhi(x.w);
                u32x4 b = *(const LAS u32x4*)(lds + (r & 7) * 4096 + ((s0 + s) * 32 + kq * 8) * 2);
                if (r >= 8) b = (u32x4){0u, 0u, 0u, 0u};
                u32x4 xa = x;
                acc = __builtin_amdgcn_mfma_f32_16x16x32_bf16(*reinterpret_cast<bf16x8*>(&xa), *reinterpret_cast<bf16x8*>(&b), acc, 0, 0, 0); }
        }
        ss += shx(ss, 16); ss += shx(ss, 32);
        const float rstd = rsqrtf(ss * (1.f / D) + EPS);
        if (kq == 0) rstd_out[blk * 16 + r] = rstd;
#pragma unroll
        for (int reg = 0; reg < 4; ++reg) { const float rr = __builtin_bit_cast(float, __builtin_amdgcn_ds_bpermute((4 * kq + reg) << 2, __builtin_bit_cast(int, rstd)));
            if (r < 8) proj[(size_t)(blk * 16 + 4 * kq + reg) * EV_NP + EC_F + r] = f2bf(acc[reg] * rr); }
    }
    __syncthreads();
}
__device__ __forceinline__ void final_norm_phase(const Frame& F, const bf16_t* __restrict__ res, float* __restrict__ out, const float* __restrict__ g) {
    for (int row0 = (F.bid * NWAVE + WAVE) * 2; row0 < M; row0 += F.G * NWAVE * 2) {
        u32x4 v[2][4];
#pragma unroll
        for (int r = 0; r < 2; ++r)
#pragma unroll
            for (int i = 0; i < 4; ++i) v[r][i] = *(const u32x4*)(res + (size_t)(row0 + r) * D + LANE * 8 + i * 512);
#pragma unroll
        for (int r = 0; r < 2; ++r) {
            float ss = 0.f;
#pragma unroll
            for (int i = 0; i < 4; ++i) { const u32x4 x = v[r][i];
                ss += bflo(x.x) * bflo(x.x) + bfhi(x.x) * bfhi(x.x) + bflo(x.y) * bflo(x.y) + bfhi(x.y) * bfhi(x.y) + bflo(x.z) * bflo(x.z) + bfhi(x.z) * bfhi(x.z) + bflo(x.w) * bflo(x.w) + bfhi(x.w) * bfhi(x.w); }
            ss = wave_sum(ss);
            const float rstd = rsqrtf(ss * (1.f / D) + EPS);
#pragma unroll
            for (int i = 0; i < 4; ++i) { const u32x4 x = v[r][i];
                const f32x4 g0 = *(const f32x4*)(g + LANE * 8 + i * 512), g1 = *(const f32x4*)(g + LANE * 8 + i * 512 + 4);
                float* o = out + (size_t)(row0 + r) * D + LANE * 8 + i * 512;
                *(f32x4*)o = (f32x4){bflo(x.x), bfhi(x.x), bflo(x.y), bfhi(x.y)} * rstd * g0;
                *(f32x4*)(o + 4) = (f32x4){bflo(x.z), bfhi(x.z), bflo(x.w), bfhi(x.w)} * rstd * g1; }
        }
    }
}

__device__ __forceinline__ void ffn_fixup_phase(const Frame& F, bf16_t* __restrict__ act, const float* __restrict__ tail, const float* __restrict__ headg, const float* __restrict__ headu,
                                                const float* __restrict__ cw, const float* __restrict__ cb) {
    constexpr int C4 = FF / 4, NPM = M / 256;
    for (int idx = F.bid * NTHR + TID; idx < NPM * 2 * C4; idx += F.G * NTHR) {
        const int c = (idx % C4) * 4, r = (idx / C4) & 1, pm = idx / (2 * C4);
        if ((pm & 15) == 0) continue;
        const f32x4 t0 = *(const f32x4*)(tail + ((size_t)(pm - 1) * 2 + 0) * FF + c), t1 = *(const f32x4*)(tail + ((size_t)(pm - 1) * 2 + 1) * FF + c);
        const f32x4 h0 = *(const f32x4*)(headg + ((size_t)pm * 2 + 0) * FF + c), h1 = *(const f32x4*)(headg + ((size_t)pm * 2 + 1) * FF + c);
        const f32x4 uu = *(const f32x4*)(headu + ((size_t)pm * 2 + r) * FF + c);
        const f32x4 gm2 = r == 0 ? t0 : t1, gm1 = r == 0 ? t1 : h0, g0 = r == 0 ? h0 : h1;
        const f32x4 w0 = *(const f32x4*)(cw + c), w1 = *(const f32x4*)(cw + FF + c), w2 = *(const f32x4*)(cw + 2 * FF + c), bb = *(const f32x4*)(cb + c);
        float o[4];
#pragma unroll
        for (int e = 0; e < 4; ++e) { const float z = w0[e] * gm2[e] + w1[e] * gm1[e] + w2[e] * g0[e] + bb[e]; o[e] = siluf_(z) * (uu[e] * -LOG2E); }
        u32x2 w; w.x = cvt_pk_bf16(o[0], o[1]); w.y = cvt_pk_bf16(o[2], o[3]);
        *(u32x2*)(act + (size_t)(pm * 256 + r) * FF + c) = w;
    }
}

__device__ __forceinline__ void p0_prologue(const Frame& F) {
    unsigned char* ws = F.ws;
    for (int j = 0; j < 2; ++j) {
        cvt_transpose<1>(F, F.in[I_EV_WIN] + (size_t)j * D * EV_N, EV_N, D, EV_NP, F.in[I_NMIX] + (size_t)(2 * j) * D, (bf16_t*)(ws + WS_W_EV_IN + j * SZ_W_EV_IN));
        cvt_transpose<0>(F, F.in[I_EV_WOUT] + (size_t)j * D * D, D, D, D, nullptr, (bf16_t*)(ws + WS_W_EV_OUT + j * SZ_W_OUT));
        cvt_transpose<2>(F, F.in[I_OD_WIN] + (size_t)j * D * OD_N, OD_N, D, OD_NP, F.in[I_NMIX] + (size_t)(2 * j + 1) * D, (bf16_t*)(ws + WS_W_OD_IN + j * SZ_W_OD_IN));
        cvt_transpose<0>(F, F.in[I_OD_WOUT] + (size_t)j * D * D, D, D, D, nullptr, (bf16_t*)(ws + WS_W_OD_OUT + j * SZ_W_OUT));
        for (int kv = 0; kv < 2; ++kv) {
            cvt_transpose<0>(F, F.in[I_OD_CW1] + (size_t)(j * 2 + kv) * 4096 * 256, 256, 4096, 256, nullptr, (bf16_t*)(ws + WS_W_C1 + (j * 2 + kv) * SZ_W_C1));
            cvt_transpose<0>(F, F.in[I_OD_CW2] + (size_t)(j * 2 + kv) * 256 * 128, 128, 256, 256, nullptr, (bf16_t*)(ws + WS_W_C2 + (j * 2 + kv) * SZ_W_C2));
        }
    }
    for (int l = 0; l < 4; ++l) {
        cvt_transpose<3>(F, F.in[I_F_WUP] + (size_t)l * D * FF2, FF2, D, FF2, F.in[I_NFFN] + (size_t)l * D, (bf16_t*)(ws + WS_W_UP + l * SZ_W_UP));
        cvt_transpose<0>(F, F.in[I_F_WDN] + (size_t)l * FF * D, D, FF, D, nullptr, (bf16_t*)(ws + WS_W_DN + l * SZ_W_DN));
    }
    if (F.bid < 64) {
        const int tid = TID, jk = F.bid >> 4, part = (F.bid & 15) * 2 + (tid >> 8), n = tid & 255;
        const float* pe = F.in[I_OD_CPOS] + (size_t)jk * 4096 + part * 128; const float* w1 = F.in[I_OD_CW1] + ((size_t)jk * 4096 + part * 128) * 256 + n;
        float s = 0.f;
        for (int i0 = 0; i0 < 128; i0 += 16) {
            float a[16], b[16];
#pragma unroll
            for (int u = 0; u < 16; ++u) { a[u] = pe[i0 + u]; b[u] = w1[(size_t)(i0 + u) * 256]; }
#pragma unroll
            for (int u = 0; u < 16; ++u) s += a[u] * b[u];
        }
        ((float*)(ws + WS_C1B))[(jk * 32 + part) * 256 + n] = s;
    }
    rownorm_phase(F, F.in[I_X], (bf16_t*)(ws + WS_RES), F.out + (size_t)M * D / 2);
}
namespace att {
constexpr int KVBLK = 64, SHM_K = KVBLK * 128 * 2, SHM_V = KVBLK * 128 * 2;
constexpr int KVBUF = SHM_V + SHM_K;
constexpr int L_V = 0, L_K = SHM_V;
constexpr int EL_WS = 4 * KVBUF, EL_CFR = EL_WS + 2048, EL_TAB = EL_CFR + 8192  , EL_MISC = EL_TAB + 4096, EL_END = EL_MISC + 256;
static_assert(EL_END <= LDS_BARW, "even attention lds");
#define KSWZ_F(row) (((row) & 7) | ((((row) >> 4) & 1) << 3))
#define KSWZ(row, colB) ((row) * 256 + ((colB) ^ (KSWZ_F(row) << 4)))
#define SBAR() __builtin_amdgcn_sched_barrier(0)
__device__ __forceinline__ int v_st(int k, int c) { const int kk = (k & ~0xC) | ((k & 4) << 1) | ((k & 8) >> 1); return ((kk >> 3) * 4 + (c >> 5)) * 512 + ((kk & 7) * 32 + (c & 31)) * 2; }
__device__ __forceinline__ int v_rd_base(int lane) { return ((lane & 3) << 3) | (((lane >> 2) & 3) << 6) | (((lane >> 4) & 1) << 5) | (((lane >> 5) & 1) << 8); }
constexpr int v_rd_off(int d0, int ks, int half) { return d0 * 512 + ks * 4096 + half * 2048; }
__device__ __forceinline__ int crow(int r, int hi) { return (r & 3) + 8 * (r >> 2) + 4 * hi; }
constexpr float C2 = LOG2E * SCALE;

struct KvOff { unsigned k, v; };
__device__ __forceinline__ KvOff kv_dma_off(int tid, int ld) {
    const int row = tid >> 4, cch = (tid & 15) ^ KSWZ_F(row);
    const int kk = ((tid >> 7) << 3) | ((tid >> 2) & 7), key = (kk & ~0xC) | ((kk & 4) << 1) | ((kk & 8) >> 1), col = ((tid >> 5) & 3) * 32 + (tid & 3) * 8;
    KvOff o; o.k = (unsigned)(row * ld + cch * 8) * 2u; o.v = (unsigned)(key * ld + col) * 2u; return o;
}
__device__ __forceinline__ void kv_dma(LAS unsigned char* buf, const bf16_t* __restrict__ Kg, const bf16_t* __restrict__ Vg, int ld, KvOff o, int wid) {
    const char* k0 = (const char*)Kg; const char* k1 = (const char*)(Kg + (size_t)32 * ld);
    const char* v0 = (const char*)Vg; const char* v1 = (const char*)(Vg + (size_t)32 * ld);
    LAS unsigned char* l = buf + wid * 1024;
    __builtin_amdgcn_global_load_lds((const unsigned*)(k0 + o.k), (LAS unsigned*)(l + L_K), 16, 0, 0);
    __builtin_amdgcn_global_load_lds((const unsigned*)(k1 + o.k), (LAS unsigned*)(l + L_K + 8192), 16, 0, 0);
    __builtin_amdgcn_global_load_lds((const unsigned*)(v0 + o.v), (LAS unsigned*)(l + L_V), 16, 0, 0);
    __builtin_amdgcn_global_load_lds((const unsigned*)(v1 + o.v), (LAS unsigned*)(l + L_V + 8192), 16, 0, 0);
}
template <int NI> __device__ __forceinline__ void dma_wait(int ahead) {
    if (ahead >= 2) { if (NI == 4) asm volatile("s_waitcnt vmcnt(8)" ::: "memory"); else asm volatile("s_waitcnt vmcnt(10)" ::: "memory"); }
    else if (ahead == 1) { if (NI == 4) asm volatile("s_waitcnt vmcnt(4)" ::: "memory"); else asm volatile("s_waitcnt vmcnt(5)" ::: "memory"); }
    else asm volatile("s_waitcnt vmcnt(0)" ::: "memory");
}
#define RING_BAR() do { asm volatile("s_waitcnt lgkmcnt(0)" ::: "memory"); __builtin_amdgcn_s_barrier(); asm volatile("" ::: "memory"); } while (0)
template <int NSET = 4>
__device__ __forceinline__ void qkt(f32x16& p0, f32x16& p1, LAS unsigned char* lds, int r32, int hi, const bf16x8* qr) {
    p0 = f32x16{}; p1 = f32x16{};
    int ad[4];
#pragma unroll
    for (int dd = 0; dd < 4; ++dd) ad[dd] = (int)(uintptr_t)(lds + L_K + KSWZ(r32, (dd * 16 + hi * 8) * 2));
    bf16x8 k0[NSET], k1[NSET];
#define KRD(dst, a_, off_) asm volatile("ds_read_b128 %0, %1 offset:%2" : "=&v"(dst) : "v"(a_), "i"(off_) : "memory")
#define KWAIT(n_, x_, y_) asm volatile("s_waitcnt lgkmcnt(" #n_ ")" : "+v"(x_), "+v"(y_) :: "memory")
#define KISSUE(d_) do { if ((d_) < 4) { KRD(k0[(d_) % NSET], ad[(d_) & 3], 0); KRD(k1[(d_) % NSET], ad[(d_) & 3], 32 * 256); } \
                        else { const int a2_ = ad[(d_) & 3] ^ 128;         \
                               KRD(k0[(d_) % NSET], a2_, 0); KRD(k1[(d_) % NSET], a2_, 32 * 256); } } while (0)
#pragma unroll
    for (int d0 = 0; d0 < NSET; ++d0) KISSUE(d0);
#define KWAITN(n_, x_, y_) do { if ((n_) == 6) KWAIT(6, x_, y_); else if ((n_) == 4) KWAIT(4, x_, y_); else if ((n_) == 2) KWAIT(2, x_, y_); else KWAIT(0, x_, y_); } while (0)
#define QK_STEP(d0_) do { constexpr int inflight_ = ((8 - (d0_)) < NSET ? (8 - (d0_)) : NSET) - 1; KWAITN(2 * inflight_, k0[(d0_) % NSET], k1[(d0_) % NSET]); \
        p0 = __builtin_amdgcn_mfma_f32_32x32x16_bf16(k0[(d0_) % NSET], qr[d0_], p0, 0, 0, 0); p1 = __builtin_amdgcn_mfma_f32_32x32x16_bf16(k1[(d0_) % NSET], qr[d0_], p1, 0, 0, 0); \
        if ((d0_) + NSET < 8) KISSUE((d0_) + NSET); } while (0)
    QK_STEP(0); QK_STEP(1); QK_STEP(2); QK_STEP(3); QK_STEP(4); QK_STEP(5); QK_STEP(6); QK_STEP(7);
#undef KWAITN
#undef QK_STEP
#undef KISSUE
#undef KWAIT
#undef KRD
}
__device__ __forceinline__ void partialSM(f32x16& p0, f32x16& p1, float& m_reg, float& mn, float& alpha) {
    float mx[4] = {p0[0], p0[1], p0[2], p0[3]};
#pragma unroll
    for (int r = 4; r < 16; ++r) mx[r & 3] = fmaxf(mx[r & 3], p0[r]);
#pragma unroll
    for (int r = 0; r < 16; ++r) mx[r & 3] = fmaxf(mx[r & 3], p1[r]);
    float pmax = fmaxf(fmaxf(mx[0], mx[1]), fmaxf(mx[2], mx[3]));
    { auto rr = __builtin_amdgcn_permlane32_swap(__float_as_uint(pmax), __float_as_uint(pmax), false, false);
      pmax = fmaxf(__uint_as_float(rr[0]), __uint_as_float(rr[1])); }
    if (__any((pmax - m_reg) * C2 > 8.f)) { mn = fmaxf(m_reg, pmax); alpha = __builtin_amdgcn_exp2f((m_reg - mn) * C2); m_reg = mn; }
    else { mn = m_reg; alpha = 1.f; }
    const float mnL = -mn * C2;
#pragma unroll
    for (int r = 0; r < 16; ++r) p0[r] = __builtin_amdgcn_exp2f(fmaf(p0[r], C2, mnL));
#pragma unroll
    for (int r = 0; r < 16; ++r) p1[r] = __builtin_amdgcn_exp2f(fmaf(p1[r], C2, mnL));
}
__device__ __forceinline__ void pack_p(const f32x16& p0, const f32x16& p1, bf16x8& pa0, bf16x8& pa1, bf16x8& pa2, bf16x8& pa3) {
#define PK4(P, B_, OUT) do { unsigned a0 = cvt_pk_bf16(P[B_+0], P[B_+1]), a1 = cvt_pk_bf16(P[B_+2], P[B_+3]);                          \
        unsigned b0 = cvt_pk_bf16(P[B_+4], P[B_+5]), b1 = cvt_pk_bf16(P[B_+6], P[B_+7]);                                             \
        auto r0 = __builtin_amdgcn_permlane32_swap(a0, b0, false, false); auto r1 = __builtin_amdgcn_permlane32_swap(a1, b1, false, false); \
        u32x4 w = {r0[0], r1[0], r0[1], r1[1]}; OUT = *reinterpret_cast<bf16x8*>(&w); } while (0)
    PK4(p0, 0, pa0); PK4(p0, 8, pa1); PK4(p1, 0, pa2); PK4(p1, 8, pa3);
#undef PK4
}
__device__ __forceinline__ float row_sum(const f32x16& p0, const f32x16& p1) {
    float sm[4] = {0.f, 0.f, 0.f, 0.f};
#pragma unroll
    for (int r = 0; r < 16; ++r) sm[r & 3] += p0[r] + p1[r];
    const float ps = (sm[0] + sm[1]) + (sm[2] + sm[3]);
    auto rr = __builtin_amdgcn_permlane32_swap(__float_as_uint(ps), __float_as_uint(ps), false, false);
    return __uint_as_float(rr[0]) + __uint_as_float(rr[1]);
}
__device__ __forceinline__ void pv_tile(f32x16* o, int vb0, bf16x8 pa0, bf16x8 pa1, bf16x8 pa2, bf16x8 pa3) {
#define TRRD(dst, off) asm volatile("ds_read_b64_tr_b16 %0, %1 offset:%2" : "=&v"(dst) : "v"(vb0), "i"(off) : "memory")
    s16x4 l[2][4], h[2][4];
#define PV_RD(d0, st) do { constexpr int b_ = L_V + v_rd_off(d0, 0, 0); \
        TRRD(l[st][0], b_); TRRD(h[st][0], b_ + 2048); TRRD(l[st][1], b_ + 4096); TRRD(h[st][1], b_ + 6144); TRRD(l[st][2], b_ + 8192); TRRD(h[st][2], b_ + 10240); TRRD(l[st][3], b_ + 12288); TRRD(h[st][3], b_ + 14336); } while (0)
#define PV_WAIT(n_, st) asm volatile("s_waitcnt lgkmcnt(" #n_ ")" : "+v"(l[st][0]), "+v"(h[st][0]), "+v"(l[st][1]), "+v"(h[st][1]), "+v"(l[st][2]), "+v"(h[st][2]), "+v"(l[st][3]), "+v"(h[st][3]) :: "memory")
#define PV_MM(d0, st) do { \
        o[d0] = __builtin_amdgcn_mfma_f32_32x32x16_bf16(pa0, (bf16x8){l[st][0][0], l[st][0][1], l[st][0][2], l[st][0][3], h[st][0][0], h[st][0][1], h[st][0][2], h[st][0][3]}, o[d0], 0, 0, 0);   \
        o[d0] = __builtin_amdgcn_mfma_f32_32x32x16_bf16(pa1, (bf16x8){l[st][1][0], l[st][1][1], l[st][1][2], l[st][1][3], h[st][1][0], h[st][1][1], h[st][1][2], h[st][1][3]}, o[d0], 0, 0, 0);   \
        o[d0] = __builtin_amdgcn_mfma_f32_32x32x16_bf16(pa2, (bf16x8){l[st][2][0], l[st][2][1], l[st][2][2], l[st][2][3], h[st][2][0], h[st][2][1], h[st][2][2], h[st][2][3]}, o[d0], 0, 0, 0);   \
        o[d0] = __builtin_amdgcn_mfma_f32_32x32x16_bf16(pa3, (bf16x8){l[st][3][0], l[st][3][1], l[st][3][2], l[st][3][3], h[st][3][0], h[st][3][1], h[st][3][2], h[st][3][3]}, o[d0], 0, 0, 0); } while (0)
    PV_RD(0, 0); PV_RD(1, 1);
    PV_WAIT(8, 0); PV_MM(0, 0); PV_RD(2, 0);
    PV_WAIT(8, 1); PV_MM(1, 1); PV_RD(3, 1);
    PV_WAIT(8, 0); PV_MM(2, 0);
    PV_WAIT(0, 1); PV_MM(3, 1);
#undef PV_MM
#undef PV_WAIT
#undef PV_RD
#undef TRRD
}
__device__ __forceinline__ void rescale_o(f32x16* o, float alpha, LAS float* al_l, int r32, int hi) {
    if (__any(alpha < 1.f)) {
        if (hi == 0) al_l[r32] = alpha;
        asm volatile("s_waitcnt lgkmcnt(0)" ::: "memory");
#pragma unroll
        for (int r = 0; r < 16; ++r) { const float a = al_l[crow(r, hi)];
#pragma unroll
            for (int d = 0; d < 4; ++d) o[d][r] *= a; }
        asm volatile("s_waitcnt lgkmcnt(0)" ::: "memory");
    }
}
__device__ __forceinline__ void sm_pv_step(f32x16& p0, f32x16& p1, f32x16* o, float& m_reg, float& l_reg, LAS float* al_l, int vb0, int r32, int hi) {
    float mn, alpha;
    partialSM(p0, p1, m_reg, mn, alpha);
    rescale_o(o, alpha, al_l, r32, hi);
    l_reg = l_reg * alpha + row_sum(p0, p1);
    bf16x8 pa0, pa1, pa2, pa3; pack_p(p0, p1, pa0, pa1, pa2, pa3);
    pv_tile(o, vb0, pa0, pa1, pa2, pa3);
}
__device__ __forceinline__ void lanes_to_rows(float x, float* vals, LAS float* xl, int r32, int hi) {
    if (hi == 0) xl[r32] = x;
    asm volatile("s_waitcnt lgkmcnt(0)" ::: "memory");
#pragma unroll
    for (int r = 0; r < 16; ++r) vals[r] = xl[crow(r, hi)];
    asm volatile("s_waitcnt lgkmcnt(0)" ::: "memory");
}
template <int NI, class Issue, class Active, class Fixup>
__device__ __forceinline__ void pingpong_attn(int nT, int wid, LAS unsigned char* lds, int vb0, const bf16x8* qr, f32x16* o, float& m_reg, float& l_reg, LAS float* al_l, int r32, int hi,
                                              Issue issue, Active active, Fixup fixup) {
    const bool grpB = wid >= 4;
    issue(0); if (nT > 1) issue(1);
    dma_wait<NI>(nT > 1 ? 1 : 0);
    RING_BAR();
    if (grpB) RING_BAR();
    bf16x8 pa0 = {}, pa1 = {}, pa2 = {}, pa3 = {}; bool act_prev = false;
    f32x16 p0 = {}, p1 = {};
    for (int s = 0; s <= nT; ++s) {
        if (s + 2 < nT) issue(s + 2);
        if (act_prev) pv_tile(o, vb0 + ((s - 1) & 3) * KVBUF, pa0, pa1, pa2, pa3);
        bool act = false;
        if (s < nT) { act = active(s); if (act) qkt(p0, p1, lds + (s & 3) * KVBUF, r32, hi, qr); }
        if (s + 1 < nT) dma_wait<NI>(s + 2 < nT ? 1 : 0);
        RING_BAR();
        if (s < nT) {
            if (act) { fixup(s, p0, p1); float mn, alpha; partialSM(p0, p1, m_reg, mn, alpha); rescale_o(o, alpha, al_l, r32, hi); l_reg = l_reg * alpha + row_sum(p0, p1);
                       pack_p(p0, p1, pa0, pa1, pa2, pa3); }
            act_prev = act;
            RING_BAR();
        }
    }
    if (!grpB) RING_BAR();
}
template <int NI, int NSET, class Issue, class Active, class Fixup>
__device__ __forceinline__ void dual_attn(int nT, int wid, LAS unsigned char* lds, int vb0, const bf16x8* qr, f32x16* o, float& m_reg, float& l_reg, LAS float* al_l, int r32, int hi,
                                          Issue issue, Active active, Fixup fixup) {
    const int nS = (nT + 1) >> 1;
    issue(0); if (nT > 1) issue(1);
    for (int s = 0; s < nS; ++s) {
        asm volatile("s_waitcnt vmcnt(0)" ::: "memory");
        RING_BAR();
        if (2 * s + 2 < nT) issue(2 * s + 2);
        if (2 * s + 3 < nT) issue(2 * s + 3);
        const int sa = (2 * s) & 3;
        const float NEGI = -__builtin_inff();
        f32x16 p0, p1, p2, p3;
        const bool acta = active(2 * s);
        if (acta) { qkt<NSET>(p0, p1, lds + sa * KVBUF, r32, hi, qr); fixup(2 * s, p0, p1); }
        else {
#pragma unroll
            for (int r = 0; r < 16; ++r) { p0[r] = NEGI; p1[r] = NEGI; } }
        if (NSET == 2) __builtin_amdgcn_sched_barrier(0);
        bool actb = false;
        if (2 * s + 1 < nT) actb = active(2 * s + 1);
        if (actb) { qkt<NSET>(p2, p3, lds + (sa + 1) * KVBUF, r32, hi, qr); fixup(2 * s + 1, p2, p3); }
        else {
#pragma unroll
            for (int r = 0; r < 16; ++r) { p2[r] = NEGI; p3[r] = NEGI; } }
        if (!acta && !actb) continue;
        float mx[4] = {p0[0], p0[1], p0[2], p0[3]};
#pragma unroll
        for (int r = 4; r < 16; ++r) mx[r & 3] = fmaxf(mx[r & 3], p0[r]);
#pragma unroll
        for (int r = 0; r < 16; ++r) mx[r & 3] = fmaxf(mx[r & 3], fmaxf(p1[r], fmaxf(p2[r], p3[r])));
        float pmax = fmaxf(fmaxf(mx[0], mx[1]), fmaxf(mx[2], mx[3]));
        { auto rr = __builtin_amdgcn_permlane32_swap(__float_as_uint(pmax), __float_as_uint(pmax), false, false);
          pmax = fmaxf(__uint_as_float(rr[0]), __uint_as_float(rr[1])); }
        float mn = m_reg, alpha = 1.f;
        if (__any((pmax - m_reg) * C2 > 8.f)) { mn = fmaxf(m_reg, pmax); alpha = __builtin_amdgcn_exp2f((m_reg - mn) * C2); m_reg = mn; }
        const float mnL = -mn * C2;
#pragma unroll
        for (int r = 0; r < 16; ++r) { p0[r] = __builtin_amdgcn_exp2f(fmaf(p0[r], C2, mnL)); p1[r] = __builtin_amdgcn_exp2f(fmaf(p1[r], C2, mnL));
                                       p2[r] = __builtin_amdgcn_exp2f(fmaf(p2[r], C2, mnL)); p3[r] = __builtin_amdgcn_exp2f(fmaf(p3[r], C2, mnL)); }
        rescale_o(o, alpha, al_l, r32, hi);
        { float sm[4] = {0.f, 0.f, 0.f, 0.f};
#pragma unroll
          for (int r = 0; r < 16; ++r) sm[r & 3] += (p0[r] + p1[r]) + (p2[r] + p3[r]);
          const float ps = (sm[0] + sm[1]) + (sm[2] + sm[3]);
          auto rr = __builtin_amdgcn_permlane32_swap(__float_as_uint(ps), __float_as_uint(ps), false, false);
          l_reg = l_reg * alpha + (__uint_as_float(rr[0]) + __uint_as_float(rr[1])); }
        if (acta) { bf16x8 a0, a1, a2, a3; pack_p(p0, p1, a0, a1, a2, a3); pv_tile(o, vb0 + sa * KVBUF, a0, a1, a2, a3); }
        if (actb) { bf16x8 b0, b1, b2, b3; pack_p(p2, p3, b0, b1, b2, b3); pv_tile(o, vb0 + (sa + 1) * KVBUF, b0, b1, b2, b3); }
    }
}
__device__ __forceinline__ void store_o_bf16(const f32x16* o, const float* rs, bf16_t* __restrict__ Ow, int ldo, int r32, int hi) {
    unsigned w[16][4];
#pragma unroll
    for (int r = 0; r < 16; ++r)
#pragma unroll
        for (int d0 = 0; d0 < 4; ++d0) { const float v = o[d0][r] * rs[r]; const float vn = DPPF(v, 0xB1); w[r][d0] = cvt_pk_bf16(v, vn); }
    if ((r32 & 1) == 0) {
#pragma unroll
        for (int r = 0; r < 16; ++r)
#pragma unroll
            for (int d0 = 0; d0 < 4; ++d0) *(unsigned*)(Ow + (size_t)crow(r, hi) * ldo + d0 * 32 + r32) = w[r][d0];
    }
}
__device__ __forceinline__ int t5_bucket(int n) {
    if (n < 16) return n;
    const float lr = logf((float)n / 16.f) / 2.0794415416798357f;
    const int v = 16 + (int)(lr * 16.f);
    return v < 31 ? v : 31;
}
}

__device__ __forceinline__ void fox_norm_phase(const Frame& F, const bf16_t* __restrict__ proj, unsigned* __restrict__ nrm) {
    const int tid = TID, sub = tid & 15, rl = tid >> 4;
    for (int it = F.bid; it < 256; it += F.G) {
        const int bh = it >> 2, qtr = it & 3, b = bh >> 3, h = bh & 7;
        float mq = 0.f, mk = 0.f;
        for (int r0 = 0; r0 < 1024; r0 += 128) {
            u32x4 qv[4], kv[4];
#pragma unroll
            for (int u = 0; u < 4; ++u) { const size_t row = (size_t)(b * T + qtr * 1024 + r0 + u * 32 + rl) * EV_NP;
                qv[u] = *(const u32x4*)(proj + row + EC_QB + h * 128 + sub * 8); kv[u] = *(const u32x4*)(proj + row + EC_KB + h * 128 + sub * 8); }
#pragma unroll
            for (int u = 0; u < 4; ++u) { const u32x4 q = qv[u], k = kv[u];
                float sq = bflo(q.x) * bflo(q.x) + bfhi(q.x) * bfhi(q.x) + bflo(q.y) * bflo(q.y) + bfhi(q.y) * bfhi(q.y) + bflo(q.z) * bflo(q.z) + bfhi(q.z) * bfhi(q.z) + bflo(q.w) * bflo(q.w) + bfhi(q.w) * bfhi(q.w);
                float sk = bflo(k.x) * bflo(k.x) + bfhi(k.x) * bfhi(k.x) + bflo(k.y) * bflo(k.y) + bfhi(k.y) * bfhi(k.y) + bflo(k.z) * bflo(k.z) + bfhi(k.z) * bfhi(k.z) + bflo(k.w) * bflo(k.w) + bfhi(k.w) * bfhi(k.w);
                sq = row16_sum(sq); sk = row16_sum(sk);
                mq = fmaxf(mq, sq); mk = fmaxf(mk, sk); }
        }
#pragma unroll
        for (int o = 16; o < 64; o <<= 1) { mq = fmaxf(mq, shx(mq, o)); mk = fmaxf(mk, shx(mk, o)); }
        if ((tid & 63) == 0) { atomicMax(nrm + bh * 2, __float_as_uint(mq)); atomicMax(nrm + bh * 2 + 1, __float_as_uint(mk)); }
    }
}
__device__ __forceinline__ void fscan_phase(const Frame& F, const bf16_t* __restrict__ proj, const float* __restrict__ bforget, float* __restrict__ cf) {
    LAS float* red = (LAS float*)F.lds;
    const int tid = TID;
    for (int it = F.bid; it < NB * 8; it += F.G) {
        const int b = it >> 3, h = it & 7; const float bf = bforget[h];
        float v[8]; float s = 0.f;
#pragma unroll
        for (int i = 0; i < 8; ++i) { const int t = tid * 8 + i; const float x = bf2f(proj[(size_t)(b * T + t) * EV_NP + EC_F + h]) + bf;
            const float ls = fminf(x, 0.f) - log1pf(__expf(-fabsf(x))); s += ls; v[i] = s; }
        __syncthreads();
        red[tid] = s;
        __syncthreads();
        if (tid < 64) { float a = 0.f;
            float loc[8];
#pragma unroll
            for (int i = 0; i < 8; ++i) { a += red[tid * 8 + i]; loc[i] = a; }
            float incl = a;
#pragma unroll
            for (int o = 1; o < 64; o <<= 1) { const float n = shu(incl, o); if (tid >= o) incl += n; }
            const float excl = incl - a;
#pragma unroll
            for (int i = 0; i < 8; ++i) red[tid * 8 + i] = excl + loc[i];
        }
        __syncthreads();
        const float base = tid > 0 ? red[tid - 1] : 0.f;
#pragma unroll
        for (int i = 0; i < 8; ++i) cf[(size_t)it * T + tid * 8 + i] = base + v[i];
    }
    __syncthreads();
}

__device__ __forceinline__ void even_attn_phase(const Frame& F, const bf16_t* __restrict__ proj, bf16_t* __restrict__ mix, const float* __restrict__ cf, const float* __restrict__ relb, const float* __restrict__ sinks, const unsigned* __restrict__ nrm, unsigned* __restrict__ qhead) {
    using namespace att;
    LAS unsigned char* lds = F.lds;
    const int tid = opaque_tid(), wid = __builtin_amdgcn_readfirstlane(tid >> 6), lane = tid & 63, r32 = lane & 31, hi = lane >> 5;
    LAS float* al_l = (LAS float*)(lds + EL_WS) + wid * 64;
    LAS float* cfr = (LAS float*)(lds + EL_CFR) + wid * 64;
    LAS float* tab = (LAS float*)(lds + EL_TAB);
    constexpr int LD = EV_NP;
    LAS int* qi = (LAS int*)(lds + EL_MISC);
    for (int i = tid; i < 1024; i += NTHR) tab[i] = relb[t5_bucket(i & 127) * 8 + (i >> 7)] * INV_SCALE;
    for (;;) {
        __syncthreads();
        if (threadIdx.x == 0) *qi = (int)__hip_atomic_fetch_add(qhead, 1u, __ATOMIC_RELAXED, __HIP_MEMORY_SCOPE_AGENT);
        __syncthreads();
        const int it = __builtin_amdgcn_readfirstlane(*qi);
        if (it >= 2048) break;
        const int tid = opaque_tid(), lane = tid & 63, r32 = lane & 31, hi = lane >> 5;
        const int vb0 = (int)(uintptr_t)(lds + L_V) + v_rd_base(lane);
        const KvOff ko = kv_dma_off(tid, LD);
        if (it < 1024) {
            const int qb = 15 - (it >> 6), bh = it & 63;
            const int b = bh >> 3, h = bh & 7, P0 = qb * 256, qpos0 = P0 + wid * 32;
            const bf16_t* Qg = proj + (size_t)(b * T + qpos0 + r32) * LD + EC_QB + h * 128;
            const bf16_t* Kg = proj + (size_t)(b * T) * LD + EC_KB + h * 128;
            const bf16_t* Vg = proj + (size_t)(b * T) * LD + EC_VB + h * 128;
            const float* cfh = cf + (size_t)(b * 8 + h) * T;
            bf16x8 qr[8];
#pragma unroll
            for (int d0 = 0; d0 < 8; ++d0) qr[d0] = *(const bf16x8*)(Qg + d0 * 16 + hi * 8);
            const float crefS = cfh[P0 + 255] * INV_SCALE;
            float m_reg = -1e30f, l_reg = 0.f; f32x16 o[4] = {};
            const int ntile = 4 * qb + 4;
            int jlo;
            { const float bnd = 2.f * sqrtf(__uint_as_float(nrm[(b * 8 + h) * 2]) * __uint_as_float(nrm[(b * 8 + h) * 2 + 1])) * SCALE * 1.02f + cfh[P0];
              const bool keep = (lane >= 4 * qb) || (bnd - cfh[lane * 64 + 63] >= -36.f);
              jlo = __builtin_amdgcn_readfirstlane(__builtin_ctzll(__ballot(keep))); }
            const int nT = ntile - jlo;
#define FOX_ISSUE(k_) do { const int t_ = jlo + (k_), s_ = (k_) & 3; kv_dma(lds + s_ * KVBUF, Kg + (size_t)(t_ * 64) * LD, Vg + (size_t)(t_ * 64) * LD, LD, ko, wid); \
                __builtin_amdgcn_global_load_lds((const unsigned*)(cfh + t_ * 64 + lane), (LAS unsigned*)(cfr + s_ * 512), 4, 0, 0); } while (0)
            __syncthreads();
            int kb = 0; const LAS float* kbb = cfr;
            pingpong_attn<5>(nT, wid, lds, vb0, qr, o, m_reg, l_reg, al_l, r32, hi,
                [&](int k) { FOX_ISSUE(k); },
                [&](int s) { kb = (jlo + s) * 64; kbb = cfr + (s & 3) * 512; return kb <= qpos0 + 31; },
                [&](int, f32x16& p0, f32x16& p1) {
#pragma unroll
                    for (int g4 = 0; g4 < 4; ++g4) { const f32x4 b0 = *(const LAS f32x4*)(kbb + 8 * g4 + 4 * hi), b1 = *(const LAS f32x4*)(kbb + 32 + 8 * g4 + 4 * hi);
#pragma unroll
                        for (int i = 0; i < 4; ++i) { p0[4 * g4 + i] += fmaf(b0[i], -INV_SCALE, crefS); p1[4 * g4 + i] += fmaf(b1[i], -INV_SCALE, crefS); } }
                    if (kb + 63 > qpos0) {
                        const int dq = qpos0 + r32 - kb - 4 * hi; const float NEG = -__builtin_inff();
#pragma unroll
                        for (int r = 0; r < 16; ++r) { const int c = (r & 3) + 8 * (r >> 2); if (dq - c < 0) p0[r] = NEG; if (dq - c - 32 < 0) p1[r] = NEG; }
                    }
                });
#undef FOX_ISSUE
            float rs[16]; lanes_to_rows(__builtin_amdgcn_rcpf(l_reg), rs, al_l, r32, hi);
            store_o_bf16(o, rs, mix + (size_t)(b * T + qpos0) * D + 1024 + h * 128, D, r32, hi);
        } else {
            const int i2 = it - 1024, qb = i2 & 63, bg = i2 >> 6, b = bg >> 1, g = bg & 1;
            const int hl = wid >> 1, head = g * 4 + hl, P0 = qb * 64, qpos0 = P0 + (wid & 1) * 32;
            const bf16_t* Qg = proj + (size_t)(b * T + qpos0 + r32) * LD + EC_QA + head * 128;
            const bf16_t* Kg = proj + (size_t)(b * T) * LD + EC_KA + g * 128;
            const bf16_t* Vg = proj + (size_t)(b * T) * LD + EC_VA + g * 128;
            bf16x8 qr[8];
#pragma unroll
            for (int d0 = 0; d0 < 8; ++d0) qr[d0] = *(const bf16x8*)(Qg + d0 * 16 + hi * 8);
            float m_reg = sinks[head] * INV_SCALE, l_reg = 1.f; f32x16 o[4] = {};
            const LAS float* tb = tab + head * 128;
            const int jt0 = (qb >= 2 ? qb - 2 : 0), nT = qb - jt0 + 1;
            __syncthreads();
            int kb = 0;
            pingpong_attn<4>(nT, wid, lds, vb0, qr, o, m_reg, l_reg, al_l, r32, hi,
                [&](int k) { kv_dma(lds + (k & 3) * KVBUF, Kg + (size_t)((jt0 + k) * 64) * LD, Vg + (size_t)((jt0 + k) * 64) * LD, LD, ko, wid); },
                [&](int s) { kb = (jt0 + s) * 64; return kb <= qpos0 + 31 && kb + 63 >= qpos0 - 127; },
                [&](int, f32x16& p0, f32x16& p1) {
                    const int dq = qpos0 + r32 - kb - 4 * hi; const float NEG = -__builtin_inff();
#pragma unroll
                    for (int r = 0; r < 16; ++r) { const int c = (r & 3) + 8 * (r >> 2); const int d0_ = dq - c, d1_ = dq - c - 32;
                        float t0 = tb[d0_ & 127], t1 = tb[d1_ & 127];
                        asm("" : "+v"(t0), "+v"(t1));
                        p0[r] = ((unsigned)d0_ < 128u) ? p0[r] + t0 : NEG; p1[r] = ((unsigned)d1_ < 128u) ? p1[r] + t1 : NEG; }
                });
            float rs[16]; lanes_to_rows(__builtin_amdgcn_rcpf(l_reg), rs, al_l, r32, hi);
            store_o_bf16(o, rs, mix + (size_t)(b * T + qpos0) * D + head * 128, D, r32, hi);
        }
    }
    __syncthreads();
}

#define N_EVEN_PHASES 5
#define even_mixer_phases \
    PH_BEGIN { pg8::Gemm g{RES, (const bf16_t*)(ws + WS_W_EV_IN + j * SZ_W_EV_IN), M, EC_F, D, D}; pg8::StaticOrder S; S.init(M, EC_F, F.G, F.bid);     \
               pg8::EpiStoreBf16 E{PROJ, EV_NP, RSTD}; pg8::gemm_phase(F.lds, g, S, E); } PH_END \
    PH_BEGIN fscan_phase(F, PROJ, F.in[I_EV_BF] + j * 8, (float*)(ws + WS_CF)); fox_norm_phase(F, PROJ, F.ctl + CW_NORM + j * 128); PH_END \
    PH_BEGIN even_attn_phase(F, PROJ, HB, (const float*)(ws + WS_CF), F.in[I_RELB], F.in[I_EV_SINK] + j * 8, F.ctl + CW_NORM + j * 128, F.ctl + CW_QUEUE + 64 * (4 + j)); PH_END \
    PH_BEGIN { pg8::Gemm g{HB, (const bf16_t*)(ws + WS_W_EV_OUT + j * SZ_W_OUT), M, D, D, D}; pg8::StaticOrder S; S.init(M, D, F.G, F.bid); \
               pg8::EpiAddRes E{RES, D}; pg8::gemm_phase(F.lds, g, S, E); } PH_END \
    PH_BEGIN rowstat_phase(F, RES, RSTD); PH_END
namespace gdn {
constexpr int RLD = 260, AMLD = 68;
constexpr int L_R = 0, L_KB16 = 64 * RLD * 4, L_QB16 = L_KB16 + 64 * 272, L_AM = L_QB16 + 64 * 272, L_GAM = L_AM + 64 * AMLD * 4, L_BETA = L_GAM + 256, L_BEG = L_BETA + 256, L_END = L_BEG + 256, L_WL = L_END + 16  , L_END2 = L_WL + 3 * 4 * 128 * 4;
static_assert(L_END2 <= LDS_BARW && (L_KB16 % 16) == 0 && (L_AM % 16) == 0 && (L_WL % 16) == 0, "gdn lds");
constexpr int RS16 = 272;

__device__ __forceinline__ void chunk_phase(const Frame& F, const bf16_t* __restrict__ proj, const float* __restrict__ convw, const float* __restrict__ alog, const float* __restrict__ dtb, unsigned* __restrict__ qhead) {
    LAS unsigned char* lds = F.lds;
    unsigned char* ws = F.ws;
    bf16_t* Ug = (bf16_t*)(ws + WS_G_U); bf16_t* Wg = (bf16_t*)(ws + WS_G_W); bf16_t* QGg = (bf16_t*)(ws + WS_G_QG); bf16_t* KTg = (bf16_t*)(ws + WS_G_KT);
    bf16_t* ATg = (bf16_t*)(ws + WS_G_ATT); float* GLg = (float*)(ws + WS_G_GL);
    LAS float* R = (LAS float*)(lds + L_R);
    LAS float* AM = (LAS float*)(lds + L_AM); LAS float* GAM = (LAS float*)(lds + L_GAM); LAS float* BETA = (LAS float*)(lds + L_BETA); LAS float* BEG = (LAS float*)(lds + L_BEG);
    LAS int* qi = (LAS int*)(lds + L_END);
    unsigned pend = 0u;
    if (threadIdx.x == 0) pend = __hip_atomic_fetch_add(qhead, 1u, __ATOMIC_RELAXED, __HIP_MEMORY_SCOPE_AGENT);
    for (;;) {
        __syncthreads();
        if (threadIdx.x == 0) { *qi = (int)pend; pend = __hip_atomic_fetch_add(qhead, 1u, __ATOMIC_RELAXED, __HIP_MEMORY_SCOPE_AGENT); }
        __syncthreads();
        const int ci = __builtin_amdgcn_readfirstlane(*qi);
        if (ci >= NCHUNK) break;
        const int n = ci & 63, bh = ci >> 6, b = bh >> 3, h = bh & 7, t0 = n * 64;
        const int tl = opaque_tid(), c0 = (tl & 15) * 8, i0 = tl >> 4;
        u32x4 xv[3][2][4];
#pragma unroll
        for (int which = 0; which < 3; ++which) {
            const int pcol = (which == 0 ? OC_QD : which == 1 ? OC_KD : OC_VD) + h * 128;
#pragma unroll
            for (int e = 0; e < 2; ++e)
#pragma unroll
                for (int jj = 0; jj < 4; ++jj) { const int t = t0 + i0 + e * 32 - 3 + jj, tc = t < 0 ? 0 : t;
                    xv[which][e][jj] = *(const u32x4*)(proj + (size_t)(b * T + tc) * OD_NP + pcol + c0); }
        }
        f32x4 wld = (f32x4){0.f, 0.f, 0.f, 0.f};
        if (tl < 384) { const int wh = tl >> 7, jj = (tl & 127) >> 5, c4 = tl & 31; wld = *(const f32x4*)(convw + (size_t)jj * 3072 + wh * 1024 + h * 128 + c4 * 4); }
        float bl = 0.f, al = 0.f;
        if (tl < 64) { const size_t row = (size_t)(b * T + t0 + tl) * OD_NP; bl = bf2f(proj[row + OC_BETA + h]); al = bf2f(proj[row + OC_A + h]); }
        LAS float* WL = (LAS float*)(lds + L_WL);
        if (tl < 384) *(LAS f32x4*)(WL + ((tl >> 7) * 4 + ((tl & 127) >> 5)) * 128 + (tl & 31) * 4) = wld;
        if (tl < 64) {
            const float x = al + dtb[h];
            const float sp = fmaxf(x, 0.f) + log1pf(__expf(-fabsf(x)));
            float g = -__expf(alog[h]) * sp;
#pragma unroll
            for (int o = 1; o < 64; o <<= 1) { const float nb = shu(g, o); if (tl >= o) g += nb; }
            const float be = sigmoidf_(bl); GAM[tl] = g; BETA[tl] = be; BEG[tl] = be * __expf(g);
            if (tl == 63) GLg[ci] = __expf(g);
        }
        __syncthreads();
#pragma unroll
        for (int which = 0; which < 3; ++which) {
            f32x4 wa[4], wb[4];
#pragma unroll
            for (int jj = 0; jj < 4; ++jj) { wa[jj] = *(LAS f32x4*)(WL + (which * 4 + jj) * 128 + c0); wb[jj] = *(LAS f32x4*)(WL + (which * 4 + jj) * 128 + c0 + 4); }
#pragma unroll
            for (int e = 0; e < 2; ++e) {
                const int i = i0 + e * 32;
                float acc[8];
#pragma unroll
                for (int q = 0; q < 8; ++q) acc[q] = 0.f;
#pragma unroll
                for (int jj = 0; jj < 4; ++jj) {
                    const float vz = (t0 + i - 3 + jj >= 0) ? 1.f : 0.f; const u32x4 x = xv[which][e][jj];
                    const f32x4 a_ = wa[jj] * vz, b_ = wb[jj] * vz;
                    acc[0] += a_[0] * bflo(x.x); acc[1] += a_[1] * bfhi(x.x); acc[2] += a_[2] * bflo(x.y); acc[3] += a_[3] * bfhi(x.y);
                    acc[4] += b_[0] * bflo(x.z); acc[5] += b_[1] * bfhi(x.z); acc[6] += b_[2] * bflo(x.w); acc[7] += b_[3] * bfhi(x.w);
                }
                float ss = 0.f;
#pragma unroll
                for (int q = 0; q < 8; ++q) { acc[q] = siluf_(acc[q]); ss += acc[q] * acc[q]; }
                if (which < 2) {
                    ss = row16_sum(ss);
                    const float rn = rsqrtf(ss + EPS) * (which == 0 ? SCALE : 1.f);
#pragma unroll
                    for (int q = 0; q < 8; ++q) acc[q] *= rn;
                    u32x4 w; w.x = cvt_pk_bf16(acc[0], acc[1]); w.y = cvt_pk_bf16(acc[2], acc[3]); w.z = cvt_pk_bf16(acc[4], acc[5]); w.w = cvt_pk_bf16(acc[6], acc[7]);
                    *(LAS u32x4*)(lds + (which == 0 ? L_QB16 : L_KB16) + i * RS16 + c0 * 2) = w;
                }
                if (which >= 1) { const float sc = (which == 1) ? BEG[i] : BETA[i]; LAS float* dst = R + i * RLD + (which == 1 ? 128 : 0) + c0;
                    *(LAS f32x4*)dst = (f32x4){acc[0], acc[1], acc[2], acc[3]} * sc; *(LAS f32x4*)(dst + 4) = (f32x4){acc[4], acc[5], acc[6], acc[7]} * sc; }
            }
        }
        __syncthreads();
        {
            const int t2 = opaque_tid(), wid = __builtin_amdgcn_readfirstlane(t2 >> 6), lane = t2 & 63, r32 = lane & 31, hi = lane >> 5;
            const int mat = wid >> 2, ti = (wid >> 1) & 1, tj = wid & 1;
            f32x16 acc = {};
            if (!(ti == 0 && tj == 1)) {
                LAS unsigned char* xa = lds + (mat == 0 ? L_KB16 : L_QB16) + (32 * ti + r32) * RS16 + hi * 16;
                LAS unsigned char* xb = lds + L_KB16 + (32 * tj + r32) * RS16 + hi * 16;
#pragma unroll
                for (int ks = 0; ks < 8; ++ks) acc = __builtin_amdgcn_mfma_f32_32x32x16_bf16(*(LAS bf16x8*)(xa + ks * 32), *(LAS bf16x8*)(xb + ks * 32), acc, 0, 0, 0);
            }
            const int jc = 32 * tj + r32; const float gj = GAM[jc];
#pragma unroll
            for (int r = 0; r < 16; ++r) {
                const int i = 32 * ti + att::crow(r, hi);
                const float dec = __expf(fminf(GAM[i] - gj, 0.f));
                if (mat == 0) AM[i * AMLD + jc] = (jc < i) ? acc[r] * BETA[i] * dec : 0.f;
                else ATg[(size_t)ci * 4096 + i * 64 + jc] = f2bf((jc <= i) ? acc[r] * dec : 0.f);
            }
        }
        __syncthreads();
        const int tid3 = opaque_tid();
        {
            { const int i = tid3 >> 3, c0 = (tid3 & 7) * 16; const float eg = __expf(GAM[i]);
#pragma unroll
              for (int q8 = 0; q8 < 2; ++q8) { const u32x4 x = *(LAS u32x4*)(lds + L_QB16 + i * RS16 + (c0 + q8 * 8) * 2);
                  u32x4 w; w.x = cvt_pk_bf16(bflo(x.x) * eg, bfhi(x.x) * eg); w.y = cvt_pk_bf16(bflo(x.y) * eg, bfhi(x.y) * eg);
                  w.z = cvt_pk_bf16(bflo(x.z) * eg, bfhi(x.z) * eg); w.w = cvt_pk_bf16(bflo(x.w) * eg, bfhi(x.w) * eg);
                  *(u32x4*)(QGg + (size_t)ci * 8192 + i * 128 + c0 + q8 * 8) = w; } }
            { const int dk = tid3 >> 2, i0 = (tid3 & 3) * 16; const float gl = GAM[63];
#pragma unroll
              for (int q8 = 0; q8 < 2; ++q8) { float v[8];
#pragma unroll
                  for (int e = 0; e < 8; ++e) { const int i = i0 + q8 * 8 + e; v[e] = bf2f(*(LAS bf16_t*)(lds + L_KB16 + i * RS16 + dk * 2)) * __expf(gl - GAM[i]); }
                  u32x4 w; w.x = cvt_pk_bf16(v[0], v[1]); w.y = cvt_pk_bf16(v[2], v[3]); w.z = cvt_pk_bf16(v[4], v[5]); w.w = cvt_pk_bf16(v[6], v[7]);
                  *(u32x4*)(KTg + (size_t)ci * 8192 + dk * 64 + i0 + q8 * 8) = w; } }
        }
        {
            const int l3 = tid3 & 63, ln = l3 & 15, lk = l3 >> 4, w3 = __builtin_amdgcn_readfirstlane(tid3 >> 6);
            LAS float* Ro = R; LAS float* AMo = AM;
            asm volatile("" : "+v"(Ro), "+v"(AMo));
#pragma unroll
            for (int bb = 0; bb < 4; ++bb) {
                if (bb > 0) {
                    const int col0 = w3 * 32 + ln, col1 = col0 + 16;
                    f32x4 c0v, c1v;
#pragma unroll
                    for (int r = 0; r < 4; ++r) { c0v[r] = Ro[(16 * bb + 4 * lk + r) * RLD + col0]; c1v[r] = Ro[(16 * bb + 4 * lk + r) * RLD + col1]; }
#pragma unroll
                    for (int bp = 0; bp < bb; ++bp)
#pragma unroll
                        for (int s = 0; s < 4; ++s) {
                            const float am = -AMo[(16 * bb + ln) * AMLD + 16 * bp + 4 * s + lk];
                            const float x0 = Ro[(16 * bp + 4 * s + lk) * RLD + col0], x1 = Ro[(16 * bp + 4 * s + lk) * RLD + col1];
                            c0v = __builtin_amdgcn_mfma_f32_16x16x4f32(am, x0, c0v, 0, 0, 0);
                            c1v = __builtin_amdgcn_mfma_f32_16x16x4f32(am, x1, c1v, 0, 0, 0);
                        }
#pragma unroll
                    for (int r = 0; r < 4; ++r) { Ro[(16 * bb + 4 * lk + r) * RLD + col0] = c0v[r]; Ro[(16 * bb + 4 * lk + r) * RLD + col1] = c1v[r]; }
                    __syncthreads();
                }
                if (tid3 < 256) {
                    LAS float* rc = Ro + (16 * bb) * RLD + tid3;
                    float x[16];
#pragma unroll
                    for (int i = 0; i < 16; ++i) x[i] = rc[i * RLD];
#pragma unroll
                    for (int i = 1; i < 16; ++i) {
#pragma unroll
                        for (int j4 = 0; j4 < (i + 3) / 4; ++j4) {
                            const f32x4 am = *(LAS f32x4*)(AMo + (16 * bb + i) * AMLD + 16 * bb + j4 * 4);
#pragma unroll
                            for (int e = 0; e < 4; ++e) if (j4 * 4 + e < i) x[i] -= am[e] * x[j4 * 4 + e];
                        }
                    }
#pragma unroll
                    for (int i = 1; i < 16; ++i) rc[i * RLD] = x[i];
                }
                __syncthreads();
            }
        }
        {
            const int tid4 = opaque_tid();
#pragma unroll
            for (int e = 0; e < 4; ++e) { const int idx = tid4 + e * NTHR, i = idx >> 5, ch = idx & 31;
                const f32x4 a0 = *(LAS f32x4*)(R + i * RLD + ch * 8), a1 = *(LAS f32x4*)(R + i * RLD + ch * 8 + 4);
                const float sg = ch < 16 ? 1.f : -1.f;
                u32x4 w; w.x = cvt_pk_bf16(a0[0] * sg, a0[1] * sg); w.y = cvt_pk_bf16(a0[2] * sg, a0[3] * sg); w.z = cvt_pk_bf16(a1[0] * sg, a1[1] * sg); w.w = cvt_pk_bf16(a1[2] * sg, a1[3] * sg);
                *(u32x4*)((ch < 16 ? Ug : Wg) + (size_t)ci * 8192 + i * 128 + (ch & 15) * 8) = w; }
        }
    }
    __syncthreads();
}

__device__ __forceinline__ bf16x8 ld_afrag(const bf16_t* __restrict__ rowp, int hi) {
    const u32x2 a = *(const u32x2*)(rowp + 4 * hi), b = *(const u32x2*)(rowp + 8 + 4 * hi);
    u32x4 w = {a.x, a.y, b.x, b.y}; return *reinterpret_cast<bf16x8*>(&w);
}
__device__ __forceinline__ bf16x8 acc_bfrag(const f32x16& x, int s) {
    u32x4 w = {cvt_pk_bf16(x[8 * s + 0], x[8 * s + 1]), cvt_pk_bf16(x[8 * s + 2], x[8 * s + 3]), cvt_pk_bf16(x[8 * s + 4], x[8 * s + 5]), cvt_pk_bf16(x[8 * s + 6], x[8 * s + 7])};
    return *reinterpret_cast<bf16x8*>(&w);
}

constexpr int SL_W = 0, SL_QG = SL_W + 64 * 272, SL_KT = SL_QG + 64 * 272, SL_AT = SL_KT + 128 * 144, SL_U = SL_AT + 64 * 144, SL_OS = SL_U + 64 * 256, SL_END = SL_OS + 64 * 132 * 4;
static_assert(SL_END <= LDS_BARW, "scan lds");
__device__ __forceinline__ bf16x8 ld_afrag_lds(const LAS unsigned char* rowp, int hi) {
    const u32x2 a = *(const LAS u32x2*)(rowp + 8 * hi), b = *(const LAS u32x2*)(rowp + 16 + 8 * hi);
    u32x4 w = {a.x, a.y, b.x, b.y}; return *reinterpret_cast<bf16x8*>(&w);
}
__device__ __forceinline__ void scan_item(const Frame& F, int bh, const bf16_t* __restrict__ proj, bf16_t* __restrict__ mix, const float* __restrict__ gnorm) {
    LAS unsigned char* lds = F.lds;
    const int tid = opaque_tid(), wid = __builtin_amdgcn_readfirstlane(tid >> 6), lane = tid & 63, r32 = lane & 31, hi = lane >> 5;
    unsigned char* ws = F.ws;
    const bf16_t* Ug = (const bf16_t*)(ws + WS_G_U); const bf16_t* Wg = (const bf16_t*)(ws + WS_G_W); const bf16_t* QGg = (const bf16_t*)(ws + WS_G_QG); const bf16_t* KTg = (const bf16_t*)(ws + WS_G_KT);
    const bf16_t* ATg = (const bf16_t*)(ws + WS_G_ATT); const float* GLg = (const float*)(ws + WS_G_GL);
    LAS float* OS = (LAS float*)(lds + SL_OS);
    const int b = bh >> 3, h = bh & 7;
    const bool loader = wid >= 4;
    u32x4 st[18];
#define SCAN_LOAD(ci_) do { const size_t c_ = (size_t)(ci_); const int lt = opaque_tid() & 255;     \
        _Pragma("unroll") for (int e = 0; e < 4; ++e) { const int idx = lt + 256 * e; \
            st[e]      = *(const u32x4*)(Wg  + c_ * 8192 + (idx >> 4) * 128 + (idx & 15) * 8); \
            st[4 + e]  = *(const u32x4*)(QGg + c_ * 8192 + (idx >> 4) * 128 + (idx & 15) * 8); \
            st[8 + e]  = *(const u32x4*)(KTg + c_ * 8192 + (idx >> 3) * 64 + (idx & 7) * 8); \
            st[12 + e] = *(const u32x4*)(Ug  + c_ * 8192 + (idx >> 4) * 128 + (idx & 15) * 8); } \
        _Pragma("unroll") for (int e = 0; e < 2; ++e) { const int idx = lt + 256 * e; st[16 + e] = *(const u32x4*)(ATg + c_ * 4096 + (idx >> 3) * 64 + (idx & 7) * 8); } } while (0)
#define SCAN_STORE() do { const int lt = opaque_tid() & 255; \
        _Pragma("unroll") for (int e = 0; e < 4; ++e) { const int idx = lt + 256 * e; \
            *(LAS u32x4*)(lds + SL_W  + (idx >> 4) * 272 + (idx & 15) * 16) = st[e]; \
            *(LAS u32x4*)(lds + SL_QG + (idx >> 4) * 272 + (idx & 15) * 16) = st[4 + e]; \
            *(LAS u32x4*)(lds + SL_KT + (idx >> 3) * 144 + (idx & 7) * 16) = st[8 + e]; \
            *(LAS u32x4*)(lds + SL_U  + (idx >> 4) * 256 + (idx & 15) * 16) = st[12 + e]; } \
        _Pragma("unroll") for (int e = 0; e < 2; ++e) { const int idx = lt + 256 * e; *(LAS u32x4*)(lds + SL_AT + (idx >> 3) * 144 + (idx & 7) * 16) = st[16 + e]; } } while (0)
    const int ci0 = bh * 64;
    const int ni = tid >> 3, nc0 = (tid & 7) * 16;
    const bf16_t* zbase = proj + (size_t)(b * T + ni) * OD_NP + OC_Z + h * 128 + nc0;
    u32x4 z0 = *(const u32x4*)zbase, z1 = *(const u32x4*)(zbase + 8);
    float glv = GLg[ci0];
    if (loader) SCAN_LOAD(ci0);
    __syncthreads();
    if (loader) { SCAN_STORE(); SCAN_LOAD(ci0 + 1); }
    __syncthreads();
    f32x16 S[4] = {};
#pragma unroll 1
    for (int n = 0; n < 64; ++n) {
        if (!loader) {
            const int c0 = 32 * wid;
            bf16x8 vb[2][2];
#pragma unroll
            for (int mt = 0; mt < 2; ++mt) {
                f32x16 vn;
#pragma unroll
                for (int r = 0; r < 16; ++r) vn[r] = bf2f(*(const LAS bf16_t*)(lds + SL_U + (32 * mt + att::crow(r, hi)) * 256 + (c0 + r32) * 2));
                const LAS unsigned char* wrow = lds + SL_W + (32 * mt + r32) * 272;
#pragma unroll
                for (int kt = 0; kt < 4; ++kt)
#pragma unroll
                    for (int s = 0; s < 2; ++s) vn = __builtin_amdgcn_mfma_f32_32x32x16_bf16(ld_afrag_lds(wrow + (kt * 32 + s * 16) * 2, hi), acc_bfrag(S[kt], s), vn, 0, 0, 0);
                vb[mt][0] = acc_bfrag(vn, 0); vb[mt][1] = acc_bfrag(vn, 1);
            }
#pragma unroll
            for (int mt = 0; mt < 2; ++mt) {
                f32x16 oa = {};
                const LAS unsigned char* qrow = lds + SL_QG + (32 * mt + r32) * 272;
#pragma unroll
                for (int kt = 0; kt < 4; ++kt)
#pragma unroll
                    for (int s = 0; s < 2; ++s) oa = __builtin_amdgcn_mfma_f32_32x32x16_bf16(ld_afrag_lds(qrow + (kt * 32 + s * 16) * 2, hi), acc_bfrag(S[kt], s), oa, 0, 0, 0);
                const LAS unsigned char* arow = lds + SL_AT + (32 * mt + r32) * 144;
#pragma unroll
                for (int m2 = 0; m2 <= mt; ++m2)
#pragma unroll
                    for (int s = 0; s < 2; ++s) oa = __builtin_amdgcn_mfma_f32_32x32x16_bf16(ld_afrag_lds(arow + (m2 * 32 + s * 16) * 2, hi), vb[m2][s], oa, 0, 0, 0);
#pragma unroll
                for (int r = 0; r < 16; ++r) OS[(32 * mt + att::crow(r, hi)) * 132 + c0 + r32] = oa[r];
            }
#pragma unroll
            for (int kt = 0; kt < 4; ++kt) {
#pragma unroll
                for (int r = 0; r < 16; ++r) S[kt][r] *= glv;
                const LAS unsigned char* krow = lds + SL_KT + (32 * kt + r32) * 144;
#pragma unroll
                for (int m2 = 0; m2 < 2; ++m2)
#pragma unroll
                    for (int s = 0; s < 2; ++s) S[kt] = __builtin_amdgcn_mfma_f32_32x32x16_bf16(ld_afrag_lds(krow + (m2 * 32 + s * 16) * 2, hi), vb[m2][s], S[kt], 0, 0, 0);
            }
        }
        __syncthreads();
        {
            const int t = n * 64 + ni;
            float v[16]; float ss = 0.f;
#pragma unroll
            for (int q = 0; q < 4; ++q) { const f32x4 x = *(LAS f32x4*)(OS + ni * 132 + nc0 + q * 4); v[q * 4] = x[0]; v[q * 4 + 1] = x[1]; v[q * 4 + 2] = x[2]; v[q * 4 + 3] = x[3]; }
#pragma unroll
            for (int q = 0; q < 16; ++q) ss += v[q] * v[q];
            ss += shx(ss, 1); ss += shx(ss, 2); ss += shx(ss, 4);
            const float rn = rsqrtf(ss * (1.f / 128.f) + EPS);
            const float z[16] = {bflo(z0.x), bfhi(z0.x), bflo(z0.y), bfhi(z0.y), bflo(z0.z), bfhi(z0.z), bflo(z0.w), bfhi(z0.w),
                                 bflo(z1.x), bfhi(z1.x), bflo(z1.y), bfhi(z1.y), bflo(z1.z), bfhi(z1.z), bflo(z1.w), bfhi(z1.w)};
            float y[16];
#pragma unroll
            for (int q = 0; q < 16; ++q) y[q] = v[q] * rn * gnorm[nc0 + q] * siluf_(z[q]);
            u32x4 w0, w1;
            w0.x = cvt_pk_bf16(y[0], y[1]); w0.y = cvt_pk_bf16(y[2], y[3]); w0.z = cvt_pk_bf16(y[4], y[5]); w0.w = cvt_pk_bf16(y[6], y[7]);
            w1.x = cvt_pk_bf16(y[8], y[9]); w1.y = cvt_pk_bf16(y[10], y[11]); w1.z = cvt_pk_bf16(y[12], y[13]); w1.w = cvt_pk_bf16(y[14], y[15]);
            bf16_t* mrow = mix + (size_t)(b * T + t) * D + 1024 + h * 128 + nc0;
            *(u32x4*)mrow = w0; *(u32x4*)(mrow + 8) = w1;
            if (n + 1 < 64) { const bf16_t* zn = zbase + (size_t)((n + 1) * 64) * OD_NP; z0 = *(const u32x4*)zn; z1 = *(const u32x4*)(zn + 8); glv = GLg[ci0 + n + 1]; }
        }
        if (loader && n + 1 < 64) { SCAN_STORE(); if (n + 2 < 64) SCAN_LOAD(ci0 + n + 2); }
        __syncthreads();
    }
#undef SCAN_LOAD
#undef SCAN_STORE
}
}
namespace pg8 {
struct EpiProjOdd {
    static constexpr bool PERM = true;
    bf16_t* O; int ldc; bf16_t* kcmp; bf16_t* vcmp; const float* rs;
    __device__ __forceinline__ void prefetch(const Unit& u, int ui) const { rs_prefetch(rs, u.pm, ui); }
    __device__ __forceinline__ void operator()(const f32x4 (&acc)[2][2][4][2], const Unit& u, int wr, int wc, int ui, int) const {
        const int ol_ = opaque_tid() & 63, fr = ol_ & 15, fq = ol_ >> 4;
        const int row0 = u.pm * BM + wr * 64 + fr, col0 = u.pn * BM + wc * 32 + 8 * fq;
        const bool cmp = (u.pn == 8 || u.pn == 9);
        bf16_t* cb = (u.pn == 8) ? kcmp : vcmp;
        float r_[2][4];
        rs_read(r_, ui, wr, fr);
#pragma unroll
        for (int ai = 0; ai < 2; ++ai)
#pragma unroll
            for (int m = 0; m < 4; ++m) { const int row = row0 + ai * HALF + m * 16; const float r = r_[ai][m];
#pragma unroll
                for (int bj = 0; bj < 2; ++bj) { const f32x4 v0 = acc[ai][bj][m][0] * r, v1 = acc[ai][bj][m][1] * r;
                    u32x4 w; w.x = cvt_pk_bf16(v0[0], v0[1]); w.y = cvt_pk_bf16(v0[2], v0[3]); w.z = cvt_pk_bf16(v1[0], v1[1]); w.w = cvt_pk_bf16(v1[2], v1[3]);
                    bf16_t* p = cmp ? cb + ((size_t)((row / T) * 2 + bj) * T + (row % T)) * 128 + wc * 32 + 8 * fq
                                    : O + (size_t)row * ldc + col0 + bj * HALF;
                    *(u32x4*)p = w; } }
    }
};
__device__ __forceinline__ float gelu_tanh(float x) { const float y = 0.7978845608028654f * (x + 0.044715f * x * x * x); return x * __builtin_amdgcn_rcpf(1.f + __expf(-2.f * y)); }
struct EpiGeluBf16 {
    static constexpr bool PERM = true;
    bf16_t* O; int ldc; const float* bias;
    __device__ __forceinline__ void prefetch(const Unit&, int) const {}
    __device__ __forceinline__ void operator()(const f32x4 (&acc)[2][2][4][2], const Unit& u, int wr, int wc, int, int) const {
        const int ol_ = opaque_tid() & 63, fr = ol_ & 15, fq = ol_ >> 4;
        const int row0 = u.pm * BM + wr * 64 + fr, col0 = u.pn * BM + wc * 32 + 8 * fq;
#pragma unroll
        for (int bj = 0; bj < 2; ++bj) { f32x4 b0 = (f32x4){0.f, 0.f, 0.f, 0.f}, b1 = b0;
#pragma unroll 8
            for (int pp = 0; pp < 32; ++pp) { b0 += *(const f32x4*)(bias + pp * 256 + col0 + bj * HALF); b1 += *(const f32x4*)(bias + pp * 256 + col0 + bj * HALF + 4); }
#pragma unroll
            for (int ai = 0; ai < 2; ++ai)
#pragma unroll
                for (int m = 0; m < 4; ++m) { const f32x4 v0 = acc[ai][bj][m][0] + b0, v1 = acc[ai][bj][m][1] + b1;
                    u32x4 w; w.x = cvt_pk_bf16(gelu_tanh(v0[0]), gelu_tanh(v0[1])); w.y = cvt_pk_bf16(gelu_tanh(v0[2]), gelu_tanh(v0[3]));
                    w.z = cvt_pk_bf16(gelu_tanh(v1[0]), gelu_tanh(v1[1])); w.w = cvt_pk_bf16(gelu_tanh(v1[2]), gelu_tanh(v1[3]));
                    *(u32x4*)(O + (size_t)(row0 + ai * HALF + m * 16) * ldc + col0 + bj * HALF) = w; } }
    }
};
}

namespace nsa {
using namespace att;
constexpr int IMP_LD = 257, SC_LD = 65;
constexpr int L_IMP = 2 * att::KVBUF, L_SC = L_IMP + 64 * IMP_LD * 4  , L_WS = L_SC + 64 * SC_LD * 4, L_TAB = L_WS + 2048, L_BM = L_TAB + 8 * 129 * 4, L_QI = L_BM + 512, L_GATE = L_QI + 16  , L_ENDN = L_GATE + 4096;
static_assert(L_ENDN <= LDS_BARW && (L_IMP % 16) == 0 && L_IMP + 2 * att::KVBUF <= L_SC, "nsa lds");

template <int MODE>
__device__ __forceinline__ void branch_out(const f32x16* o, const float* rs, float* __restrict__ accw, bf16_t* __restrict__ Ow, int ldo, int, int) {
    const int l_ = opaque_tid() & 63, r32 = l_ & 31, hi = l_ >> 5;
    float* base = accw + 4 * hi * 128 + r32;
    float a[16][4];
    if (MODE != 0) {
#pragma unroll
        for (int r = 0; r < 16; ++r)
#pragma unroll
            for (int d0 = 0; d0 < 4; ++d0) a[r][d0] = base[((r & 3) + 8 * (r >> 2)) * 128 + d0 * 32];
    }
    if (MODE != 2) {
#pragma unroll
        for (int r = 0; r < 16; ++r)
#pragma unroll
            for (int d0 = 0; d0 < 4; ++d0) { const float v = o[d0][r] * rs[r]; base[((r & 3) + 8 * (r >> 2)) * 128 + d0 * 32] = (MODE == 0) ? v : a[r][d0] + v; }
    } else {
        unsigned w[16][4];
#pragma unroll
        for (int r = 0; r < 16; ++r)
#pragma unroll
            for (int d0 = 0; d0 < 4; ++d0) { const float v = o[d0][r] * rs[r] + a[r][d0]; const float vn = DPPF(v, 0xB1); w[r][d0] = cvt_pk_bf16(v, vn); }
        if ((r32 & 1) == 0) {
#pragma unroll
            for (int r = 0; r < 16; ++r) { const int orow = crow(r, hi);
#pragma unroll
                for (int d0 = 0; d0 < 4; ++d0) *(unsigned*)(Ow + (size_t)(orow >> 2) * ldo + (orow & 3) * 128 + d0 * 32 + r32) = w[r][d0]; }
        }
    }
}

__device__ __forceinline__ void nsa_item(const Frame& F, int item, const bf16_t* __restrict__ proj, bf16_t* __restrict__ mix, const float* __restrict__ relb) {
    LAS unsigned char* lds = F.lds;
    const int tid = opaque_tid(), wid = __builtin_amdgcn_readfirstlane(tid >> 6), lane = tid & 63, r32 = lane & 31, hi = lane >> 5;
    unsigned char* ws = F.ws;
    LAS float* al_l = (LAS float*)(lds + L_WS) + wid * 64;
    LAS float* tab = (LAS float*)(lds + L_TAB);
    LAS float* IMP = (LAS float*)(lds + L_IMP);
    LAS float* SC = (LAS float*)(lds + L_SC);
    LAS unsigned* BM = (LAS unsigned*)(lds + L_BM);
    const int vb0 = (int)(uintptr_t)(lds + L_V) + v_rd_base(lane);
    constexpr int LD = OD_NP;
    const int qb = 63 - (item >> 4), bg = item & 15, b = bg >> 1, g = bg & 1;
    const int P0 = qb * 64, qlo = P0 + wid * 8, qhi = qlo + 7, ql = wid * 8 + (r32 >> 2), hl = r32 & 3, head = g * 4 + hl, qpos = qlo + (r32 >> 2), cur = qb;
    float* accw = (float*)(ws + WS_NSAACC) + ((size_t)F.bid * 256 + wid * 32) * 128;
    __syncthreads();
    for (int i = tid; i < 64 * IMP_LD; i += NTHR) IMP[i] = 0.f;
    if (tid < 128) BM[tid] = 0u;
    const size_t qrow = (size_t)(b * T + qpos) * LD;
    bf16x8 qr[8];
#pragma unroll
    for (int d0 = 0; d0 < 8; ++d0) qr[d0] = *(const bf16x8*)(proj + qrow + OC_QC + head * 128 + d0 * 16 + hi * 8);
    { u32x2 gg; gg.x = (unsigned)proj[qrow + OC_GATE + head] | ((unsigned)proj[qrow + OC_GATE + 8 + head] << 16); gg.y = proj[qrow + OC_GATE + 16 + head];
      *(LAS u32x2*)(lds + L_GATE + tid * 8) = gg; }
#define gate01_ (((const LAS unsigned*)(lds + L_GATE))[opaque_tid() * 2])
#define gate2_  (((const LAS unsigned*)(lds + L_GATE))[opaque_tid() * 2 + 1])
#define NSA_GATE(br) sigmoidf_((br) == 0 ? bflo(gate01_) : (br) == 1 ? bfhi(gate01_) : bflo(gate2_))
    const LAS float* tb = tab + head * 129;
    const float NEG = -__builtin_inff();

    const bf16_t* KCg = (const bf16_t*)(ws + WS_KC) + (size_t)(bg * 256) * 256;
    const bf16_t* VCg = KCg + (size_t)4096 * 256;
    const int cmax = (qpos - 31) >> 4;
    const int cmax_wg = (P0 + 63 - 31) >> 4;
    const int nct = (cmax_wg >> 6) + 1;
    float m_reg = -1e30f, l_reg = 0.f;
    {
        const KvOff kc = kv_dma_off(tid, 256);
        kv_dma(lds, KCg, VCg, 256, kc, wid);
        float inv_l = 0.f, mL = 0.f;
        f32x16 o[4] = {};
        for (int s = 0; s < 2 * nct; ++s) {
            const int jt = s < nct ? s : s - nct, bo = (s & 1) * KVBUF;
            asm volatile("s_waitcnt vmcnt(0)" ::: "memory");
            RING_BAR();
            if (s + 1 < 2 * nct) { const int jn = (s + 1 < nct) ? s + 1 : s + 1 - nct; kv_dma(lds + (bo ^ KVBUF), KCg + (size_t)(jn * 64) * 256, VCg + (size_t)(jn * 64) * 256, 256, kc, wid); }
            if (s == nct) { inv_l = l_reg > 0.f ? 1.f / l_reg : 0.f; mL = -m_reg * C2; }
            f32x16 p0, p1; qkt(p0, p1, lds + bo, r32, hi, qr);
            if (s < nct) {
#pragma unroll
                for (int r = 0; r < 16; ++r) { const int c = jt * 64 + crow(r, hi); if (c > cmax) p0[r] = NEG; if (c + 32 > cmax) p1[r] = NEG; }
                float mn, alpha; partialSM(p0, p1, m_reg, mn, alpha);
                l_reg = l_reg * alpha + row_sum(p0, p1);
            } else {
                LAS float* ib = IMP + ql * IMP_LD + jt * 64 + 4 * hi;
#pragma unroll
                for (int r = 0; r < 16; ++r) { const int c = jt * 64 + crow(r, hi);
                    p0[r] = (c <= cmax) ? __builtin_amdgcn_exp2f(fmaf(p0[r], C2, mL)) * inv_l : 0.f;
                    p1[r] = (c + 32 <= cmax) ? __builtin_amdgcn_exp2f(fmaf(p1[r], C2, mL)) * inv_l : 0.f;
                    float s0 = p0[r], s1 = p1[r];
                    s0 += DPPF(s0, 0xB1); s1 += DPPF(s1, 0xB1); s0 += DPPF(s0, 0x4E); s1 += DPPF(s1, 0x4E);
                    if (hl == 0) { ib[(r & 3) + 8 * (r >> 2)] = s0; ib[(r & 3) + 8 * (r >> 2) + 32] = s1; } }
                bf16x8 pa0, pa1, pa2, pa3; pack_p(p0, p1, pa0, pa1, pa2, pa3);
                pv_tile(o, vb0 + bo, pa0, pa1, pa2, pa3);
            }
        }
        float rs[16]; lanes_to_rows(NSA_GATE(0), rs, al_l, r32, hi);
        branch_out<0>(o, rs, accw, nullptr, 0, r32, hi);
    }
    __syncthreads();
    {
        const int q = tid & 63, j0 = (tid >> 6) * 8;
        const LAS float* ip = IMP + q * IMP_LD;
#pragma unroll
        for (int e = 0; e < 8; ++e) { const int j = j0 + e;
            const float left = (j > 0) ? ip[4 * j - 1] : 0.f;
            const float blk = left + 2.f * (ip[4 * j] + ip[4 * j + 1] + ip[4 * j + 2]) + ip[4 * j + 3];
            const bool forced = (j == 0) || (j == cur) || (j == cur - 1);
            SC[q * SC_LD + j] = forced ? 1e9f : (j > cur ? -1e9f : blk); }
    }
    __syncthreads();
    {
        const int q = tid & 63, j0 = (tid >> 6) * 8;
        unsigned long long mine[8]; int rank[8];
#define NSA_KEY(sc_, j_) ((((unsigned long long)(__float_as_uint(sc_) ^ ((__float_as_uint(sc_) >> 31) ? 0xffffffffu : 0x80000000u))) << 6) | (unsigned)(63 - (j_)))
#pragma unroll
        for (int e = 0; e < 8; ++e) { const float v = SC[q * SC_LD + j0 + e]; mine[e] = NSA_KEY(v, j0 + e); rank[e] = 0; }
#pragma unroll 2
        for (int jj = 0; jj <= cur; ++jj) { const float sv = SC[q * SC_LD + jj]; const unsigned long long ks = NSA_KEY(sv, jj);
#pragma unroll
            for (int e = 0; e < 8; ++e) rank[e] += (ks > mine[e]) ? 1 : 0; }
#undef NSA_KEY
        unsigned bits = 0u;
#pragma unroll
        for (int e = 0; e < 8; ++e) if (rank[e] < 8 && (j0 + e) <= cur) bits |= 1u << e;
        if (bits) __hip_atomic_fetch_or(BM + q * 2 + (j0 >> 5), bits << (j0 & 31), __ATOMIC_RELAXED, __HIP_MEMORY_SCOPE_WORKGROUP);
    }
    __syncthreads();
    unsigned wu_lo, wu_hi, gu_lo, gu_hi;
    { unsigned a = BM[ql * 2], c = BM[ql * 2 + 1];
#pragma unroll
      for (int o_ = 1; o_ < 32; o_ <<= 1) { a |= shx(a, o_); c |= shx(c, o_); }
      wu_lo = __builtin_amdgcn_readfirstlane(a); wu_hi = __builtin_amdgcn_readfirstlane(c);
      unsigned a2 = BM[lane * 2], c2 = BM[lane * 2 + 1];
#pragma unroll
      for (int o_ = 1; o_ < 64; o_ <<= 1) { a2 |= shx(a2, o_); c2 |= shx(c2, o_); }
      gu_lo = __builtin_amdgcn_readfirstlane(a2); gu_hi = __builtin_amdgcn_readfirstlane(c2); }
    {
        const int tid = opaque_tid(), lane = tid & 63, r32 = lane & 31, hi = lane >> 5, qpos = qlo + (r32 >> 2), ql = wid * 8 + (r32 >> 2);
        const int vb0 = (int)(uintptr_t)(lds + L_V) + v_rd_base(lane);
        const KvOff ko = kv_dma_off(tid, LD);
        const bf16_t* Kg = proj + (size_t)(b * T) * LD + OC_KSEL + g * 128;
        const bf16_t* Vg = proj + (size_t)(b * T) * LD + OC_VSEL + g * 128;
        m_reg = -1e30f; l_reg = 0.f; f32x16 o[4] = {};
        unsigned long long remI = ((unsigned long long)gu_hi << 32) | gu_lo, remC = remI;
        const int nT = __builtin_popcountll(remI);
#define SEL_ISSUE(k_) do { const int jn = __builtin_ctzll(remI); remI &= remI - 1; kv_dma(lds + ((k_) & 3) * KVBUF, Kg + (size_t)(jn * 64) * LD, Vg + (size_t)(jn * 64) * LD, LD, ko, wid); } while (0)
        int jt = 0, kb = 0;
        dual_attn<4, 4>(nT, wid, lds, vb0, qr, o, m_reg, l_reg, al_l, r32, hi,
            [&](int k) { SEL_ISSUE(k); },
            [&](int) { jt = __builtin_ctzll(remC); remC &= remC - 1; kb = jt * 64; return ((jt < 32 ? wu_lo >> jt : wu_hi >> (jt - 32)) & 1u) != 0u; },
            [&](int, f32x16& p0, f32x16& p1) {
                const bool mysel = ((BM[ql * 2 + (jt >> 5)] >> (jt & 31)) & 1u) != 0u;
                const int dq = qpos - kb - 4 * hi;
                if (qlo - kb >= 190) {
                    const float tc = tb[127];
#pragma unroll
                    for (int r = 0; r < 16; ++r) { p0[r] = mysel ? p0[r] + tc : NEG; p1[r] = mysel ? p1[r] + tc : NEG; }
                } else {
#pragma unroll
                for (int r = 0; r < 16; ++r) { const int c = (r & 3) + 8 * (r >> 2); const int d0_ = dq - c, d1_ = dq - c - 32;
                    float t0 = tb[min(max(d0_, 0), 127)], t1 = tb[min(max(d1_, 0), 127)];
                    asm("" : "+v"(t0), "+v"(t1));
                    p0[r] = (mysel && d0_ >= 0) ? p0[r] + t0 : NEG; p1[r] = (mysel && d1_ >= 0) ? p1[r] + t1 : NEG; }
                }
            });
#undef SEL_ISSUE
        float rs[16]; lanes_to_rows(l_reg > 0.f ? NSA_GATE(1) * __builtin_amdgcn_rcpf(l_reg) : 0.f, rs, al_l, r32, hi);
        branch_out<1>(o, rs, accw, nullptr, 0, r32, hi);
    }
    {
        const int tid = opaque_tid(), lane = tid & 63, r32 = lane & 31, hi = lane >> 5, qpos = qlo + (r32 >> 2);
        const int vb0 = (int)(uintptr_t)(lds + L_V) + v_rd_base(lane);
        const KvOff ko = kv_dma_off(tid, LD);
        const bf16_t* Kg = proj + (size_t)(b * T) * LD + OC_KWIN + g * 128;
        const bf16_t* Vg = proj + (size_t)(b * T) * LD + OC_VWIN + g * 128;
        m_reg = -1e30f; l_reg = 0.f; f32x16 o[4] = {};
        const int jt0 = (qb >= 8 ? qb - 8 : 0), nT = qb - jt0 + 1;
#define WIN_ISSUE(k_) kv_dma(lds + ((k_) & 3) * KVBUF, Kg + (size_t)((jt0 + (k_)) * 64) * LD, Vg + (size_t)((jt0 + (k_)) * 64) * LD, LD, ko, wid)
        __syncthreads();
        int kb = 0;
        dual_attn<4, 4>(nT, wid, lds, vb0, qr, o, m_reg, l_reg, al_l, r32, hi,
            [&](int k) { WIN_ISSUE(k); },
            [&](int s) { kb = (jt0 + s) * 64; return kb <= qhi && kb + 63 >= qlo - 511; },
            [&](int, f32x16& p0, f32x16& p1) {
                const int dq = qpos - kb - 4 * hi;
                if (qlo - kb >= 190 && qhi - kb <= 511) {
                    const float tc = tb[127];
#pragma unroll
                    for (int r = 0; r < 16; ++r) { p0[r] += tc; p1[r] += tc; }
                } else {
#pragma unroll
                for (int r = 0; r < 16; ++r) { const int c = (r & 3) + 8 * (r >> 2); const int d0_ = dq - c, d1_ = dq - c - 32;
                    float t0 = tb[min(max(d0_, 0), 127)], t1 = tb[min(max(d1_, 0), 127)];
                    asm("" : "+v"(t0), "+v"(t1));
                    p0[r] = ((unsigned)d0_ < 512u) ? p0[r] + t0 : NEG; p1[r] = ((unsigned)d1_ < 512u) ? p1[r] + t1 : NEG; }
                }
            });
#undef WIN_ISSUE
        float rs[16]; lanes_to_rows(l_reg > 0.f ? NSA_GATE(2) * __builtin_amdgcn_rcpf(l_reg) : 0.f, rs, al_l, r32, hi);
        branch_out<2>(o, rs, accw, mix + (size_t)(b * T + qlo) * D + g * 512, D, r32, hi);
    }
#undef NSA_GATE
#undef gate01_
#undef gate2_
}

__device__ __forceinline__ void odd_attn_phase(const Frame& F, const bf16_t* __restrict__ proj, bf16_t* __restrict__ mix, const float* __restrict__ relb, const float* __restrict__ gnorm, unsigned* __restrict__ qhead) {
    for (int bh = F.bid; bh < NB * 8; bh += F.G) gdn::scan_item(F, bh, proj, mix, gnorm);
    LAS int* qi = (LAS int*)(F.lds + L_QI);
    __syncthreads();
    for (int i = opaque_tid(); i < 8 * 129; i += NTHR) { const int hd = i / 129, dist = i - hd * 129; ((LAS float*)(F.lds + L_TAB))[i] = relb[att::t5_bucket(dist < 128 ? dist : 127) * 8 + hd] * INV_SCALE; }
    for (;;) {
        __syncthreads();
        if (threadIdx.x == 0) *qi = (int)__hip_atomic_fetch_add(qhead, 1u, __ATOMIC_RELAXED, __HIP_MEMORY_SCOPE_AGENT);
        __syncthreads();
        const int item = __builtin_amdgcn_readfirstlane(*qi);
        if (item >= 1024) break;
        nsa_item(F, item, proj, mix, relb);
    }
    __syncthreads();
}
}

#define N_ODD_PHASES 5
#define odd_mixer_phases \
    PH_BEGIN { pg8::Gemm g{RES, (const bf16_t*)(ws + WS_W_OD_IN + j * SZ_W_OD_IN), M, OD_NP, D, D}; pg8::StaticOrder S; S.init(M, OD_NP, F.G, F.bid); \
               pg8::EpiProjOdd E{PROJ, OD_NP, (bf16_t*)(ws + WS_KCMP), (bf16_t*)(ws + WS_VCMP), RSTD}; pg8::gemm_phase(F.lds, g, S, E); } PH_END \
    PH_BEGIN { for (int kv = 0; kv < 2; ++kv) { \
                 { pg8::Gemm g{(const bf16_t*)(ws + (kv ? WS_VCMP : WS_KCMP)), (const bf16_t*)(ws + WS_W_C1 + (j * 2 + kv) * SZ_W_C1), 4096, 256, 4096, 2048}; \
                   pg8::StaticOrder S; S.init(4096, 256, F.G, (F.bid + F.G - 16 * kv) % F.G); \
                   pg8::EpiGeluBf16 E{(bf16_t*)(ws + WS_CHID) + (size_t)kv * 4096 * 256, 256, (const float*)(ws + WS_C1B) + (j * 2 + kv) * 32 * 256}; pg8::gemm_phase(F.lds, g, S, E); } \
                 asm volatile("s_waitcnt vmcnt(0)" ::: "memory"); __syncthreads();     \
                 { pg8::Gemm g{(const bf16_t*)(ws + WS_CHID) + (size_t)kv * 4096 * 256, (const bf16_t*)(ws + WS_W_C2 + (j * 2 + kv) * SZ_W_C2), 4096, 256, 256, 256}; \
                   pg8::StaticOrder S; S.init(4096, 256, F.G, (F.bid + F.G - 16 * kv) % F.G); \
                   pg8::EpiStoreBf16 E{(bf16_t*)(ws + WS_KC) + (size_t)kv * 4096 * 256, 256, nullptr}; pg8::gemm_phase(F.lds, g, S, E); } } \
               gdn::chunk_phase(F, PROJ, F.in[I_OD_CONVW] + (size_t)j * 4 * 3072, F.in[I_OD_ALOG] + j * 8, F.in[I_OD_DTB] + j * 8, F.ctl + CW_QUEUE + 64 * (2 + j)); } PH_END \
    PH_BEGIN nsa::odd_attn_phase(F, PROJ, HB, F.in[I_RELB], F.in[I_OD_GNORM] + j * 128, F.ctl + CW_QUEUE + 64 * j); PH_END \
    PH_BEGIN { pg8::Gemm g{HB, (const bf16_t*)(ws + WS_W_OD_OUT + j * SZ_W_OUT), M, D, D, D}; pg8::StaticOrder S; S.init(M, D, F.G, F.bid); \
               pg8::EpiAddRes E{RES, D}; pg8::gemm_phase(F.lds, g, S, E); } PH_END \
    PH_BEGIN rowstat_phase(F, RES, RSTD); PH_END
struct Args { const float* in[22]; float* out; unsigned char* ws; int ph_lo, ph_hi; };

#ifndef MIXERS
#define MIXERS 3
#endif

__global__ void __launch_bounds__(NTHR, 2) mega(Args args) {
    extern __shared__ __attribute__((aligned(16))) unsigned char lds_raw[];
    Frame F;
    F.lds = (LAS unsigned char*)lds_raw;
    F.G = gridDim.x; F.bid = blockIdx.x;
    F.in = (const float* const*)__builtin_amdgcn_kernarg_segment_ptr();
    F.out = args.out; F.ws = args.ws; F.ctl = (unsigned*)(args.ws + WS_CTL);
    const int lo = args.ph_lo, hi = args.ph_hi;
    volatile LAS unsigned* barw = (volatile LAS unsigned*)(F.lds + LDS_BARW);
    if (TID < 4) barw[TID] = 0u;
    __syncthreads();
    XcdBarrier bar; bar.bar = F.ctl + CW_BAR; bar.x = 0; bar.st = barw;
    if (hi - lo > 1) bar = xcd_barrier_post(F.ctl + CW_BAR, barw);
    int ph = 0;
#define PH_BEGIN if (lo <= ph && ph < hi) {
#define PH_END   if (ph + 1 < hi) xcd_barrier(bar); } ++ph;
    unsigned char* ws = F.ws;
    bf16_t* HB = (bf16_t*)F.out;
    bf16_t* RES = (bf16_t*)(ws + WS_RES);
    float* RSTD = F.out + (size_t)M * D / 2;
    bf16_t* PROJ = (bf16_t*)(ws + WS_PROJ);

    PH_BEGIN p0_prologue(F); PH_END
    PH_BEGIN rowstat_f_phase(F, RES, RSTD, (const bf16_t*)(ws + WS_W_EV_IN) + (size_t)EC_F * D, PROJ); PH_END

    for (int layer = 0; layer < 4; ++layer) {
        const int j = layer >> 1;
        if ((layer & 1) == 0) {
#if (MIXERS & 1)
            even_mixer_phases
#endif
        } else {
#if (MIXERS & 2)
            odd_mixer_phases
#endif
        }
        PH_BEGIN {
            pg8::Gemm g{RES, (const bf16_t*)(ws + WS_W_UP + layer * SZ_W_UP), M, FF2, D, D};
            pg8::StaticOrder S; S.init(M, FF2, F.G, F.bid);
            pg8::EpiFfnGate E{(bf16_t*)(ws + WS_ACT), F.in[I_F_CONVW] + (size_t)layer * 3 * FF, F.in[I_F_CONVB] + (size_t)layer * FF,
                              (float*)(ws + WS_TAIL), (float*)(ws + WS_HEADG), (float*)(ws + WS_HEADU), F.lds + 131072, RSTD};
            pg8::gemm_phase(F.lds, g, S, E);
        } PH_END
        PH_BEGIN
            ffn_fixup_phase(F, (bf16_t*)(ws + WS_ACT), (const float*)(ws + WS_TAIL), (const float*)(ws + WS_HEADG), (const float*)(ws + WS_HEADU),
                            F.in[I_F_CONVW] + (size_t)layer * 3 * FF, F.in[I_F_CONVB] + (size_t)layer * FF);
        PH_END
        PH_BEGIN {
            pg8::Gemm g{(const bf16_t*)(ws + WS_ACT), (const bf16_t*)(ws + WS_W_DN + layer * SZ_W_DN), M, D, FF, FF};
            pg8::StaticOrder S; S.init(M, D, F.G, F.bid);
            pg8::EpiAddRes E{RES, D};
            pg8::gemm_phase(F.lds, g, S, E);
        } PH_END
        if (layer == 1) { PH_BEGIN rowstat_f_phase(F, RES, RSTD, (const bf16_t*)(ws + WS_W_EV_IN + SZ_W_EV_IN) + (size_t)EC_F * D, PROJ); PH_END }
        else if (layer < 3) { PH_BEGIN rowstat_phase(F, RES, RSTD); PH_END }
        else { PH_BEGIN final_norm_phase(F, RES, F.out, F.in[I_NFIN]); PH_END }
    }
#undef PH_BEGIN
#undef PH_END
}

static int count_phases() {
    int ph = 2;
    for (int layer = 0; layer < 4; ++layer) {
        if ((layer & 1) == 0) { if (MIXERS & 1) ph += N_EVEN_PHASES; } else { if (MIXERS & 2) ph += N_ODD_PHASES; }
        ph += 3; ph += 1;
    }
    return ph;
}

#ifndef N_LAUNCH_MODE
#define N_LAUNCH_MODE 0
#endif

extern "C" void kernel_launch(void* const* d_in, const int* in_sizes, int n_in, void* d_out, int out_size, void* d_ws, size_t ws_size, hipStream_t stream) {
    static int grid = 0;
    if (grid == 0) {
        if (n_in != 22 || out_size != M * D || ws_size < WS_END) { fprintf(stderr, "kernel_launch: unexpected shapes (n_in %d out %d ws %zu need %zu)\n", n_in, out_size, ws_size, (size_t)WS_END); grid = -1; return; }
        int dev = 0, cus = 0, per_cu = 0;
        if (hipGetDevice(&dev) != hipSuccess || hipDeviceGetAttribute(&cus, hipDeviceAttributeMultiprocessorCount, dev) != hipSuccess) { grid = -1; return; }
        if (hipFuncSetAttribute((const void*)mega, hipFuncAttributeMaxDynamicSharedMemorySize, LDS_BYTES) != hipSuccess) { fprintf(stderr, "kernel_launch: hipFuncSetAttribute failed\n"); grid = -1; return; }
        if (hipOccupancyMaxActiveBlocksPerMultiprocessor(&per_cu, (const void*)mega, NTHR, LDS_BYTES) != hipSuccess || per_cu < 1) { fprintf(stderr, "kernel_launch: occupancy query says %d\n", per_cu); }
        (void)hipGetLastError();
        grid = cus;
    }
    if (grid < 0) return;
    (void)hipMemsetAsync((char*)d_ws + WS_CTL, 0, CTL_BYTES, stream);
    Args a{};
    for (int i = 0; i < 22; ++i) a.in[i] = (const float*)d_in[i];
    a.out = (float*)d_out; a.ws = (unsigned char*)d_ws;
    const int nph = count_phases();
#if N_LAUNCH_MODE == 1
    a.ph_lo = 0; a.ph_hi = nph;
    hipLaunchKernelGGL(mega, dim3(grid), dim3(NTHR), LDS_BYTES, stream, a);
#else
    for (int p = 0; p < nph; ++p) { a.ph_lo = p; a.ph_hi = p + 1; hipLaunchKernelGGL(mega, dim3(grid), dim3(NTHR), LDS_BYTES, stream, a); }
#endif
}
```

```cpp
#define MIXERS 3
#define N_LAUNCH_MODE 1
#include <hip/hip_runtime.h>
#include <cstdio>
#include <cstdint>

#define LAS __attribute__((address_space(3)))
typedef unsigned short bf16_t;
typedef short bf16x8 __attribute__((ext_vector_type(8)));
typedef short s16x4 __attribute__((ext_vector_type(4)));
typedef float f32x2 __attribute__((ext_vector_type(2)));
typedef float f32x4 __attribute__((ext_vector_type(4)));
typedef float f32x16 __attribute__((ext_vector_type(16)));
typedef unsigned u32x2 __attribute__((ext_vector_type(2)));
typedef unsigned u32x4 __attribute__((ext_vector_type(4)));

constexpr int NB = 8, T = 4096, M = NB * T, D = 2048, HD = 128;
constexpr int EV_N = 4616, EV_NP = 4864, OD_N = 6696, OD_NP = 6912, FF = 5632, FF2 = 11264;
constexpr int MH = M / 2;
constexpr int NTHR = 512, NWAVE = 8;
constexpr int LDS_BYTES = 159744;
constexpr int LDS_BARW = LDS_BYTES - 16;
constexpr float EPS = 1e-6f;
constexpr float SCALE = 0.08838834764831845f;
constexpr float INV_SCALE = 11.313708498984761f;
constexpr float LOG2E = 1.4426950408889634f;

constexpr int EC_QA = 0, EC_QB = 1024, EC_KA = 2048, EC_VA = 2304, EC_KB = 2560, EC_VB = 3584, EC_F = 4608;
constexpr int OC_QC = 0, OC_QD = 1024, OC_KCMP = 2048, OC_VCMP = 2304, OC_KSEL = 2560, OC_VSEL = 2816, OC_KWIN = 3072, OC_VWIN = 3328,
              OC_KD = 3584, OC_VD = 4608, OC_Z = 5632, OC_GATE = 6656, OC_BETA = 6680, OC_A = 6688;

__host__ __device__ inline int ev_src(int n) {
    if (n < 1024) return n;
    if (n < 2048) return n - 1024 + 1536;
    if (n < 2304) return n - 2048 + 1024;
    if (n < 2560) return n - 2304 + 1280;
    if (n < 3584) return n - 2560 + 2560;
    if (n < 4608) return n - 3584 + 3584;
    if (n < 4616) return n;
    return -1;
}
__host__ __device__ inline int od_src(int n) {
    if (n < 1024) return n;
    if (n < 2048) return n - 1024 + 2584;
    if (n < 3584) return n - 2048 + 1024;
    if (n < 4608) return n - 3584 + 3608;
    if (n < 5632) return n - 4608 + 4632;
    if (n < 6656) return n - 5632 + 5672;
    if (n < 6680) return n - 6656 + 2560;
    if (n < 6688) return n - 6680 + 5656;
    if (n < 6696) return n - 6688 + 5664;
    return -1;
}

constexpr size_t al256(size_t x) { return (x + 255) & ~(size_t)255; }
constexpr size_t WS_CTL = 0, CTL_BYTES = 65536;
constexpr size_t SZ_W_EV_IN = (size_t)EV_NP * D * 2, SZ_W_OUT = (size_t)D * D * 2, SZ_W_OD_IN = (size_t)OD_NP * D * 2,
                 SZ_W_UP = (size_t)FF2 * D * 2, SZ_W_DN = (size_t)D * FF * 2, SZ_W_C1 = (size_t)256 * 4096 * 2, SZ_W_C2 = (size_t)256 * 256 * 2;
constexpr size_t WS_W_EV_IN = WS_CTL + CTL_BYTES;
constexpr size_t WS_W_EV_OUT = WS_W_EV_IN + 2 * SZ_W_EV_IN;
constexpr size_t WS_W_OD_IN = WS_W_EV_OUT + 2 * SZ_W_OUT;
constexpr size_t WS_W_OD_OUT = WS_W_OD_IN + 2 * SZ_W_OD_IN;
constexpr size_t WS_W_UP = WS_W_OD_OUT + 2 * SZ_W_OUT;
constexpr size_t WS_W_DN = WS_W_UP + 4 * SZ_W_UP;
constexpr size_t WS_W_C1 = WS_W_DN + 4 * SZ_W_DN;
constexpr size_t WS_W_C2 = WS_W_C1 + 4 * SZ_W_C1;
constexpr size_t WS_C1B = WS_W_C2 + 4 * SZ_W_C2;
constexpr size_t WS_HB = WS_C1B + 131072;
constexpr size_t WS_RES = WS_HB;
constexpr size_t SZ_HB = (size_t)M * D * 2;
constexpr size_t WS_R = WS_HB + SZ_HB;
constexpr size_t SZ_PROJ = (size_t)M * OD_NP * 2;
constexpr size_t WS_PROJ = WS_R;
constexpr size_t WS_R2 = WS_R + SZ_PROJ;
constexpr size_t WS_CF = WS_R2;
constexpr size_t SZ_CMPBUF = (size_t)(16 * T + 64) * 128 * 2;
constexpr size_t WS_KCMP = WS_R2, WS_VCMP = al256(WS_KCMP + SZ_CMPBUF);
constexpr int NCHUNK = NB * 8 * (T / 64);
constexpr size_t SZ_G16 = (size_t)NCHUNK * 64 * 128 * 2;
constexpr size_t WS_G_U = al256(WS_VCMP + SZ_CMPBUF), WS_G_W = WS_G_U + SZ_G16, WS_G_QG = WS_G_W + SZ_G16, WS_G_KT = WS_G_QG + SZ_G16;
constexpr size_t WS_G_ATT = WS_G_KT + SZ_G16;
constexpr size_t WS_G_GL = WS_G_ATT + (size_t)NCHUNK * 64 * 64 * 2;
constexpr size_t WS_CHID = al256(WS_G_GL + (size_t)NCHUNK * 4);
constexpr size_t WS_KC = WS_CHID + (size_t)2 * 4096 * 256 * 2;
constexpr size_t WS_NSAACC = WS_KC + (size_t)2 * 4096 * 256 * 2;
constexpr size_t WS_R_END_ODD = WS_NSAACC + (size_t)256 * 256 * 128 * 4;
constexpr size_t SZ_HALO = (size_t)(M / 256) * 2 * FF * 4;
constexpr size_t WS_ACT = WS_R, WS_TAIL = WS_ACT + (size_t)M * FF * 2, WS_HEADG = WS_TAIL + SZ_HALO, WS_HEADU = WS_HEADG + SZ_HALO, WS_R_END_FFN = WS_HEADU + SZ_HALO;
constexpr size_t WS_END = (WS_R_END_ODD > WS_R_END_FFN ? WS_R_END_ODD : WS_R_END_FFN);

constexpr int CW_BAR = 0;
constexpr int CW_QUEUE = 4096;
constexpr int CW_NORM = 8192;

typedef __bf16 bf16v2_ __attribute__((ext_vector_type(2)));
__device__ __forceinline__ unsigned cvt_pk_bf16(float lo, float hi) { const f32x2 v = {lo, hi}; const bf16v2_ r = __builtin_convertvector(v, bf16v2_); return __builtin_bit_cast(unsigned, r); }
__device__ __forceinline__ bf16_t f2bf(float f) { return (bf16_t)(cvt_pk_bf16(f, 0.f) & 0xffffu); }
__device__ __forceinline__ float bf2f(bf16_t b) { return __uint_as_float(((unsigned)b) << 16); }
__device__ __forceinline__ float bflo(unsigned w) { return __uint_as_float(w << 16); }
__device__ __forceinline__ float bfhi(unsigned w) { return __uint_as_float(w & 0xffff0000u); }
__device__ __forceinline__ int opaque_tid() { int t = threadIdx.x; asm volatile("" : "+v"(t)); return t; }
__device__ __forceinline__ int olane() { return opaque_tid() & 63; }
__device__ __forceinline__ float shx(float v, int m) { return __builtin_bit_cast(float, __builtin_amdgcn_ds_bpermute((olane() ^ m) << 2, __builtin_bit_cast(int, v))); }
__device__ __forceinline__ unsigned shx(unsigned v, int m) { return (unsigned)__builtin_amdgcn_ds_bpermute((olane() ^ m) << 2, (int)v); }
__device__ __forceinline__ float shu(float v, int d) { const int l = olane(), s = l - d; return __builtin_bit_cast(float, __builtin_amdgcn_ds_bpermute((s < 0 ? l : s) << 2, __builtin_bit_cast(int, v))); }
#define DPPF(x, ctrl) __builtin_bit_cast(float, __builtin_amdgcn_update_dpp(0, __builtin_bit_cast(int, (x)), (ctrl), 0xf, 0xf, true))
__device__ __forceinline__ float row16_sum(float x) { x += DPPF(x, 0x128); x += DPPF(x, 0x124); x += DPPF(x, 0x122); x += DPPF(x, 0x121); return x; }
__device__ __forceinline__ float row8_sum(float x) { x += DPPF(x, 0xB1); x += DPPF(x, 0x4E); x += DPPF(x, 0x141); return x; }
__device__ __forceinline__ float wave_sum(float v) { v = row16_sum(v); v += shx(v, 16); v += shx(v, 32); return v; }
__device__ __forceinline__ float sigmoidf_(float x) { return __builtin_amdgcn_rcpf(1.f + __expf(-x)); }
__device__ __forceinline__ float siluf_(float x) { return x * __builtin_amdgcn_rcpf(1.f + __expf(-x)); }

#define XB_TMO      128
#define XB_XCNT(j)  (256  + 64 * (j))
#define XB_XSUB(j)  (1280 + 64 * (j))
#define XB_XGEN(j)  (2304 + 64 * (j))
#define XB_TOP      3328
#define XB_TOPGEN   3392
#define XCD_BAR_WORDS 3456
#define XB_SPIN_CAP (1u << 24)

__device__ __forceinline__ unsigned xb_ld(unsigned* p)              { return __hip_atomic_load(p, __ATOMIC_RELAXED, __HIP_MEMORY_SCOPE_AGENT); }
__device__ __forceinline__ unsigned xb_add(unsigned* p, unsigned v) { return __hip_atomic_fetch_add(p, v, __ATOMIC_RELAXED, __HIP_MEMORY_SCOPE_AGENT); }
__device__ __forceinline__ unsigned xb_xcc_id() { return (unsigned)__builtin_amdgcn_s_getreg((3 << 11) | 20) & 0xFu; }
#define XB_SPIN(cond, bar) do { unsigned _sp = 0; while (cond) { __builtin_amdgcn_s_sleep(1); \
    if ((++_sp & 255u) == 0u) { if (xb_ld(&(bar)[XB_TMO])) break; if (_sp > XB_SPIN_CAP) { atomicAdd(&(bar)[XB_TMO], 1u); break; } } } } while (0)

struct XcdBarrier { unsigned* bar; unsigned x; volatile LAS unsigned* st; };

__device__ __forceinline__ XcdBarrier xcd_barrier_post(unsigned* bar, volatile LAS unsigned* st) {
    XcdBarrier b; b.bar = bar; b.x = xb_xcc_id(); b.st = st;
    if (threadIdx.x == 0) (void)xb_add(&bar[XB_XCNT(b.x)], 1u);
    return b;
}
__device__ __forceinline__ void xcd_barrier_complete(unsigned* bar, unsigned x, unsigned& nloc, unsigned& nx) {
    const unsigned G = gridDim.x * gridDim.y * gridDim.z;
    unsigned sum, cnt, mine, sp = 0u;
    for (;;) {
        sum = 0u; cnt = 0u; mine = 0u;
#pragma unroll
        for (unsigned j = 0; j < 16; ++j) { const unsigned c = xb_ld(&bar[XB_XCNT(j)]); sum += c; cnt += (c > 0u) ? 1u : 0u; mine = (j == x) ? c : mine; }
        if (sum == G) break;
        __builtin_amdgcn_s_sleep(1);
        if ((++sp & 255u) == 0u) { if (xb_ld(&bar[XB_TMO])) break; if (sp > XB_SPIN_CAP) { atomicAdd(&bar[XB_TMO], 1u); break; } }
    }
    nloc = mine > 0u ? mine : 1u; nx = cnt > 0u ? cnt : 1u;
}
__device__ __forceinline__ void xcd_barrier(const XcdBarrier& b) {
    asm volatile("s_waitcnt vmcnt(0)" ::: "memory");
    __syncthreads();
    if (threadIdx.x == 0) {
        unsigned* bar = b.bar;
        __builtin_amdgcn_s_waitcnt(0);
        unsigned nloc = b.st[0], nx = b.st[1];
        if (nloc == 0u) { xcd_barrier_complete(bar, b.x, nloc, nx); b.st[0] = nloc; b.st[1] = nx; }
        const unsigned old = xb_add(&bar[XB_XSUB(b.x)], 1u);
        const unsigned gen = old / nloc;
        if (old + 1u == (gen + 1u) * nloc) {
            __builtin_amdgcn_fence(__ATOMIC_RELEASE, "agent");
            asm volatile("s_waitcnt vmcnt(0)" ::: "memory");
            const unsigned og = xb_add(&bar[XB_TOP], 1u);
            const unsigned tg = og / nx;
            if (og + 1u == (tg + 1u) * nx) xb_add(&bar[XB_TOPGEN], 1u);
            else XB_SPIN(xb_ld(&bar[XB_TOPGEN]) == tg, bar);
            __builtin_amdgcn_fence(__ATOMIC_ACQUIRE, "agent");
            xb_add(&bar[XB_XGEN(b.x)], 1u);
            asm volatile("s_waitcnt vmcnt(0)" ::: "memory");
        } else {
            XB_SPIN(xb_ld(&bar[XB_XGEN(b.x)]) == gen, bar);
            __builtin_amdgcn_fence(__ATOMIC_ACQUIRE, "agent");
            asm volatile("s_waitcnt vmcnt(0)" ::: "memory");
        }
    }
    __syncthreads();
}

namespace pg8 {
constexpr int BM = 256, BK = 64, HALF = 128, HTB = HALF * BK * 2, STAGE_BYTES = 8 * HTB, NXCD = 8, WGM = 4;
__host__ __device__ __forceinline__ int lds_byte(int r, int c) { const int st = (r >> 4) * 2 + (c >> 5), rr = r & 15, cc = c & 31, ob = rr * 64 + cc * 2; return st * 1024 + (ob ^ (((ob >> 9) & 1) << 5)); }
__host__ __device__ __forceinline__ void stage_rc(int b, int& R, int& C) { const int st = b / 1024, sb = b % 1024, swz = sb ^ (((sb >> 9) & 1) << 5); R = (st >> 1) * 16 + swz / 64; C = (st & 1) * 32 + (swz % 64) / 2; }
__host__ __device__ __forceinline__ int perm32(int rho) { const int n = rho >> 4, i = rho & 15; return 8 * (i >> 2) + 4 * n + (i & 3); }

struct Unit { int pm, pn; };
struct Gemm { const bf16_t* A; const bf16_t* Bt; int M, N, K, lda; };

struct StaticOrder {
    int nM, nN, nwg, G, c;
    __host__ __device__ void init(int M_, int N_, int G_, int c_) { nM = M_ / BM; nN = N_ / BM; nwg = nM * nN; G = G_; c = c_; }
    __host__ __device__ bool next(int i, Unit& u) const {
        const long L = (long)i * G + c; if (L >= nwg) return false;
        int wgid = (int)L; { const int q = nwg / NXCD, r = nwg % NXCD, xcd = wgid % NXCD, off = wgid / NXCD; wgid = (xcd < r ? xcd * (q + 1) : r * (q + 1) + (xcd - r) * q) + off; }
        const int nig = WGM * nN, gid = wgid / nig, fm = gid * WGM, gsz = (nM - fm) < WGM ? (nM - fm) : WGM;
        u.pm = fm + ((wgid % nig) % gsz); u.pn = (wgid % nig) / gsz; return true;
    }
    __device__ __forceinline__ void a_ready(const Unit&) const {}
    __device__ __forceinline__ void done(const Unit&) const {}
};

constexpr int L_RSPF = 131072 + 4096;
__device__ __forceinline__ void rs_prefetch(const float* rs, int pm, int ui) {
    const int t = opaque_tid(), w = __builtin_amdgcn_readfirstlane(t >> 6);
    extern __shared__ __attribute__((aligned(16))) unsigned char lds_dyn_[];
    if (w < 4) __builtin_amdgcn_global_load_lds((const unsigned*)(rs + pm * BM + t), (LAS unsigned*)((LAS unsigned char*)lds_dyn_ + L_RSPF + (ui & 1) * 1024 + w * 256), 4, 0, 0);
}
__device__ __forceinline__ void rs_read(float (&r_)[2][4], int ui, int wr, int fr) {
    extern __shared__ __attribute__((aligned(16))) unsigned char lds_dyn_[];
    const LAS float* rl = (const LAS float*)((LAS unsigned char*)lds_dyn_ + L_RSPF + (ui & 1) * 1024) + wr * 64 + fr;
#pragma unroll
    for (int ai = 0; ai < 2; ++ai)
#pragma unroll
        for (int m = 0; m < 4; ++m) r_[ai][m] = rl[ai * HALF + m * 16];
}
struct EpiStoreBf16 {
    static constexpr bool PERM = true;
    bf16_t* O; int ldc; const float* rs;
    __device__ __forceinline__ void prefetch(const Unit& u, int ui) const { if (rs) rs_prefetch(rs, u.pm, ui); }
    __device__ __forceinline__ void operator()(const f32x4 (&acc)[2][2][4][2], const Unit& u, int wr, int wc, int ui, int) const {
        const int ol_ = opaque_tid() & 63, fr = ol_ & 15, fq = ol_ >> 4;
        const int row0 = u.pm * BM + wr * 64 + fr, col0 = u.pn * BM + wc * 32 + 8 * fq;
        float r_[2][4];
        if (rs) rs_read(r_, ui, wr, fr);
        else {
#pragma unroll
            for (int ai = 0; ai < 2; ++ai)
#pragma unroll
                for (int m = 0; m < 4; ++m) r_[ai][m] = 1.f;
        }
#pragma unroll
        for (int ai = 0; ai < 2; ++ai)
#pragma unroll
            for (int m = 0; m < 4; ++m) { bf16_t* rowp = O + (size_t)(row0 + ai * HALF + m * 16) * ldc + col0; const float r = r_[ai][m];
#pragma unroll
                for (int bj = 0; bj < 2; ++bj) { const f32x4 v0 = acc[ai][bj][m][0] * r, v1 = acc[ai][bj][m][1] * r;
                    u32x4 w; w.x = cvt_pk_bf16(v0[0], v0[1]); w.y = cvt_pk_bf16(v0[2], v0[3]); w.z = cvt_pk_bf16(v1[0], v1[1]); w.w = cvt_pk_bf16(v1[2], v1[3]);
                    *(u32x4*)(rowp + bj * HALF) = w; } }
    }
};
struct EpiAddRes {
    static constexpr bool PERM = true;
    bf16_t* C; int ldc;
    __device__ __forceinline__ void prefetch(const Unit&, int) const {}
    __device__ __forceinline__ void operator()(const f32x4 (&acc)[2][2][4][2], const Unit& u, int wr, int wc, int, int) const {
        const int ol_ = opaque_tid() & 63, fr = ol_ & 15, fq = ol_ >> 4;
        const int row0 = u.pm * BM + wr * 64 + fr, col0 = u.pn * BM + wc * 32 + 8 * fq;
        u32x4 cin[2][4][2];
#pragma unroll
        for (int ai = 0; ai < 2; ++ai)
#pragma unroll
            for (int m = 0; m < 4; ++m)
#pragma unroll
                for (int bj = 0; bj < 2; ++bj) cin[ai][m][bj] = *(const u32x4*)(C + (size_t)(row0 + ai * HALF + m * 16) * ldc + col0 + bj * HALF);
#pragma unroll
        for (int ai = 0; ai < 2; ++ai)
#pragma unroll
            for (int m = 0; m < 4; ++m)
#pragma unroll
                for (int bj = 0; bj < 2; ++bj) { const u32x4 c = cin[ai][m][bj]; const f32x4 v0 = acc[ai][bj][m][0], v1 = acc[ai][bj][m][1];
                    u32x4 w; w.x = cvt_pk_bf16(bflo(c.x) + v0[0], bfhi(c.x) + v0[1]); w.y = cvt_pk_bf16(bflo(c.y) + v0[2], bfhi(c.y) + v0[3]);
                    w.z = cvt_pk_bf16(bflo(c.z) + v1[0], bfhi(c.z) + v1[1]); w.w = cvt_pk_bf16(bflo(c.w) + v1[2], bfhi(c.w) + v1[3]);
                    *(u32x4*)(C + (size_t)(row0 + ai * HALF + m * 16) * ldc + col0 + bj * HALF) = w; }
    }
};
struct EpiFfnGate {
    static constexpr bool PERM = true;
    bf16_t* act; const float* cw; const float* cb; float* tail; float* headg; float* headu; LAS unsigned char* hl; const float* rs;
    __device__ __forceinline__ void prefetch(const Unit& u, int ui) const { rs_prefetch(rs, u.pm, ui); }
    __device__ __forceinline__ void operator()(f32x4 (&acc)[2][2][4][2], const Unit& u, int wr, int wc, int ui, int) const {
        const int ol_ = opaque_tid() & 63, fr = ol_ & 15, fq = ol_ >> 4;
        { float r_[2][4];
          rs_read(r_, ui, wr, fr);
#pragma unroll
          for (int ai = 0; ai < 2; ++ai)
#pragma unroll
              for (int bj = 0; bj < 2; ++bj)
#pragma unroll
                  for (int m = 0; m < 4; ++m) { acc[ai][bj][m][0] *= r_[ai][m]; acc[ai][bj][m][1] *= r_[ai][m]; } }
        const int col = u.pn * 128 + wc * 32 + 8 * fq;
        if (fr >= 14) {
#pragma unroll
            for (int ai = 0; ai < 2; ++ai) { LAS f32x4* s = (LAS f32x4*)(hl + ((((ai * 2 + wr) * 4 + wc) * 8 + fq * 2 + (fr - 14)) * 32));
                s[0] = acc[ai][1][3][0]; s[1] = acc[ai][1][3][1]; }
        }
        asm volatile("s_waitcnt lgkmcnt(0)" ::: "memory"); __builtin_amdgcn_s_barrier(); asm volatile("" ::: "memory");
        __builtin_amdgcn_s_barrier(); asm volatile("" ::: "memory");
        float w0[8], w1[8], w2[8], bb[8];
        { const f32x4 a0 = *(const f32x4*)(cw + col), a1 = *(const f32x4*)(cw + col + 4), b0 = *(const f32x4*)(cw + FF + col), b1 = *(const f32x4*)(cw + FF + col + 4),
                      c0 = *(const f32x4*)(cw + 2 * FF + col), c1 = *(const f32x4*)(cw + 2 * FF + col + 4), d0 = *(const f32x4*)(cb + col), d1 = *(const f32x4*)(cb + col + 4);
#pragma unroll
          for (int e = 0; e < 4; ++e) { w0[e] = a0[e] * -LOG2E; w0[4 + e] = a1[e] * -LOG2E; w1[e] = b0[e] * -LOG2E; w1[4 + e] = b1[e] * -LOG2E; w2[e] = c0[e] * -LOG2E; w2[4 + e] = c1[e] * -LOG2E; bb[e] = d0[e] * -LOG2E; bb[4 + e] = d1[e] * -LOG2E; } }
#pragma unroll
        for (int ai = 0; ai < 2; ++ai) {
            f32x4 hal[2] = {(f32x4){0.f, 0.f, 0.f, 0.f}, (f32x4){0.f, 0.f, 0.f, 0.f}};
            if (!(ai == 0 && wr == 0) && fr >= 14) {
                const int sai = (wr == 1) ? ai : 0, swr = (wr == 1) ? 0 : 1;
                const LAS f32x4* s = (const LAS f32x4*)(hl + ((((sai * 2 + swr) * 4 + wc) * 8 + fq * 2 + (fr - 14)) * 32));
                hal[0] = s[0]; hal[1] = s[1];
            }
#pragma unroll
            for (int m = 0; m < 4; ++m) {
                const int row = u.pm * BM + ai * HALF + wr * 64 + m * 16 + fr;
                float o[8], z[8], g1[8], g2[8];
#pragma unroll
                for (int k = 0; k < 8; ++k) { const int n = k >> 2, e = k & 3;
                    const float gc = acc[ai][1][m][n][e], gp = (m == 0) ? hal[n][e] : acc[ai][1][m - 1][n][e];
                    const int gci = __builtin_bit_cast(int, gc), gpi = __builtin_bit_cast(int, gp);
                    const int r1 = __builtin_amdgcn_update_dpp(0, gpi, 0x121, 0xf, 0xf, true), r2 = __builtin_amdgcn_update_dpp(0, gpi, 0x122, 0xf, 0xf, true);
                    g1[k] = __builtin_bit_cast(float, __builtin_amdgcn_update_dpp(r1, gci, 0x111, 0xf, 0xf, false));
                    g2[k] = __builtin_bit_cast(float, __builtin_amdgcn_update_dpp(r2, gci, 0x112, 0xf, 0xf, false)); }
#pragma unroll
                for (int k = 0; k < 8; ++k) z[k] = w0[k] * g2[k] + bb[k];
#pragma unroll
                for (int k = 0; k < 8; ++k) z[k] += w1[k] * g1[k];
#pragma unroll
                for (int k = 0; k < 8; ++k) z[k] += w2[k] * acc[ai][1][m][k >> 2][k & 3];
#pragma unroll
                for (int k = 0; k < 8; ++k) o[k] = __builtin_amdgcn_exp2f(z[k]);
#pragma unroll
                for (int k = 0; k < 8; ++k) o[k] += 1.f;
#pragma unroll
                for (int k = 0; k < 8; ++k) o[k] = __builtin_amdgcn_rcpf(o[k]);
#pragma unroll
                for (int k = 0; k < 8; ++k) z[k] *= acc[ai][0][m][k >> 2][k & 3];
#pragma unroll
                for (int k = 0; k < 8; ++k) o[k] *= z[k];
                u32x4 w; w.x = cvt_pk_bf16(o[0], o[1]); w.y = cvt_pk_bf16(o[2], o[3]); w.z = cvt_pk_bf16(o[4], o[5]); w.w = cvt_pk_bf16(o[6], o[7]);
                *(u32x4*)(act + (size_t)row * FF + col) = w;
            }
        }
        if (wr == 1 && fr >= 14) { float* t = tail + ((size_t)u.pm * 2 + (fr - 14)) * FF + col; *(f32x4*)t = acc[1][1][3][0]; *(f32x4*)(t + 4) = acc[1][1][3][1]; }
        if (wr == 0 && fr < 2) { float* hg = headg + ((size_t)u.pm * 2 + fr) * FF + col; *(f32x4*)hg = acc[0][1][0][0]; *(f32x4*)(hg + 4) = acc[0][1][0][1];
                                 float* hu = headu + ((size_t)u.pm * 2 + fr) * FF + col; *(f32x4*)hu = acc[0][0][0][0]; *(f32x4*)(hu + 4) = acc[0][0][0][1]; }
    }
};

template <class Epi, class Sched>
__device__ __forceinline__ void gemm_phase(LAS unsigned char* lds, const Gemm g, const Sched& S, const Epi& E) {
    const int tid = opaque_tid(), wid = __builtin_amdgcn_readfirstlane(tid >> 6), lane = tid & 63, wr = wid >> 2, wc = wid & 3, fr = lane & 15, fq = lane >> 4;
    const int K = g.K, nt = K / BK, lda = g.lda;
    unsigned voffA[2], voffB[2];
#pragma unroll
    for (int i = 0; i < 2; ++i) { int R, C; stage_rc(tid * 16 + i * 8192, R, C); const int Rb = Epi::PERM ? ((R & ~31) + perm32(R & 31)) : R;
        voffA[i] = (unsigned)(R * lda + C) * 2u; voffB[i] = (unsigned)(Rb * K + C) * 2u; }
    const size_t kstep = (size_t)(BK * 2);
    const size_t hstepA = (size_t)HALF * lda * 2, hstepB = (size_t)HALF * K * 2;
    const size_t tstepA = 2 * hstepA, tstepB = 2 * hstepB;
    const unsigned ldsw = (unsigned)wid * 1024u;
    const int aoff = lds_byte(wr * 64 + fr, fq * 8), boff = lds_byte(wc * 32 + fr, fq * 8);
#define PG8_SA(b, h) (((b) * 2 + (h)) * HTB)
#define PG8_SB(b, h) ((4 + (b) * 2 + (h)) * HTB)
#define PG8_STAGE(bufoff, gbase, voff) do { _Pragma("unroll") for (int _i = 0; _i < 2; ++_i) \
        __builtin_amdgcn_global_load_lds((const unsigned*)((const char*)(gbase) + (voff)[_i]), (LAS unsigned*)(lds + (bufoff) + ldsw + _i * 8192), 16, 0, 0); } while (0)
#define PG8_LDA(dst, b, h) do { _Pragma("unroll") for (int m = 0; m < 4; ++m) _Pragma("unroll") for (int k = 0; k < 2; ++k) dst[m][k] = *(const LAS bf16x8*)(lds + PG8_SA(b, h) + aoff + m * 2048 + k * 1024); } while (0)
#define PG8_LDB(dst, b, h) do { _Pragma("unroll") for (int n = 0; n < 2; ++n) _Pragma("unroll") for (int k = 0; k < 2; ++k) dst[n][k] = *(const LAS bf16x8*)(lds + PG8_SB(b, h) + boff + n * 2048 + k * 1024); } while (0)
#define PG8_MMA(ai, bj, At, Bt) do { __builtin_amdgcn_s_setprio(1); _Pragma("unroll") for (int m = 0; m < 4; ++m) _Pragma("unroll") for (int n = 0; n < 2; ++n) _Pragma("unroll") for (int k = 0; k < 2; ++k) \
        acc[ai][bj][m][n] = __builtin_amdgcn_mfma_f32_16x16x32_bf16(Bt[n][k], At[m][k], acc[ai][bj][m][n], 0, 0, 0); __builtin_amdgcn_s_setprio(0); } while (0)
#define PG8_WAIT_V(n) asm volatile("s_waitcnt vmcnt(" #n ")" ::: "memory")
#define PG8_WAIT_L(n) asm volatile("s_waitcnt lgkmcnt(" #n ")" ::: "memory")
#define PG8_BAR __builtin_amdgcn_s_barrier()
#define PG8_SCHED __builtin_amdgcn_sched_barrier(0)
    Unit cur, nxt; int ui = 0;
    if (!S.next(0, cur)) return;
    f32x4 acc[2][2][4][2];
#pragma unroll
    for (int a = 0; a < 2; ++a)
#pragma unroll
        for (int b = 0; b < 2; ++b)
#pragma unroll
            for (int m = 0; m < 4; ++m)
#pragma unroll
                for (int n = 0; n < 2; ++n) acc[a][b][m][n] = (f32x4){0.f, 0.f, 0.f, 0.f};
    bf16x8 At[4][2], B0[2][2], B1[2][2];
    const char* cA = (const char*)g.A + (size_t)cur.pm * tstepA; const char* cB = (const char*)g.Bt + (size_t)cur.pn * tstepB;
    S.a_ready(cur);
    PG8_STAGE(PG8_SB(0, 0), cB, voffB); PG8_STAGE(PG8_SA(0, 0), cA, voffA); PG8_STAGE(PG8_SB(0, 1), cB + hstepB, voffB); PG8_STAGE(PG8_SA(0, 1), cA + hstepA, voffA);
    if (wr == 1) PG8_BAR;
    PG8_WAIT_V(4); PG8_BAR;
    PG8_STAGE(PG8_SB(1, 0), cB + kstep, voffB); PG8_STAGE(PG8_SA(1, 0), cA + kstep, voffA); PG8_STAGE(PG8_SB(1, 1), cB + hstepB + kstep, voffB);
    PG8_WAIT_V(6); PG8_BAR;
    for (;;) {
        E.prefetch(cur, ui);
        const bool has_next = S.next(ui + 1, nxt);
        const char* nA = has_next ? (const char*)g.A + (size_t)nxt.pm * tstepA : cA; const char* nB = has_next ? (const char*)g.Bt + (size_t)nxt.pn * tstepB : cB;
        for (int t = 0; t < nt; t += 2) {
            const bool last = (t == nt - 2);
            const char* a1 = cA + (size_t)(t + 1) * kstep;
            const char* a2 = last ? nA : cA + (size_t)(t + 2) * kstep; const char* b2 = last ? nB : cB + (size_t)(t + 2) * kstep;
            const char* a3 = a2 + kstep; const char* b3 = b2 + kstep;
            if (last && has_next) S.a_ready(nxt);
            PG8_LDB(B0, 0, 0); PG8_SCHED; PG8_LDA(At, 0, 0); PG8_STAGE(PG8_SA(1, 1), a1 + hstepA, voffA);
            PG8_WAIT_L(8); PG8_BAR; PG8_WAIT_L(0); PG8_MMA(0, 0, At, B0); PG8_BAR; PG8_SCHED;
            PG8_LDB(B1, 0, 1); PG8_STAGE(PG8_SB(0, 0), b2, voffB);
            PG8_BAR; PG8_WAIT_L(0); PG8_MMA(0, 1, At, B1); PG8_BAR;
            PG8_LDA(At, 0, 1); PG8_STAGE(PG8_SA(0, 0), a2, voffA);
            PG8_BAR; PG8_WAIT_L(0); PG8_MMA(1, 0, At, B0); PG8_BAR; PG8_SCHED;
            PG8_STAGE(PG8_SB(0, 1), b2 + hstepB, voffB);
            PG8_WAIT_V(6); PG8_BAR; PG8_MMA(1, 1, At, B1); PG8_BAR;
            PG8_LDB(B0, 1, 0); PG8_SCHED; PG8_LDA(At, 1, 0); PG8_STAGE(PG8_SA(0, 1), a2 + hstepA, voffA);
            PG8_WAIT_L(8); PG8_BAR; PG8_WAIT_L(0); PG8_MMA(0, 0, At, B0); PG8_BAR; PG8_SCHED;
            PG8_LDB(B1, 1, 1); PG8_STAGE(PG8_SB(1, 0), b3, voffB);
            PG8_BAR; PG8_WAIT_L(0); PG8_MMA(0, 1, At, B1); PG8_BAR;
            PG8_LDA(At, 1, 1); PG8_STAGE(PG8_SA(1, 0), a3, voffA);
            PG8_BAR; PG8_WAIT_L(0); PG8_MMA(1, 0, At, B0); PG8_BAR; PG8_SCHED;
            PG8_STAGE(PG8_SB(1, 1), b3 + hstepB, voffB);
            PG8_WAIT_V(6); PG8_BAR; PG8_MMA(1, 1, At, B1); PG8_BAR;
        }
        E(acc, cur, wr, wc, ui, fq);
        S.done(cur);
        if (!has_next) break;
#pragma unroll
        for (int a = 0; a < 2; ++a)
#pragma unroll
            for (int b = 0; b < 2; ++b)
#pragma unroll
                for (int m = 0; m < 4; ++m)
#pragma unroll
                    for (int n = 0; n < 2; ++n) acc[a][b][m][n] = (f32x4){0.f, 0.f, 0.f, 0.f};
        cur = nxt; cA = nA; cB = nB; ++ui;
    }
    PG8_WAIT_V(0);
    if (wr == 0) PG8_BAR;
    PG8_BAR;
#undef PG8_SA
#undef PG8_SB
#undef PG8_STAGE
#undef PG8_LDA
#undef PG8_LDB
#undef PG8_MMA
#undef PG8_WAIT_V
#undef PG8_WAIT_L
#undef PG8_BAR
#undef PG8_SCHED
}
}
struct Frame {
    LAS unsigned char* lds; int G, bid;
    const float* const* in; float* out; unsigned char* ws; unsigned* ctl;
};
#define TID (opaque_tid())
#define LANE (opaque_tid() & 63)
#define WAVE (__builtin_amdgcn_readfirstlane(opaque_tid() >> 6))
enum { I_X = 0, I_RELB, I_NMIX, I_NFFN, I_NFIN, I_EV_WIN, I_EV_BF, I_EV_SINK, I_EV_WOUT, I_OD_WIN, I_OD_CPOS, I_OD_CW1, I_OD_CW2, I_OD_CONVW, I_OD_ALOG, I_OD_DTB,
       I_OD_GNORM, I_OD_WOUT, I_F_WUP, I_F_CONVW, I_F_CONVB, I_F_WDN };

template <int MAP>
__device__ __forceinline__ int cvt_map(int n, int srcN) {
    if (MAP == 0) return (n < srcN) ? n : -1;
    if (MAP == 1) return ev_src(n);
    if (MAP == 2) return od_src(n);
    return ((n & 255) < 128) ? (n >> 8) * 128 + (n & 127) : FF + (n >> 8) * 128 + (n & 127);
}
template <int MAP>
__device__ __forceinline__ void cvt_load(f32x4 (&v)[8], const float* __restrict__ src, int srcN, const float* __restrict__ gain, int k0, int n0, int tid) {
    const int n4 = (tid & 31) * 4, s = cvt_map<MAP>(n0 + n4, srcN);
    const int sc = s >= 0 ? s : 0;
    const float keep = (MAP == 3) ? ((((n0 + n4) & 255) < 128) ? -0.6931471805599453f : 1.f) : (s >= 0 ? 1.f : 0.f);
    float gv[8];
#pragma unroll
    for (int e = 0; e < 8; ++e) { const int kk = e * 16 + (tid >> 5);
        v[e] = *(const f32x4*)(src + (size_t)(k0 + kk) * srcN + sc);
        gv[e] = gain ? gain[k0 + kk] : 1.f; }
#pragma unroll
    for (int e = 0; e < 8; ++e) v[e] *= gv[e] * keep;
}
template <int MAP>
__device__ __forceinline__ void cvt_transpose(const Frame& F, const float* __restrict__ src, int srcN, int K, int Npad, const float* __restrict__ gain, bf16_t* __restrict__ dst) {
    LAS float* tile = (LAS float*)F.lds;
    const int tid = TID, tk = K / 128, tn = Npad / 128, ntile = tk * tn;
    int t = F.bid;
    f32x4 v[8];
    if (t < ntile) cvt_load<MAP>(v, src, srcN, gain, (t % tk) * 128, (t / tk) * 128, tid);
    for (; t < ntile; t += F.G) {
        const int k0 = (t % tk) * 128, n0 = (t / tk) * 128;
        __syncthreads();
#pragma unroll
        for (int e = 0; e < 8; ++e) *(LAS f32x4*)(tile + (e * 16 + (tid >> 5)) * 132 + (tid & 31) * 4) = v[e];
        __syncthreads();
        const int tnx = t + F.G;
        if (tnx < ntile) cvt_load<MAP>(v, src, srcN, gain, (tnx % tk) * 128, (tnx / tk) * 128, tid);
        { const int nn = tid & 127, kq = (tid >> 7) * 32;
          bf16_t* d = dst + (size_t)(n0 + nn) * K + k0 + kq;
#pragma unroll
          for (int q = 0; q < 4; ++q) { float x[8];
#pragma unroll
              for (int i = 0; i < 8; ++i) x[i] = tile[(kq + q * 8 + i) * 132 + nn];
              u32x4 w; w.x = cvt_pk_bf16(x[0], x[1]); w.y = cvt_pk_bf16(x[2], x[3]); w.z = cvt_pk_bf16(x[4], x[5]); w.w = cvt_pk_bf16(x[6], x[7]);
              *(u32x4*)(d + q * 8) = w; } }
    }
    __syncthreads();
}

__device__ __forceinline__ void rownorm_phase(const Frame& F, const float* __restrict__ src, bf16_t* __restrict__ cpy, float* __restrict__ rstd_out) {
    for (int row = F.bid * NWAVE + WAVE; row < M; row += F.G * NWAVE) {
        const float* p = src + (size_t)row * D + LANE * 4;
        f32x4 v[8]; float ss = 0.f;
        u32x2 c[8];
#pragma unroll
        for (int i = 0; i < 8; ++i) { v[i] = *(const f32x4*)(p + i * 256); c[i].x = cvt_pk_bf16(v[i][0], v[i][1]); c[i].y = cvt_pk_bf16(v[i][2], v[i][3]);
            ss += bflo(c[i].x) * bflo(c[i].x) + bfhi(c[i].x) * bfhi(c[i].x) + bflo(c[i].y) * bflo(c[i].y) + bfhi(c[i].y) * bfhi(c[i].y); }
        ss = wave_sum(ss);
        if (LANE == 0) rstd_out[row] = rsqrtf(ss * (1.f / D) + EPS);
#pragma unroll
        for (int i = 0; i < 8; ++i) *(u32x2*)(cpy + (size_t)row * D + LANE * 4 + i * 256) = c[i];
    }
}
__device__ __forceinline__ void rowstat_phase(const Frame& F, const bf16_t* __restrict__ res, float* __restrict__ rstd_out) {
    for (int row0 = (F.bid * NWAVE + WAVE) * 4; row0 < M; row0 += F.G * NWAVE * 4) {
        u32x4 v[4][4];
#pragma unroll
        for (int r = 0; r < 4; ++r)
#pragma unroll
            for (int i = 0; i < 4; ++i) v[r][i] = *(const u32x4*)(res + (size_t)(row0 + r) * D + LANE * 8 + i * 512);
        float ss[4];
#pragma unroll
        for (int r = 0; r < 4; ++r) { ss[r] = 0.f;
#pragma unroll
            for (int i = 0; i < 4; ++i) { const u32x4 x = v[r][i];
                ss[r] += bflo(x.x) * bflo(x.x) + bfhi(x.x) * bfhi(x.x) + bflo(x.y) * bflo(x.y) + bfhi(x.y) * bfhi(x.y) + bflo(x.z) * bflo(x.z) + bfhi(x.z) * bfhi(x.z) + bflo(x.w) * bflo(x.w) + bfhi(x.w) * bfhi(x.w); }
            ss[r] = wave_sum(ss[r]); }
        if (LANE < 4) rstd_out[row0 + LANE] = rsqrtf((LANE == 0 ? ss[0] : LANE == 1 ? ss[1] : LANE == 2 ? ss[2] : ss[3]) * (1.f / D) + EPS);
    }
}
__device__ __forceinline__ void rowstat_f_phase(const Frame& F, const bf16_t* __restrict__ res, float* __restrict__ rstd_out, const bf16_t* __restrict__ wf  , bf16_t* __restrict__ proj) {
    LAS unsigned char* lds = F.lds;
    __syncthreads();
    for (int i = TID; i < 8 * D / 8; i += NTHR) *(LAS u32x4*)(lds + i * 16) = *(const u32x4*)(wf + (size_t)i * 8);
    __syncthreads();
    const int l = LANE, r = l & 15, kq = l >> 4;
    for (int blk = F.bid * NWAVE + WAVE; blk < M / 16; blk += F.G * NWAVE) {
        const bf16_t* rowp = res + (size_t)(blk * 16 + r) * D + kq * 8;
        f32x4 acc = {0.f, 0.f, 0.f, 0.f}; float ss = 0.f;
#pragma unroll 1
        for (int s0 = 0; s0 < 64; s0 += 32) {
            u32x4 a[32];
#pragma unroll
            for (int s = 0; s < 32; ++s) a[s] = *(const u32x4*)(rowp + (s0 + s) * 32);
#pragma unroll
            for (int s = 0; s < 32; ++s) { const u32x4 x = a[s];
                ss += bflo(x.x) * bflo(x.x) + bfhi(x.x) * bfhi(x.x) + bflo(x.y) * bflo(x.y) + bfhi(x.y) * bfhi(x.y) + bflo(x.z) * bflo(x.z) + bfhi(x.z) * bfhi(x.z) + bflo(x.w) * bflo(x.w) + bfhi(x.w) * bfhi(x.w);
                u32x4 b = *(const LAS u32x4*)(lds + (r & 7) * 4096 + ((s0 + s) * 32 + kq * 8) * 2);
                if (r >= 8) b = (u32x4){0u, 0u, 0u, 0u};
                u32x4 xa = x;
                acc = __builtin_amdgcn_mfma_f32_16x16x32_bf16(*reinterpret_cast<bf16x8*>(&xa), *reinterpret_cast<bf16x8*>(&b), acc, 0, 0, 0); }
        }
        ss += shx(ss, 16); ss += shx(ss, 32);
        const float rstd = rsqrtf(ss * (1.f / D) + EPS);
        if (kq == 0) rstd_out[blk * 16 + r] = rstd;
#pragma unroll
        for (int reg = 0; reg < 4; ++reg) { const float rr = __builtin_bit_cast(float, __builtin_amdgcn_ds_bpermute((4 * kq + reg) << 2, __builtin_bit_cast(int, rstd)));
            if (r < 8) proj[(size_t)(blk * 16 + 4 * kq + reg) * EV_NP + EC_F + r] = f2bf(acc[reg] * rr); }
    }
    __syncthreads();
}
__device__ __forceinline__ void final_norm_phase(const Frame& F, const bf16_t* __restrict__ res, float* __restrict__ out, const float* __restrict__ g) {
    for (int row0 = (F.bid * NWAVE + WAVE) * 2; row0 < M; row0 += F.G * NWAVE * 2) {
        u32x4 v[2][4];
#pragma unroll
        for (int r = 0; r < 2; ++r)
#pragma unroll
            for (int i = 0; i < 4; ++i) v[r][i] = *(const u32x4*)(res + (size_t)(row0 + r) * D + LANE * 8 + i * 512);
#pragma unroll
        for (int r = 0; r < 2; ++r) {
            float ss = 0.f;
#pragma unroll
            for (int i = 0; i < 4; ++i) { const u32x4 x = v[r][i];
                ss += bflo(x.x) * bflo(x.x) + bfhi(x.x) * bfhi(x.x) + bflo(x.y) * bflo(x.y) + bfhi(x.y) * bfhi(x.y) + bflo(x.z) * bflo(x.z) + bfhi(x.z) * bfhi(x.z) + bflo(x.w) * bflo(x.w) + bfhi(x.w) * bfhi(x.w); }
            ss = wave_sum(ss);
            const float rstd = rsqrtf(ss * (1.f / D) + EPS);
#pragma unroll
            for (int i = 0; i < 4; ++i) { const u32x4 x = v[r][i];
                const f32x4 g0 = *(const f32x4*)(g + LANE * 8 + i * 512), g1 = *(const f32x4*)(g + LANE * 8 + i * 512 + 4);
                float* o = out + (size_t)(row0 + r) * D + LANE * 8 + i * 512;
                *(f32x4*)o = (f32x4){bflo(x.x), bfhi(x.x), bflo(x.y), bfhi(x.y)} * rstd * g0;
                *(f32x4*)(o + 4) = (f32x4){bflo(x.z), bfhi(x.z), bflo(x.w), bfhi(x.w)} * rstd * g1; }
        }
    }
}

__device__ __forceinline__ void ffn_fixup_phase(const Frame& F, bf16_t* __restrict__ act, const float* __restrict__ tail, const float* __restrict__ headg, const float* __restrict__ headu,
                                                const float* __restrict__ cw, const float* __restrict__ cb) {
    constexpr int C4 = FF / 4, NPM = M / 256;
    for (int idx = F.bid * NTHR + TID; idx < NPM * 2 * C4; idx += F.G * NTHR) {
        const int c = (idx % C4) * 4, r = (idx / C4) & 1, pm = idx / (2 * C4);
        if ((pm & 15) == 0) continue;
        const f32x4 t0 = *(const f32x4*)(tail + ((size_t)(pm - 1) * 2 + 0) * FF + c), t1 = *(const f32x4*)(tail + ((size_t)(pm - 1) * 2 + 1) * FF + c);
        const f32x4 h0 = *(const f32x4*)(headg + ((size_t)pm * 2 + 0) * FF + c), h1 = *(const f32x4*)(headg + ((size_t)pm * 2 + 1) * FF + c);
        const f32x4 uu = *(const f32x4*)(headu + ((size_t)pm * 2 + r) * FF + c);
        const f32x4 gm2 = r == 0 ? t0 : t1, gm1 = r == 0 ? t1 : h0, g0 = r == 0 ? h0 : h1;
        const f32x4 w0 = *(const f32x4*)(cw + c), w1 = *(const f32x4*)(cw + FF + c), w2 = *(const f32x4*)(cw + 2 * FF + c), bb = *(const f32x4*)(cb + c);
        float o[4];
#pragma unroll
        for (int e = 0; e < 4; ++e) { const float z = w0[e] * gm2[e] + w1[e] * gm1[e] + w2[e] * g0[e] + bb[e]; o[e] = siluf_(z) * (uu[e] * -LOG2E); }
        u32x2 w; w.x = cvt_pk_bf16(o[0], o[1]); w.y = cvt_pk_bf16(o[2], o[3]);
        *(u32x2*)(act + (size_t)(pm * 256 + r) * FF + c) = w;
    }
}

__device__ __forceinline__ void p0_prologue(const Frame& F) {
    unsigned char* ws = F.ws;
    for (int j = 0; j < 2; ++j) {
        cvt_transpose<1>(F, F.in[I_EV_WIN] + (size_t)j * D * EV_N, EV_N, D, EV_NP, F.in[I_NMIX] + (size_t)(2 * j) * D, (bf16_t*)(ws + WS_W_EV_IN + j * SZ_W_EV_IN));
        cvt_transpose<0>(F, F.in[I_EV_WOUT] + (size_t)j * D * D, D, D, D, nullptr, (bf16_t*)(ws + WS_W_EV_OUT + j * SZ_W_OUT));
        cvt_transpose<2>(F, F.in[I_OD_WIN] + (size_t)j * D * OD_N, OD_N, D, OD_NP, F.in[I_NMIX] + (size_t)(2 * j + 1) * D, (bf16_t*)(ws + WS_W_OD_IN + j * SZ_W_OD_IN));
        cvt_transpose<0>(F, F.in[I_OD_WOUT] + (size_t)j * D * D, D, D, D, nullptr, (bf16_t*)(ws + WS_W_OD_OUT + j * SZ_W_OUT));
        for (int kv = 0; kv < 2; ++kv) {
            cvt_transpose<0>(F, F.in[I_OD_CW1] + (size_t)(j * 2 + kv) * 4096 * 256, 256, 4096, 256, nullptr, (bf16_t*)(ws + WS_W_C1 + (j * 2 + kv) * SZ_W_C1));
            cvt_transpose<0>(F, F.in[I_OD_CW2] + (size_t)(j * 2 + kv) * 256 * 128, 128, 256, 256, nullptr, (bf16_t*)(ws + WS_W_C2 + (j * 2 + kv) * SZ_W_C2));
        }
    }
    for (int l = 0; l < 4; ++l) {
        cvt_transpose<3>(F, F.in[I_F_WUP] + (size_t)l * D * FF2, FF2, D, FF2, F.in[I_NFFN] + (size_t)l * D, (bf16_t*)(ws + WS_W_UP + l * SZ_W_UP));
        cvt_transpose<0>(F, F.in[I_F_WDN] + (size_t)l * FF * D, D, FF, D, nullptr, (bf16_t*)(ws + WS_W_DN + l * SZ_W_DN));
    }
    if (F.bid < 64) {
        const int tid = TID, jk = F.bid >> 4, part = (F.bid & 15) * 2 + (tid >> 8), n = tid & 255;
        const float* pe = F.in[I_OD_CPOS] + (size_t)jk * 4096 + part * 128; const float* w1 = F.in[I_OD_CW1] + ((size_t)jk * 4096 + part * 128) * 256 + n;
        float s = 0.f;
        for (int i0 = 0; i0 < 128; i0 += 16) {
            float a[16], b[16];
#pragma unroll
            for (int u = 0; u < 16; ++u) { a[u] = pe[i0 + u]; b[u] = w1[(size_t)(i0 + u) * 256]; }
#pragma unroll
            for (int u = 0; u < 16; ++u) s += a[u] * b[u];
        }
        ((float*)(ws + WS_C1B))[(jk * 32 + part) * 256 + n] = s;
    }
    rownorm_phase(F, F.in[I_X], (bf16_t*)(ws + WS_RES), F.out + (size_t)M * D / 2);
}
namespace att {
constexpr int KVBLK = 64, SHM_K = KVBLK * 128 * 2, SHM_V = KVBLK * 128 * 2;
constexpr int KVBUF = SHM_V + SHM_K;
constexpr int L_V = 0, L_K = SHM_V;
constexpr int EL_WS = 4 * KVBUF, EL_CFR = EL_WS + 2048, EL_TAB = EL_CFR + 8192  , EL_MISC = EL_TAB + 4096, EL_END = EL_MISC + 256;
static_assert(EL_END <= LDS_BARW, "even attention lds");
#define KSWZ_F(row) (((row) & 7) | ((((row) >> 4) & 1) << 3))
#define KSWZ(row, colB) ((row) * 256 + ((colB) ^ (KSWZ_F(row) << 4)))
#define SBAR() __builtin_amdgcn_sched_barrier(0)
__device__ __forceinline__ int v_st(int k, int c) { const int kk = (k & ~0xC) | ((k & 4) << 1) | ((k & 8) >> 1); return ((kk >> 3) * 4 + (c >> 5)) * 512 + ((kk & 7) * 32 + (c & 31)) * 2; }
__device__ __forceinline__ int v_rd_base(int lane) { return ((lane & 3) << 3) | (((lane >> 2) & 3) << 6) | (((lane >> 4) & 1) << 5) | (((lane >> 5) & 1) << 8); }
constexpr int v_rd_off(int d0, int ks, int half) { return d0 * 512 + ks * 4096 + half * 2048; }
__device__ __forceinline__ int crow(int r, int hi) { return (r & 3) + 8 * (r >> 2) + 4 * hi; }
constexpr float C2 = LOG2E * SCALE;

struct KvOff { unsigned k, v; };
__device__ __forceinline__ KvOff kv_dma_off(int tid, int ld) {
    const int row = tid >> 4, cch = (tid & 15) ^ KSWZ_F(row);
    const int kk = ((tid >> 7) << 3) | ((tid >> 2) & 7), key = (kk & ~0xC) | ((kk & 4) << 1) | ((kk & 8) >> 1), col = ((tid >> 5) & 3) * 32 + (tid & 3) * 8;
    KvOff o; o.k = (unsigned)(row * ld + cch * 8) * 2u; o.v = (unsigned)(key * ld + col) * 2u; return o;
}
__device__ __forceinline__ void kv_dma(LAS unsigned char* buf, const bf16_t* __restrict__ Kg, const bf16_t* __restrict__ Vg, int ld, KvOff o, int wid) {
    const char* k0 = (const char*)Kg; const char* k1 = (const char*)(Kg + (size_t)32 * ld);
    const char* v0 = (const char*)Vg; const char* v1 = (const char*)(Vg + (size_t)32 * ld);
    LAS unsigned char* l = buf + wid * 1024;
    __builtin_amdgcn_global_load_lds((const unsigned*)(k0 + o.k), (LAS unsigned*)(l + L_K), 16, 0, 0);
    __builtin_amdgcn_global_load_lds((const unsigned*)(k1 + o.k), (LAS unsigned*)(l + L_K + 8192), 16, 0, 0);
    __builtin_amdgcn_global_load_lds((const unsigned*)(v0 + o.v), (LAS unsigned*)(l + L_V), 16, 0, 0);
    __builtin_amdgcn_global_load_lds((const unsigned*)(v1 + o.v), (LAS unsigned*)(l + L_V + 8192), 16, 0, 0);
}
template <int NI> __device__ __forceinline__ void dma_wait(int ahead) {
    if (ahead >= 2) { if (NI == 4) asm volatile("s_waitcnt vmcnt(8)" ::: "memory"); else asm volatile("s_waitcnt vmcnt(10)" ::: "memory"); }
    else if (ahead == 1) { if (NI == 4) asm volatile("s_waitcnt vmcnt(4)" ::: "memory"); else asm volatile("s_waitcnt vmcnt(5)" ::: "memory"); }
    else asm volatile("s_waitcnt vmcnt(0)" ::: "memory");
}
#define RING_BAR() do { asm volatile("s_waitcnt lgkmcnt(0)" ::: "memory"); __builtin_amdgcn_s_barrier(); asm volatile("" ::: "memory"); } while (0)
template <int NSET = 4>
__device__ __forceinline__ void qkt(f32x16& p0, f32x16& p1, LAS unsigned char* lds, int r32, int hi, const bf16x8* qr) {
    p0 = f32x16{}; p1 = f32x16{};
    int ad[4];
#pragma unroll
    for (int dd = 0; dd < 4; ++dd) ad[dd] = (int)(uintptr_t)(lds + L_K + KSWZ(r32, (dd * 16 + hi * 8) * 2));
    bf16x8 k0[NSET], k1[NSET];
#define KRD(dst, a_, off_) asm volatile("ds_read_b128 %0, %1 offset:%2" : "=&v"(dst) : "v"(a_), "i"(off_) : "memory")
#define KWAIT(n_, x_, y_) asm volatile("s_waitcnt lgkmcnt(" #n_ ")" : "+v"(x_), "+v"(y_) :: "memory")
#define KISSUE(d_) do { if ((d_) < 4) { KRD(k0[(d_) % NSET], ad[(d_) & 3], 0); KRD(k1[(d_) % NSET], ad[(d_) & 3], 32 * 256); } \
                        else { const int a2_ = ad[(d_) & 3] ^ 128;         \
                               KRD(k0[(d_) % NSET], a2_, 0); KRD(k1[(d_) % NSET], a2_, 32 * 256); } } while (0)
#pragma unroll
    for (int d0 = 0; d0 < NSET; ++d0) KISSUE(d0);
#define KWAITN(n_, x_, y_) do { if ((n_) == 6) KWAIT(6, x_, y_); else if ((n_) == 4) KWAIT(4, x_, y_); else if ((n_) == 2) KWAIT(2, x_, y_); else KWAIT(0, x_, y_); } while (0)
#define QK_STEP(d0_) do { constexpr int inflight_ = ((8 - (d0_)) < NSET ? (8 - (d0_)) : NSET) - 1; KWAITN(2 * inflight_, k0[(d0_) % NSET], k1[(d0_) % NSET]); \
        p0 = __builtin_amdgcn_mfma_f32_32x32x16_bf16(k0[(d0_) % NSET], qr[d0_], p0, 0, 0, 0); p1 = __builtin_amdgcn_mfma_f32_32x32x16_bf16(k1[(d0_) % NSET], qr[d0_], p1, 0, 0, 0); \
        if ((d0_) + NSET < 8) KISSUE((d0_) + NSET); } while (0)
    QK_STEP(0); QK_STEP(1); QK_STEP(2); QK_STEP(3); QK_STEP(4); QK_STEP(5); QK_STEP(6); QK_STEP(7);
#undef KWAITN
#undef QK_STEP
#undef KISSUE
#undef KWAIT
#undef KRD
}
__device__ __forceinline__ void partialSM(f32x16& p0, f32x16& p1, float& m_reg, float& mn, float& alpha) {
    float mx[4] = {p0[0], p0[1], p0[2], p0[3]};
#pragma unroll
    for (int r = 4; r < 16; ++r) mx[r & 3] = fmaxf(mx[r & 3], p0[r]);
#pragma unroll
    for (int r = 0; r < 16; ++r) mx[r & 3] = fmaxf(mx[r & 3], p1[r]);
    float pmax = fmaxf(fmaxf(mx[0], mx[1]), fmaxf(mx[2], mx[3]));
    { auto rr = __builtin_amdgcn_permlane32_swap(__float_as_uint(pmax), __float_as_uint(pmax), false, false);
      pmax = fmaxf(__uint_as_float(rr[0]), __uint_as_float(rr[1])); }
    if (__any((pmax - m_reg) * C2 > 8.f)) { mn = fmaxf(m_reg, pmax); alpha = __builtin_amdgcn_exp2f((m_reg - mn) * C2); m_reg = mn; }
    else { mn = m_reg; alpha = 1.f; }
    const float mnL = -mn * C2;
#pragma unroll
    for (int r = 0; r < 16; ++r) p0[r] = __builtin_amdgcn_exp2f(fmaf(p0[r], C2, mnL));
#pragma unroll
    for (int r = 0; r < 16; ++r) p1[r] = __builtin_amdgcn_exp2f(fmaf(p1[r], C2, mnL));
}
__device__ __forceinline__ void pack_p(const f32x16& p0, const f32x16& p1, bf16x8& pa0, bf16x8& pa1, bf16x8& pa2, bf16x8& pa3) {
#define PK4(P, B_, OUT) do { unsigned a0 = cvt_pk_bf16(P[B_+0], P[B_+1]), a1 = cvt_pk_bf16(P[B_+2], P[B_+3]);                          \
        unsigned b0 = cvt_pk_bf16(P[B_+4], P[B_+5]), b1 = cvt_pk_bf16(P[B_+6], P[B_+7]);                                             \
        auto r0 = __builtin_amdgcn_permlane32_swap(a0, b0, false, false); auto r1 = __builtin_amdgcn_permlane32_swap(a1, b1, false, false); \
        u32x4 w = {r0[0], r1[0], r0[1], r1[1]}; OUT = *reinterpret_cast<bf16x8*>(&w); } while (0)
    PK4(p0, 0, pa0); PK4(p0, 8, pa1); PK4(p1, 0, pa2); PK4(p1, 8, pa3);
#undef PK4
}
__device__ __forceinline__ float row_sum(const f32x16& p0, const f32x16& p1) {
    float sm[4] = {0.f, 0.f, 0.f, 0.f};
#pragma unroll
    for (int r = 0; r < 16; ++r) sm[r & 3] += p0[r] + p1[r];
    const float ps = (sm[0] + sm[1]) + (sm[2] + sm[3]);
    auto rr = __builtin_amdgcn_permlane32_swap(__float_as_uint(ps), __float_as_uint(ps), false, false);
    return __uint_as_float(rr[0]) + __uint_as_float(rr[1]);
}
__device__ __forceinline__ void pv_tile(f32x16* o, int vb0, bf16x8 pa0, bf16x8 pa1, bf16x8 pa2, bf16x8 pa3) {
#define TRRD(dst, off) asm volatile("ds_read_b64_tr_b16 %0, %1 offset:%2" : "=&v"(dst) : "v"(vb0), "i"(off) : "memory")
    s16x4 l[2][4], h[2][4];
#define PV_RD(d0, st) do { constexpr int b_ = L_V + v_rd_off(d0, 0, 0); \
        TRRD(l[st][0], b_); TRRD(h[st][0], b_ + 2048); TRRD(l[st][1], b_ + 4096); TRRD(h[st][1], b_ + 6144); TRRD(l[st][2], b_ + 8192); TRRD(h[st][2], b_ + 10240); TRRD(l[st][3], b_ + 12288); TRRD(h[st][3], b_ + 14336); } while (0)
#define PV_WAIT(n_, st) asm volatile("s_waitcnt lgkmcnt(" #n_ ")" : "+v"(l[st][0]), "+v"(h[st][0]), "+v"(l[st][1]), "+v"(h[st][1]), "+v"(l[st][2]), "+v"(h[st][2]), "+v"(l[st][3]), "+v"(h[st][3]) :: "memory")
#define PV_MM(d0, st) do { \
        o[d0] = __builtin_amdgcn_mfma_f32_32x32x16_bf16(pa0, (bf16x8){l[st][0][0], l[st][0][1], l[st][0][2], l[st][0][3], h[st][0][0], h[st][0][1], h[st][0][2], h[st][0][3]}, o[d0], 0, 0, 0);   \
        o[d0] = __builtin_amdgcn_mfma_f32_32x32x16_bf16(pa1, (bf16x8){l[st][1][0], l[st][1][1], l[st][1][2], l[st][1][3], h[st][1][0], h[st][1][1], h[st][1][2], h[st][1][3]}, o[d0], 0, 0, 0);   \
        o[d0] = __builtin_amdgcn_mfma_f32_32x32x16_bf16(pa2, (bf16x8){l[st][2][0], l[st][2][1], l[st][2][2], l[st][2][3], h[st][2][0], h[st][2][1], h[st][2][2], h[st][2][3]}, o[d0], 0, 0, 0);   \
        o[d0] = __builtin_amdgcn_mfma_f32_32x32x16_bf16(pa3, (bf16x8){l[st][3][0], l[st][3][1], l[st][3][2], l[st][3][3], h[st][3][0], h[st][3][1], h[st][3][2], h[st][3][3]}, o[d0], 0, 0, 0); } while (0)
    PV_RD(0, 0); PV_RD(1, 1);
    PV_WAIT(8, 0); PV_MM(0, 0); PV_RD(2, 0);
    PV_WAIT(8, 1); PV_MM(1, 1); PV_RD(3, 1);
    PV_WAIT(8, 0); PV_MM(2, 0);
    PV_WAIT(0, 1); PV_MM(3, 1);
#undef PV_MM
#undef PV_WAIT
#undef PV_RD
#undef TRRD
}
__device__ __forceinline__ void rescale_o(f32x16* o, float alpha, LAS float* al_l, int r32, int hi) {
    if (__any(alpha < 1.f)) {
        if (hi == 0) al_l[r32] = alpha;
        asm volatile("s_waitcnt lgkmcnt(0)" ::: "memory");
#pragma unroll
        for (int r = 0; r < 16; ++r) { const float a = al_l[crow(r, hi)];
#pragma unroll
            for (int d = 0; d < 4; ++d) o[d][r] *= a; }
        asm volatile("s_waitcnt lgkmcnt(0)" ::: "memory");
    }
}
__device__ __forceinline__ void sm_pv_step(f32x16& p0, f32x16& p1, f32x16* o, float& m_reg, float& l_reg, LAS float* al_l, int vb0, int r32, int hi) {
    float mn, alpha;
    partialSM(p0, p1, m_reg, mn, alpha);
    rescale_o(o, alpha, al_l, r32, hi);
    l_reg = l_reg * alpha + row_sum(p0, p1);
    bf16x8 pa0, pa1, pa2, pa3; pack_p(p0, p1, pa0, pa1, pa2, pa3);
    pv_tile(o, vb0, pa0, pa1, pa2, pa3);
}
__device__ __forceinline__ void lanes_to_rows(float x, float* vals, LAS float* xl, int r32, int hi) {
    if (hi == 0) xl[r32] = x;
    asm volatile("s_waitcnt lgkmcnt(0)" ::: "memory");
#pragma unroll
    for (int r = 0; r < 16; ++r) vals[r] = xl[crow(r, hi)];
    asm volatile("s_waitcnt lgkmcnt(0)" ::: "memory");
}
template <int NI, class Issue, class Active, class Fixup>
__device__ __forceinline__ void pingpong_attn(int nT, int wid, LAS unsigned char* lds, int vb0, const bf16x8* qr, f32x16* o, float& m_reg, float& l_reg, LAS float* al_l, int r32, int hi,
                                              Issue issue, Active active, Fixup fixup) {
    const bool grpB = wid >= 4;
    issue(0); if (nT > 1) issue(1);
    dma_wait<NI>(nT > 1 ? 1 : 0);
    RING_BAR();
    if (grpB) RING_BAR();
    bf16x8 pa0 = {}, pa1 = {}, pa2 = {}, pa3 = {}; bool act_prev = false;
    f32x16 p0 = {}, p1 = {};
    for (int s = 0; s <= nT; ++s) {
        if (s + 2 < nT) issue(s + 2);
        if (act_prev) pv_tile(o, vb0 + ((s - 1) & 3) * KVBUF, pa0, pa1, pa2, pa3);
        bool act = false;
        if (s < nT) { act = active(s); if (act) qkt(p0, p1, lds + (s & 3) * KVBUF, r32, hi, qr); }
        if (s + 1 < nT) dma_wait<NI>(s + 2 < nT ? 1 : 0);
        RING_BAR();
        if (s < nT) {
            if (act) { fixup(s, p0, p1); float mn, alpha; partialSM(p0, p1, m_reg, mn, alpha); rescale_o(o, alpha, al_l, r32, hi); l_reg = l_reg * alpha + row_sum(p0, p1);
                       pack_p(p0, p1, pa0, pa1, pa2, pa3); }
            act_prev = act;
            RING_BAR();
        }
    }
    if (!grpB) RING_BAR();
}
template <int NI, int NSET, class Issue, class Active, class Fixup>
__device__ __forceinline__ void dual_attn(int nT, int wid, LAS unsigned char* lds, int vb0, const bf16x8* qr, f32x16* o, float& m_reg, float& l_reg, LAS float* al_l, int r32, int hi,
                                          Issue issue, Active active, Fixup fixup) {
    const int nS = (nT + 1) >> 1;
    issue(0); if (nT > 1) issue(1);
    for (int s = 0; s < nS; ++s) {
        asm volatile("s_waitcnt vmcnt(0)" ::: "memory");
        RING_BAR();
        if (2 * s + 2 < nT) issue(2 * s + 2);
        if (2 * s + 3 < nT) issue(2 * s + 3);
        const int sa = (2 * s) & 3;
        const float NEGI = -__builtin_inff();
        f32x16 p0, p1, p2, p3;
        const bool acta = active(2 * s);
        if (acta) { qkt<NSET>(p0, p1, lds + sa * KVBUF, r32, hi, qr); fixup(2 * s, p0, p1); }
        else {
#pragma unroll
            for (int r = 0; r < 16; ++r) { p0[r] = NEGI; p1[r] = NEGI; } }
        if (NSET == 2) __builtin_amdgcn_sched_barrier(0);
        bool actb = false;
        if (2 * s + 1 < nT) actb = active(2 * s + 1);
        if (actb) { qkt<NSET>(p2, p3, lds + (sa + 1) * KVBUF, r32, hi, qr); fixup(2 * s + 1, p2, p3); }
        else {
#pragma unroll
            for (int r = 0; r < 16; ++r) { p2[r] = NEGI; p3[r] = NEGI; } }
        if (!acta && !actb) continue;
        float mx[4] = {p0[0], p0[1], p0[2], p0[3]};
#pragma unroll
        for (int r = 4; r < 16; ++r) mx[r & 3] = fmaxf(mx[r & 3], p0[r]);
#pragma unroll
        for (int r = 0; r < 16; ++r) mx[r & 3] = fmaxf(mx[r & 3], fmaxf(p1[r], fmaxf(p2[r], p3[r])));
        float pmax = fmaxf(fmaxf(mx[0], mx[1]), fmaxf(mx[2], mx[3]));
        { auto rr = __builtin_amdgcn_permlane32_swap(__float_as_uint(pmax), __float_as_uint(pmax), false, false);
          pmax = fmaxf(__uint_as_float(rr[0]), __uint_as_float(rr[1])); }
        float mn = m_reg, alpha = 1.f;
        if (__any((pmax - m_reg) * C2 > 8.f)) { mn = fmaxf(m_reg, pmax); alpha = __builtin_amdgcn_exp2f((m_reg - mn) * C2); m_reg = mn; }
        const float mnL = -mn * C2;
#pragma unroll
        for (int r = 0; r < 16; ++r) { p0[r] = __builtin_amdgcn_exp2f(fmaf(p0[r], C2, mnL)); p1[r] = __builtin_amdgcn_exp2f(fmaf(p1[r], C2, mnL));
                                       p2[r] = __builtin_amdgcn_exp2f(fmaf(p2[r], C2, mnL)); p3[r] = __builtin_amdgcn_exp2f(fmaf(p3[r], C2, mnL)); }
        rescale_o(o, alpha, al_l, r32, hi);
        { float sm[4] = {0.f, 0.f, 0.f, 0.f};
#pragma unroll
          for (int r = 0; r < 16; ++r) sm[r & 3] += (p0[r] + p1[r]) + (p2[r] + p3[r]);
          const float ps = (sm[0] + sm[1]) + (sm[2] + sm[3]);
          auto rr = __builtin_amdgcn_permlane32_swap(__float_as_uint(ps), __float_as_uint(ps), false, false);
          l_reg = l_reg * alpha + (__uint_as_float(rr[0]) + __uint_as_float(rr[1])); }
        if (acta) { bf16x8 a0, a1, a2, a3; pack_p(p0, p1, a0, a1, a2, a3); pv_tile(o, vb0 + sa * KVBUF, a0, a1, a2, a3); }
        if (actb) { bf16x8 b0, b1, b2, b3; pack_p(p2, p3, b0, b1, b2, b3); pv_tile(o, vb0 + (sa + 1) * KVBUF, b0, b1, b2, b3); }
    }
}
__device__ __forceinline__ void store_o_bf16(const f32x16* o, const float* rs, bf16_t* __restrict__ Ow, int ldo, int r32, int hi) {
    unsigned w[16][4];
#pragma unroll
    for (int r = 0; r < 16; ++r)
#pragma unroll
        for (int d0 = 0; d0 < 4; ++d0) { const float v = o[d0][r] * rs[r]; const float vn = DPPF(v, 0xB1); w[r][d0] = cvt_pk_bf16(v, vn); }
    if ((r32 & 1) == 0) {
#pragma unroll
        for (int r = 0; r < 16; ++r)
#pragma unroll
            for (int d0 = 0; d0 < 4; ++d0) *(unsigned*)(Ow + (size_t)crow(r, hi) * ldo + d0 * 32 + r32) = w[r][d0];
    }
}
__device__ __forceinline__ int t5_bucket(int n) {
    if (n < 16) return n;
    const float lr = logf((float)n / 16.f) / 2.0794415416798357f;
    const int v = 16 + (int)(lr * 16.f);
    return v < 31 ? v : 31;
}
}

__device__ __forceinline__ void fox_norm_phase(const Frame& F, const bf16_t* __restrict__ proj, unsigned* __restrict__ nrm) {
    const int tid = TID, sub = tid & 15, rl = tid >> 4;
    for (int it = F.bid; it < 256; it += F.G) {
        const int bh = it >> 2, qtr = it & 3, b = bh >> 3, h = bh & 7;
        float mq = 0.f, mk = 0.f;
        for (int r0 = 0; r0 < 1024; r0 += 128) {
            u32x4 qv[4], kv[4];
#pragma unroll
            for (int u = 0; u < 4; ++u) { const size_t row = (size_t)(b * T + qtr * 1024 + r0 + u * 32 + rl) * EV_NP;
                qv[u] = *(const u32x4*)(proj + row + EC_QB + h * 128 + sub * 8); kv[u] = *(const u32x4*)(proj + row + EC_KB + h * 128 + sub * 8); }
#pragma unroll
            for (int u = 0; u < 4; ++u) { const u32x4 q = qv[u], k = kv[u];
                float sq = bflo(q.x) * bflo(q.x) + bfhi(q.x) * bfhi(q.x) + bflo(q.y) * bflo(q.y) + bfhi(q.y) * bfhi(q.y) + bflo(q.z) * bflo(q.z) + bfhi(q.z) * bfhi(q.z) + bflo(q.w) * bflo(q.w) + bfhi(q.w) * bfhi(q.w);
                float sk = bflo(k.x) * bflo(k.x) + bfhi(k.x) * bfhi(k.x) + bflo(k.y) * bflo(k.y) + bfhi(k.y) * bfhi(k.y) + bflo(k.z) * bflo(k.z) + bfhi(k.z) * bfhi(k.z) + bflo(k.w) * bflo(k.w) + bfhi(k.w) * bfhi(k.w);
                sq = row16_sum(sq); sk = row16_sum(sk);
                mq = fmaxf(mq, sq); mk = fmaxf(mk, sk); }
        }
#pragma unroll
        for (int o = 16; o < 64; o <<= 1) { mq = fmaxf(mq, shx(mq, o)); mk = fmaxf(mk, shx(mk, o)); }
        if ((tid & 63) == 0) { atomicMax(nrm + bh * 2, __float_as_uint(mq)); atomicMax(nrm + bh * 2 + 1, __float_as_uint(mk)); }
    }
}
__device__ __forceinline__ void fscan_phase(const Frame& F, const bf16_t* __restrict__ proj, const float* __restrict__ bforget, float* __restrict__ cf) {
    LAS float* red = (LAS float*)F.lds;
    const int tid = TID;
    for (int it = F.bid; it < NB * 8; it += F.G) {
        const int b = it >> 3, h = it & 7; const float bf = bforget[h];
        float v[8]; float s = 0.f;
#pragma unroll
        for (int i = 0; i < 8; ++i) { const int t = tid * 8 + i; const float x = bf2f(proj[(size_t)(b * T + t) * EV_NP + EC_F + h]) + bf;
            const float ls = fminf(x, 0.f) - log1pf(__expf(-fabsf(x))); s += ls; v[i] = s; }
        __syncthreads();
        red[tid] = s;
        __syncthreads();
        if (tid < 64) { float a = 0.f;
            float loc[8];
#pragma unroll
            for (int i = 0; i < 8; ++i) { a += red[tid * 8 + i]; loc[i] = a; }
            float incl = a;
#pragma unroll
            for (int o = 1; o < 64; o <<= 1) { const float n = shu(incl, o); if (tid >= o) incl += n; }
            const float excl = incl - a;
#pragma unroll
            for (int i = 0; i < 8; ++i) red[tid * 8 + i] = excl + loc[i];
        }
        __syncthreads();
        const float base = tid > 0 ? red[tid - 1] : 0.f;
#pragma unroll
        for (int i = 0; i < 8; ++i) cf[(size_t)it * T + tid * 8 + i] = base + v[i];
    }
    __syncthreads();
}

__device__ __forceinline__ void even_attn_phase(const Frame& F, const bf16_t* __restrict__ proj, bf16_t* __restrict__ mix, const float* __restrict__ cf, const float* __restrict__ relb, const float* __restrict__ sinks, const unsigned* __restrict__ nrm, unsigned* __restrict__ qhead) {
    using namespace att;
    LAS unsigned char* lds = F.lds;
    const int tid = opaque_tid(), wid = __builtin_amdgcn_readfirstlane(tid >> 6), lane = tid & 63, r32 = lane & 31, hi = lane >> 5;
    LAS float* al_l = (LAS float*)(lds + EL_WS) + wid * 64;
    LAS float* cfr = (LAS float*)(lds + EL_CFR) + wid * 64;
    LAS float* tab = (LAS float*)(lds + EL_TAB);
    constexpr int LD = EV_NP;
    LAS int* qi = (LAS int*)(lds + EL_MISC);
    for (int i = tid; i < 1024; i += NTHR) tab[i] = relb[t5_bucket(i & 127) * 8 + (i >> 7)] * INV_SCALE;
    for (;;) {
        __syncthreads();
        if (threadIdx.x == 0) *qi = (int)__hip_atomic_fetch_add(qhead, 1u, __ATOMIC_RELAXED, __HIP_MEMORY_SCOPE_AGENT);
        __syncthreads();
        const int it = __builtin_amdgcn_readfirstlane(*qi);
        if (it >= 2048) break;
        const int tid = opaque_tid(), lane = tid & 63, r32 = lane & 31, hi = lane >> 5;
        const int vb0 = (int)(uintptr_t)(lds + L_V) + v_rd_base(lane);
        const KvOff ko = kv_dma_off(tid, LD);
        if (it < 1024) {
            const int qb = 15 - (it >> 6), bh = it & 63;
            const int b = bh >> 3, h = bh & 7, P0 = qb * 256, qpos0 = P0 + wid * 32;
            const bf16_t* Qg = proj + (size_t)(b * T + qpos0 + r32) * LD + EC_QB + h * 128;
            const bf16_t* Kg = proj + (size_t)(b * T) * LD + EC_KB + h * 128;
            const bf16_t* Vg = proj + (size_t)(b * T) * LD + EC_VB + h * 128;
            const float* cfh = cf + (size_t)(b * 8 + h) * T;
            bf16x8 qr[8];
#pragma unroll
            for (int d0 = 0; d0 < 8; ++d0) qr[d0] = *(const bf16x8*)(Qg + d0 * 16 + hi * 8);
            const float crefS = cfh[P0 + 255] * INV_SCALE;
            float m_reg = -1e30f, l_reg = 0.f; f32x16 o[4] = {};
            const int ntile = 4 * qb + 4;
            int jlo;
            { const float bnd = 2.f * sqrtf(__uint_as_float(nrm[(b * 8 + h) * 2]) * __uint_as_float(nrm[(b * 8 + h) * 2 + 1])) * SCALE * 1.02f + cfh[P0];
              const bool keep = (lane >= 4 * qb) || (bnd - cfh[lane * 64 + 63] >= -36.f);
              jlo = __builtin_amdgcn_readfirstlane(__builtin_ctzll(__ballot(keep))); }
            const int nT = ntile - jlo;
#define FOX_ISSUE(k_) do { const int t_ = jlo + (k_), s_ = (k_) & 3; kv_dma(lds + s_ * KVBUF, Kg + (size_t)(t_ * 64) * LD, Vg + (size_t)(t_ * 64) * LD, LD, ko, wid); \
                __builtin_amdgcn_global_load_lds((const unsigned*)(cfh + t_ * 64 + lane), (LAS unsigned*)(cfr + s_ * 512), 4, 0, 0); } while (0)
            __syncthreads();
            int kb = 0; const LAS float* kbb = cfr;
            pingpong_attn<5>(nT, wid, lds, vb0, qr, o, m_reg, l_reg, al_l, r32, hi,
                [&](int k) { FOX_ISSUE(k); },
                [&](int s) { kb = (jlo + s) * 64; kbb = cfr + (s & 3) * 512; return kb <= qpos0 + 31; },
                [&](int, f32x16& p0, f32x16& p1) {
#pragma unroll
                    for (int g4 = 0; g4 < 4; ++g4) { const f32x4 b0 = *(const LAS f32x4*)(kbb + 8 * g4 + 4 * hi), b1 = *(const LAS f32x4*)(kbb + 32 + 8 * g4 + 4 * hi);
#pragma unroll
                        for (int i = 0; i < 4; ++i) { p0[4 * g4 + i] += fmaf(b0[i], -INV_SCALE, crefS); p1[4 * g4 + i] += fmaf(b1[i], -INV_SCALE, crefS); } }
                    if (kb + 63 > qpos0) {
                        const int dq = qpos0 + r32 - kb - 4 * hi; const float NEG = -__builtin_inff();
#pragma unroll
                        for (int r = 0; r < 16; ++r) { const int c = (r & 3) + 8 * (r >> 2); if (dq - c < 0) p0[r] = NEG; if (dq - c - 32 < 0) p1[r] = NEG; }
                    }
                });
#undef FOX_ISSUE
            float rs[16]; lanes_to_rows(__builtin_amdgcn_rcpf(l_reg), rs, al_l, r32, hi);
            store_o_bf16(o, rs, mix + (size_t)(b * T + qpos0) * D + 1024 + h * 128, D, r32, hi);
        } else {
            const int i2 = it - 1024, qb = i2 & 63, bg = i2 >> 6, b = bg >> 1, g = bg & 1;
            const int hl = wid >> 1, head = g * 4 + hl, P0 = qb * 64, qpos0 = P0 + (wid & 1) * 32;
            const bf16_t* Qg = proj + (size_t)(b * T + qpos0 + r32) * LD + EC_QA + head * 128;
            const bf16_t* Kg = proj + (size_t)(b * T) * LD + EC_KA + g * 128;
            const bf16_t* Vg = proj + (size_t)(b * T) * LD + EC_VA + g * 128;
            bf16x8 qr[8];
#pragma unroll
            for (int d0 = 0; d0 < 8; ++d0) qr[d0] = *(const bf16x8*)(Qg + d0 * 16 + hi * 8);
            float m_reg = sinks[head] * INV_SCALE, l_reg = 1.f; f32x16 o[4] = {};
            const LAS float* tb = tab + head * 128;
            const int jt0 = (qb >= 2 ? qb - 2 : 0), nT = qb - jt0 + 1;
            __syncthreads();
            int kb = 0;
            pingpong_attn<4>(nT, wid, lds, vb0, qr, o, m_reg, l_reg, al_l, r32, hi,
                [&](int k) { kv_dma(lds + (k & 3) * KVBUF, Kg + (size_t)((jt0 + k) * 64) * LD, Vg + (size_t)((jt0 + k) * 64) * LD, LD, ko, wid); },
                [&](int s) { kb = (jt0 + s) * 64; return kb <= qpos0 + 31 && kb + 63 >= qpos0 - 127; },
                [&](int, f32x16& p0, f32x16& p1) {
                    const int dq = qpos0 + r32 - kb - 4 * hi; const float NEG = -__builtin_inff();
#pragma unroll
                    for (int r = 0; r < 16; ++r) { const int c = (r & 3) + 8 * (r >> 2); const int d0_ = dq - c, d1_ = dq - c - 32;
                        float t0 = tb[d0_ & 127], t1 = tb[d1_ & 127];
                        asm("" : "+v"(t0), "+v"(t1));
                        p0[r] = ((unsigned)d0_ < 128u) ? p0[r] + t0 : NEG; p1[r] = ((unsigned)d1_ < 128u) ? p1[r] + t1 : NEG; }
                });
            float rs[16]; lanes_to_rows(__builtin_amdgcn_rcpf(l_reg), rs, al_l, r32, hi);
            store_o_bf16(o, rs, mix + (size_t)(b * T + qpos0) * D + head * 128, D, r32, hi);
        }
    }
    __syncthreads();
}

#define N_EVEN_PHASES 5
#define even_mixer_phases \
    PH_BEGIN { pg8::Gemm g{RES, (const bf16_t*)(ws + WS_W_EV_IN + j * SZ_W_EV_IN), M, EC_F, D, D}; pg8::StaticOrder S; S.init(M, EC_F, F.G, F.bid);     \
               pg8::EpiStoreBf16 E{PROJ, EV_NP, RSTD}; pg8::gemm_phase(F.lds, g, S, E); } PH_END \
    PH_BEGIN fscan_phase(F, PROJ, F.in[I_EV_BF] + j * 8, (float*)(ws + WS_CF)); fox_norm_phase(F, PROJ, F.ctl + CW_NORM + j * 128); PH_END \
    PH_BEGIN even_attn_phase(F, PROJ, HB, (const float*)(ws + WS_CF), F.in[I_RELB], F.in[I_EV_SINK] + j * 8, F.ctl + CW_NORM + j * 128, F.ctl + CW_QUEUE + 64 * (4 + j)); PH_END \
    PH_BEGIN { pg8::Gemm g{HB, (const bf16_t*)(ws + WS_W_EV_OUT + j * SZ_W_OUT), M, D, D, D}; pg8::StaticOrder S; S.init(M, D, F.G, F.bid); \
               pg8::EpiAddRes E{RES, D}; pg8::gemm_phase(F.lds, g, S, E); } PH_END \
    PH_BEGIN rowstat_phase(F, RES, RSTD); PH_END
namespace gdn {
constexpr int RLD = 260, AMLD = 68;
constexpr int L_R = 0, L_KB16 = 64 * RLD * 4, L_QB16 = L_KB16 + 64 * 272, L_AM = L_QB16 + 64 * 272, L_GAM = L_AM + 64 * AMLD * 4, L_BETA = L_GAM + 256, L_BEG = L_BETA + 256, L_END = L_BEG + 256, L_WL = L_END + 16  , L_END2 = L_WL + 3 * 4 * 128 * 4;
static_assert(L_END2 <= LDS_BARW && (L_KB16 % 16) == 0 && (L_AM % 16) == 0 && (L_WL % 16) == 0, "gdn lds");
constexpr int RS16 = 272;

__device__ __forceinline__ void chunk_phase(const Frame& F, const bf16_t* __restrict__ proj, const float* __restrict__ convw, const float* __restrict__ alog, const float* __restrict__ dtb, unsigned* __restrict__ qhead) {
    LAS unsigned char* lds = F.lds;
    unsigned char* ws = F.ws;
    bf16_t* Ug = (bf16_t*)(ws + WS_G_U); bf16_t* Wg = (bf16_t*)(ws + WS_G_W); bf16_t* QGg = (bf16_t*)(ws + WS_G_QG); bf16_t* KTg = (bf16_t*)(ws + WS_G_KT);
    bf16_t* ATg = (bf16_t*)(ws + WS_G_ATT); float* GLg = (float*)(ws + WS_G_GL);
    LAS float* R = (LAS float*)(lds + L_R);
    LAS float* AM = (LAS float*)(lds + L_AM); LAS float* GAM = (LAS float*)(lds + L_GAM); LAS float* BETA = (LAS float*)(lds + L_BETA); LAS float* BEG = (LAS float*)(lds + L_BEG);
    LAS int* qi = (LAS int*)(lds + L_END);
    u32x4 xv[3][2][4]; f32x4 wld = (f32x4){0.f, 0.f, 0.f, 0.f}; unsigned blr = 0u, alr = 0u;
#define CH_LOADS(ci_) do { const int n_ = (ci_) & 63, bh_ = (ci_) >> 6, b_ = bh_ >> 3, h_ = bh_ & 7, t0_ = n_ * 64; \
        const int tl_ = opaque_tid(), c0_ = (tl_ & 15) * 8, i0_ = tl_ >> 4;     \
        _Pragma("unroll") for (int which = 0; which < 3; ++which) {             \
            const int pcol = (which == 0 ? OC_QD : which == 1 ? OC_KD : OC_VD) + h_ * 128; \
            _Pragma("unroll") for (int e = 0; e < 2; ++e) \
                _Pragma("unroll") for (int jj = 0; jj < 4; ++jj) { const int t = t0_ + i0_ + e * 32 - 3 + jj, tc = t < 0 ? 0 : t;         \
                    xv[which][e][jj] = *(const u32x4*)(proj + (size_t)(b_ * T + tc) * OD_NP + pcol + c0_); } } \
        if (tl_ < 384) { const int wh = tl_ >> 7, jj = (tl_ & 127) >> 5, c4 = tl_ & 31; wld = *(const f32x4*)(convw + (size_t)jj * 3072 + wh * 1024 + h_ * 128 + c4 * 4); } \
        if (tl_ < 64) { const size_t row = (size_t)(b_ * T + t0_ + tl_) * OD_NP; blr = proj[row + OC_BETA + h_]; alr = proj[row + OC_A + h_]; } } while (0)
#define CH_STEP01(ci_) do { const int n = (ci_) & 63, bh = (ci_) >> 6, h = bh & 7, t0 = n * 64; const int tl = opaque_tid(), c0 = (tl & 15) * 8, i0 = tl >> 4; \
        LAS float* WL = (LAS float*)(lds + L_WL); \
        if (tl < 384) *(LAS f32x4*)(WL + ((tl >> 7) * 4 + ((tl & 127) >> 5)) * 128 + (tl & 31) * 4) = wld; \
        if (tl < 64) { \
            const float bl = __uint_as_float(blr << 16), al = __uint_as_float(alr << 16); const float x = al + dtb[h]; \
            const float sp = fmaxf(x, 0.f) + log1pf(__expf(-fabsf(x))); \
            float g = -__expf(alog[h]) * sp; \
        _Pragma("unroll") \
            for (int o = 1; o < 64; o <<= 1) { const float nb = shu(g, o); if (tl >= o) g += nb; } \
            const float be = sigmoidf_(bl); GAM[tl] = g; BETA[tl] = be; BEG[tl] = be * __expf(g); \
            if (tl == 63) GLg[ci_] = __expf(g); \
        } \
        __syncthreads(); \
        _Pragma("unroll") \
        for (int which = 0; which < 3; ++which) { \
            f32x4 wa[4], wb[4]; \
        _Pragma("unroll") \
            for (int jj = 0; jj < 4; ++jj) { wa[jj] = *(LAS f32x4*)(WL + (which * 4 + jj) * 128 + c0); wb[jj] = *(LAS f32x4*)(WL + (which * 4 + jj) * 128 + c0 + 4); } \
        _Pragma("unroll") \
            for (int e = 0; e < 2; ++e) { \
                const int i = i0 + e * 32; \
                float acc[8]; \
        _Pragma("unroll") \
                for (int q = 0; q < 8; ++q) acc[q] = 0.f; \
        _Pragma("unroll") \
                for (int jj = 0; jj < 4; ++jj) { \
                    const float vz = (t0 + i - 3 + jj >= 0) ? 1.f : 0.f; const u32x4 x = xv[which][e][jj]; \
                    const f32x4 a_ = wa[jj] * vz, b_ = wb[jj] * vz; \
                    acc[0] += a_[0] * bflo(x.x); acc[1] += a_[1] * bfhi(x.x); acc[2] += a_[2] * bflo(x.y); acc[3] += a_[3] * bfhi(x.y); \
                    acc[4] += b_[0] * bflo(x.z); acc[5] += b_[1] * bfhi(x.z); acc[6] += b_[2] * bflo(x.w); acc[7] += b_[3] * bfhi(x.w); \
                } \
                float ss = 0.f; \
        _Pragma("unroll") \
                for (int q = 0; q < 8; ++q) { acc[q] = siluf_(acc[q]); ss += acc[q] * acc[q]; } \
                if (which < 2) { \
                    ss = row16_sum(ss); \
                    const float rn = rsqrtf(ss + EPS) * (which == 0 ? SCALE : 1.f); \
        _Pragma("unroll") \
                    for (int q = 0; q < 8; ++q) acc[q] *= rn; \
                    u32x4 w; w.x = cvt_pk_bf16(acc[0], acc[1]); w.y = cvt_pk_bf16(acc[2], acc[3]); w.z = cvt_pk_bf16(acc[4], acc[5]); w.w = cvt_pk_bf16(acc[6], acc[7]); \
                    *(LAS u32x4*)(lds + (which == 0 ? L_QB16 : L_KB16) + i * RS16 + c0 * 2) = w; \
                } \
                if (which >= 1) { const float sc = (which == 1) ? BEG[i] : BETA[i]; LAS float* dst = R + i * RLD + (which == 1 ? 128 : 0) + c0; \
                    *(LAS f32x4*)dst = (f32x4){acc[0], acc[1], acc[2], acc[3]} * sc; *(LAS f32x4*)(dst + 4) = (f32x4){acc[4], acc[5], acc[6], acc[7]} * sc; } \
            } \
        } \
    } while (0)
    unsigned pend = 0u;
    if (threadIdx.x == 0) pend = __hip_atomic_fetch_add(qhead, 1u, __ATOMIC_RELAXED, __HIP_MEMORY_SCOPE_AGENT);
    __syncthreads();
    if (threadIdx.x == 0) { *qi = (int)pend; pend = __hip_atomic_fetch_add(qhead, 1u, __ATOMIC_RELAXED, __HIP_MEMORY_SCOPE_AGENT); }
    __syncthreads();
    int ci = __builtin_amdgcn_readfirstlane(*qi);
    if (ci < NCHUNK) { CH_LOADS(ci); CH_STEP01(ci); }
    if (threadIdx.x == 0) { *qi = (int)pend; pend = __hip_atomic_fetch_add(qhead, 1u, __ATOMIC_RELAXED, __HIP_MEMORY_SCOPE_AGENT); }
    for (;;) {
        if (ci >= NCHUNK) break;
        __syncthreads();
        const int ci_next = __builtin_amdgcn_readfirstlane(*qi);
        if (ci_next < NCHUNK) CH_LOADS(ci_next);
        {
            const int t2 = opaque_tid(), wid = __builtin_amdgcn_readfirstlane(t2 >> 6), lane = t2 & 63, r32 = lane & 31, hi = lane >> 5;
            const int mat = wid >> 2, ti = (wid >> 1) & 1, tj = wid & 1;
            f32x16 acc = {};
            if (!(ti == 0 && tj == 1)) {
                LAS unsigned char* xa = lds + (mat == 0 ? L_KB16 : L_QB16) + (32 * ti + r32) * RS16 + hi * 16;
                LAS unsigned char* xb = lds + L_KB16 + (32 * tj + r32) * RS16 + hi * 16;
#pragma unroll
                for (int ks = 0; ks < 8; ++ks) acc = __builtin_amdgcn_mfma_f32_32x32x16_bf16(*(LAS bf16x8*)(xa + ks * 32), *(LAS bf16x8*)(xb + ks * 32), acc, 0, 0, 0);
            }
            const int jc = 32 * tj + r32; const float gj = GAM[jc];
#pragma unroll
            for (int r = 0; r < 16; ++r) {
                const int i = 32 * ti + att::crow(r, hi);
                const float dec = __expf(fminf(GAM[i] - gj, 0.f));
                if (mat == 0) AM[i * AMLD + jc] = (jc < i) ? acc[r] * BETA[i] * dec : 0.f;
                else ATg[(size_t)ci * 4096 + i * 64 + jc] = f2bf((jc <= i) ? acc[r] * dec : 0.f);
            }
        }
        __syncthreads();
        const int tid3 = opaque_tid();
        {
            { const int i = tid3 >> 3, c0 = (tid3 & 7) * 16; const float eg = __expf(GAM[i]);
#pragma unroll
              for (int q8 = 0; q8 < 2; ++q8) { const u32x4 x = *(LAS u32x4*)(lds + L_QB16 + i * RS16 + (c0 + q8 * 8) * 2);
                  u32x4 w; w.x = cvt_pk_bf16(bflo(x.x) * eg, bfhi(x.x) * eg); w.y = cvt_pk_bf16(bflo(x.y) * eg, bfhi(x.y) * eg);
                  w.z = cvt_pk_bf16(bflo(x.z) * eg, bfhi(x.z) * eg); w.w = cvt_pk_bf16(bflo(x.w) * eg, bfhi(x.w) * eg);
                  *(u32x4*)(QGg + (size_t)ci * 8192 + i * 128 + c0 + q8 * 8) = w; } }
            { const int dk = tid3 >> 2, i0 = (tid3 & 3) * 16; const float gl = GAM[63];
#pragma unroll
              for (int q8 = 0; q8 < 2; ++q8) { float v[8];
#pragma unroll
                  for (int e = 0; e < 8; ++e) { const int i = i0 + q8 * 8 + e; v[e] = bf2f(*(LAS bf16_t*)(lds + L_KB16 + i * RS16 + dk * 2)) * __expf(gl - GAM[i]); }
                  u32x4 w; w.x = cvt_pk_bf16(v[0], v[1]); w.y = cvt_pk_bf16(v[2], v[3]); w.z = cvt_pk_bf16(v[4], v[5]); w.w = cvt_pk_bf16(v[6], v[7]);
                  *(u32x4*)(KTg + (size_t)ci * 8192 + dk * 64 + i0 + q8 * 8) = w; } }
        }
        {
            const int l3 = tid3 & 63, ln = l3 & 15, lk = l3 >> 4, w3 = __builtin_amdgcn_readfirstlane(tid3 >> 6);
            LAS float* Ro = R; LAS float* AMo = AM;
            asm volatile("" : "+v"(Ro), "+v"(AMo));
#pragma unroll
            for (int bb = 0; bb < 4; ++bb) {
                if (bb > 0) {
                    const int col0 = w3 * 32 + ln, col1 = col0 + 16;
                    f32x4 c0v, c1v;
#pragma unroll
                    for (int r = 0; r < 4; ++r) { c0v[r] = Ro[(16 * bb + 4 * lk + r) * RLD + col0]; c1v[r] = Ro[(16 * bb + 4 * lk + r) * RLD + col1]; }
#pragma unroll
                    for (int bp = 0; bp < bb; ++bp)
#pragma unroll
                        for (int s = 0; s < 4; ++s) {
                            const float am = -AMo[(16 * bb + ln) * AMLD + 16 * bp + 4 * s + lk];
                            const float x0 = Ro[(16 * bp + 4 * s + lk) * RLD + col0], x1 = Ro[(16 * bp + 4 * s + lk) * RLD + col1];
                            c0v = __builtin_amdgcn_mfma_f32_16x16x4f32(am, x0, c0v, 0, 0, 0);
                            c1v = __builtin_amdgcn_mfma_f32_16x16x4f32(am, x1, c1v, 0, 0, 0);
                        }
#pragma unroll
                    for (int r = 0; r < 4; ++r) { Ro[(16 * bb + 4 * lk + r) * RLD + col0] = c0v[r]; Ro[(16 * bb + 4 * lk + r) * RLD + col1] = c1v[r]; }
                    __syncthreads();
                }
                if (tid3 < 256) {
                    LAS float* rc = Ro + (16 * bb) * RLD + tid3;
                    float x[16];
#pragma unroll
                    for (int i = 0; i < 16; ++i) x[i] = rc[i * RLD];
#pragma unroll
                    for (int i = 1; i < 16; ++i) {
#pragma unroll
                        for (int j4 = 0; j4 < (i + 3) / 4; ++j4) {
                            const f32x4 am = *(LAS f32x4*)(AMo + (16 * bb + i) * AMLD + 16 * bb + j4 * 4);
#pragma unroll
                            for (int e = 0; e < 4; ++e) if (j4 * 4 + e < i) x[i] -= am[e] * x[j4 * 4 + e];
                        }
                    }
#pragma unroll
                    for (int i = 1; i < 16; ++i) rc[i * RLD] = x[i];
                }
                __syncthreads();
            }
        }
        if (threadIdx.x == 0) { *qi = (int)pend; pend = __hip_atomic_fetch_add(qhead, 1u, __ATOMIC_RELAXED, __HIP_MEMORY_SCOPE_AGENT); }
        {
            const int tid4 = opaque_tid();
#pragma unroll
            for (int e = 0; e < 4; ++e) { const int idx = tid4 + e * NTHR, i = idx >> 5, ch = idx & 31;
                const f32x4 a0 = *(LAS f32x4*)(R + i * RLD + ch * 8), a1 = *(LAS f32x4*)(R + i * RLD + ch * 8 + 4);
                const float sg = ch < 16 ? 1.f : -1.f;
                u32x4 w; w.x = cvt_pk_bf16(a0[0] * sg, a0[1] * sg); w.y = cvt_pk_bf16(a0[2] * sg, a0[3] * sg); w.z = cvt_pk_bf16(a1[0] * sg, a1[1] * sg); w.w = cvt_pk_bf16(a1[2] * sg, a1[3] * sg);
                *(u32x4*)((ch < 16 ? Ug : Wg) + (size_t)ci * 8192 + i * 128 + (ch & 15) * 8) = w; }
        }
        __syncthreads();
        if (ci_next < NCHUNK) CH_STEP01(ci_next);
        ci = ci_next;
    }
#undef CH_STEP01
#undef CH_LOADS
    __syncthreads();
}

__device__ __forceinline__ bf16x8 ld_afrag(const bf16_t* __restrict__ rowp, int hi) {
    const u32x2 a = *(const u32x2*)(rowp + 4 * hi), b = *(const u32x2*)(rowp + 8 + 4 * hi);
    u32x4 w = {a.x, a.y, b.x, b.y}; return *reinterpret_cast<bf16x8*>(&w);
}
__device__ __forceinline__ bf16x8 acc_bfrag(const f32x16& x, int s) {
    u32x4 w = {cvt_pk_bf16(x[8 * s + 0], x[8 * s + 1]), cvt_pk_bf16(x[8 * s + 2], x[8 * s + 3]), cvt_pk_bf16(x[8 * s + 4], x[8 * s + 5]), cvt_pk_bf16(x[8 * s + 6], x[8 * s + 7])};
    return *reinterpret_cast<bf16x8*>(&w);
}

constexpr int SL_W = 0, SL_QG = SL_W + 64 * 272, SL_KT = SL_QG + 64 * 272, SL_AT = SL_KT + 128 * 144, SL_U = SL_AT + 64 * 144, SL_OS = SL_U + 64 * 256, SL_END = SL_OS + 64 * 132 * 4;
static_assert(SL_END <= LDS_BARW, "scan lds");
__device__ __forceinline__ bf16x8 ld_afrag_lds(const LAS unsigned char* rowp, int hi) {
    const u32x2 a = *(const LAS u32x2*)(rowp + 8 * hi), b = *(const LAS u32x2*)(rowp + 16 + 8 * hi);
    u32x4 w = {a.x, a.y, b.x, b.y}; return *reinterpret_cast<bf16x8*>(&w);
}
__device__ __forceinline__ void scan_item(const Frame& F, int bh, const bf16_t* __restrict__ proj, bf16_t* __restrict__ mix, const float* __restrict__ gnorm) {
    LAS unsigned char* lds = F.lds;
    const int tid = opaque_tid(), wid = __builtin_amdgcn_readfirstlane(tid >> 6), lane = tid & 63, r32 = lane & 31, hi = lane >> 5;
    unsigned char* ws = F.ws;
    const bf16_t* Ug = (const bf16_t*)(ws + WS_G_U); const bf16_t* Wg = (const bf16_t*)(ws + WS_G_W); const bf16_t* QGg = (const bf16_t*)(ws + WS_G_QG); const bf16_t* KTg = (const bf16_t*)(ws + WS_G_KT);
    const bf16_t* ATg = (const bf16_t*)(ws + WS_G_ATT); const float* GLg = (const float*)(ws + WS_G_GL);
    LAS float* OS = (LAS float*)(lds + SL_OS);
    const int b = bh >> 3, h = bh & 7;
    const bool loader = wid >= 4;
    u32x4 st[18];
#define SCAN_LOAD(ci_) do { const size_t c_ = (size_t)(ci_); const int lt = opaque_tid() & 255;     \
        _Pragma("unroll") for (int e = 0; e < 4; ++e) { const int idx = lt + 256 * e; \
            st[e]      = *(const u32x4*)(Wg  + c_ * 8192 + (idx >> 4) * 128 + (idx & 15) * 8); \
            st[4 + e]  = *(const u32x4*)(QGg + c_ * 8192 + (idx >> 4) * 128 + (idx & 15) * 8); \
            st[8 + e]  = *(const u32x4*)(KTg + c_ * 8192 + (idx >> 3) * 64 + (idx & 7) * 8); \
            st[12 + e] = *(const u32x4*)(Ug  + c_ * 8192 + (idx >> 4) * 128 + (idx & 15) * 8); } \
        _Pragma("unroll") for (int e = 0; e < 2; ++e) { const int idx = lt + 256 * e; st[16 + e] = *(const u32x4*)(ATg + c_ * 4096 + (idx >> 3) * 64 + (idx & 7) * 8); } } while (0)
#define SCAN_STORE() do { const int lt = opaque_tid() & 255; \
        _Pragma("unroll") for (int e = 0; e < 4; ++e) { const int idx = lt + 256 * e; \
            *(LAS u32x4*)(lds + SL_W  + (idx >> 4) * 272 + (idx & 15) * 16) = st[e]; \
            *(LAS u32x4*)(lds + SL_QG + (idx >> 4) * 272 + (idx & 15) * 16) = st[4 + e]; \
            *(LAS u32x4*)(lds + SL_KT + (idx >> 3) * 144 + (idx & 7) * 16) = st[8 + e]; \
            *(LAS u32x4*)(lds + SL_U  + (idx >> 4) * 256 + (idx & 15) * 16) = st[12 + e]; } \
        _Pragma("unroll") for (int e = 0; e < 2; ++e) { const int idx = lt + 256 * e; *(LAS u32x4*)(lds + SL_AT + (idx >> 3) * 144 + (idx & 7) * 16) = st[16 + e]; } } while (0)
    const int ci0 = bh * 64;
    const int ni = tid >> 3, nc0 = (tid & 7) * 16;
    const bf16_t* zbase = proj + (size_t)(b * T + ni) * OD_NP + OC_Z + h * 128 + nc0;
    u32x4 z0 = *(const u32x4*)zbase, z1 = *(const u32x4*)(zbase + 8);
    float glv = GLg[ci0];
    if (loader) SCAN_LOAD(ci0);
    __syncthreads();
    if (loader) { SCAN_STORE(); SCAN_LOAD(ci0 + 1); }
    __syncthreads();
    f32x16 S[4] = {};
#pragma unroll 1
    for (int n = 0; n < 64; ++n) {
        if (!loader) {
            const int c0 = 32 * wid;
            bf16x8 vb[2][2];
#pragma unroll
            for (int mt = 0; mt < 2; ++mt) {
                f32x16 vn;
#pragma unroll
                for (int r = 0; r < 16; ++r) vn[r] = bf2f(*(const LAS bf16_t*)(lds + SL_U + (32 * mt + att::crow(r, hi)) * 256 + (c0 + r32) * 2));
                const LAS unsigned char* wrow = lds + SL_W + (32 * mt + r32) * 272;
#pragma unroll
                for (int kt = 0; kt < 4; ++kt)
#pragma unroll
                    for (int s = 0; s < 2; ++s) vn = __builtin_amdgcn_mfma_f32_32x32x16_bf16(ld_afrag_lds(wrow + (kt * 32 + s * 16) * 2, hi), acc_bfrag(S[kt], s), vn, 0, 0, 0);
                vb[mt][0] = acc_bfrag(vn, 0); vb[mt][1] = acc_bfrag(vn, 1);
            }
#pragma unroll
            for (int mt = 0; mt < 2; ++mt) {
                f32x16 oa = {};
                const LAS unsigned char* qrow = lds + SL_QG + (32 * mt + r32) * 272;
#pragma unroll
                for (int kt = 0; kt < 4; ++kt)
#pragma unroll
                    for (int s = 0; s < 2; ++s) oa = __builtin_amdgcn_mfma_f32_32x32x16_bf16(ld_afrag_lds(qrow + (kt * 32 + s * 16) * 2, hi), acc_bfrag(S[kt], s), oa, 0, 0, 0);
                const LAS unsigned char* arow = lds + SL_AT + (32 * mt + r32) * 144;
#pragma unroll
                for (int m2 = 0; m2 <= mt; ++m2)
#pragma unroll
                    for (int s = 0; s < 2; ++s) oa = __builtin_amdgcn_mfma_f32_32x32x16_bf16(ld_afrag_lds(arow + (m2 * 32 + s * 16) * 2, hi), vb[m2][s], oa, 0, 0, 0);
#pragma unroll
                for (int r = 0; r < 16; ++r) OS[(32 * mt + att::crow(r, hi)) * 132 + c0 + r32] = oa[r];
            }
#pragma unroll
            for (int kt = 0; kt < 4; ++kt) {
#pragma unroll
                for (int r = 0; r < 16; ++r) S[kt][r] *= glv;
                const LAS unsigned char* krow = lds + SL_KT + (32 * kt + r32) * 144;
#pragma unroll
                for (int m2 = 0; m2 < 2; ++m2)
#pragma unroll
                    for (int s = 0; s < 2; ++s) S[kt] = __builtin_amdgcn_mfma_f32_32x32x16_bf16(ld_afrag_lds(krow + (m2 * 32 + s * 16) * 2, hi), vb[m2][s], S[kt], 0, 0, 0);
            }
        }
        __syncthreads();
        {
            const int t = n * 64 + ni;
            float v[16]; float ss = 0.f;
#pragma unroll
            for (int q = 0; q < 4; ++q) { const f32x4 x = *(LAS f32x4*)(OS + ni * 132 + nc0 + q * 4); v[q * 4] = x[0]; v[q * 4 + 1] = x[1]; v[q * 4 + 2] = x[2]; v[q * 4 + 3] = x[3]; }
#pragma unroll
            for (int q = 0; q < 16; ++q) ss += v[q] * v[q];
            ss += shx(ss, 1); ss += shx(ss, 2); ss += shx(ss, 4);
            const float rn = rsqrtf(ss * (1.f / 128.f) + EPS);
            const float z[16] = {bflo(z0.x), bfhi(z0.x), bflo(z0.y), bfhi(z0.y), bflo(z0.z), bfhi(z0.z), bflo(z0.w), bfhi(z0.w),
                                 bflo(z1.x), bfhi(z1.x), bflo(z1.y), bfhi(z1.y), bflo(z1.z), bfhi(z1.z), bflo(z1.w), bfhi(z1.w)};
            float y[16];
#pragma unroll
            for (int q = 0; q < 16; ++q) y[q] = v[q] * rn * gnorm[nc0 + q] * siluf_(z[q]);
            u32x4 w0, w1;
            w0.x = cvt_pk_bf16(y[0], y[1]); w0.y = cvt_pk_bf16(y[2], y[3]); w0.z = cvt_pk_bf16(y[4], y[5]); w0.w = cvt_pk_bf16(y[6], y[7]);
            w1.x = cvt_pk_bf16(y[8], y[9]); w1.y = cvt_pk_bf16(y[10], y[11]); w1.z = cvt_pk_bf16(y[12], y[13]); w1.w = cvt_pk_bf16(y[14], y[15]);
            bf16_t* mrow = mix + (size_t)(b * T + t) * D + 1024 + h * 128 + nc0;
            *(u32x4*)mrow = w0; *(u32x4*)(mrow + 8) = w1;
            if (n + 1 < 64) { const bf16_t* zn = zbase + (size_t)((n + 1) * 64) * OD_NP; z0 = *(const u32x4*)zn; z1 = *(const u32x4*)(zn + 8); glv = GLg[ci0 + n + 1]; }
        }
        if (loader && n + 1 < 64) { SCAN_STORE(); if (n + 2 < 64) SCAN_LOAD(ci0 + n + 2); }
        __syncthreads();
    }
#undef SCAN_LOAD
#undef SCAN_STORE
}
}
namespace pg8 {
struct EpiProjOdd {
    static constexpr bool PERM = true;
    bf16_t* O; int ldc; bf16_t* kcmp; bf16_t* vcmp; const float* rs;
    __device__ __forceinline__ void prefetch(const Unit& u, int ui) const { rs_prefetch(rs, u.pm, ui); }
    __device__ __forceinline__ void operator()(const f32x4 (&acc)[2][2][4][2], const Unit& u, int wr, int wc, int ui, int) const {
        const int ol_ = opaque_tid() & 63, fr = ol_ & 15, fq = ol_ >> 4;
        const int row0 = u.pm * BM + wr * 64 + fr, col0 = u.pn * BM + wc * 32 + 8 * fq;
        const bool cmp = (u.pn == 8 || u.pn == 9);
        bf16_t* cb = (u.pn == 8) ? kcmp : vcmp;
        float r_[2][4];
        rs_read(r_, ui, wr, fr);
#pragma unroll
        for (int ai = 0; ai < 2; ++ai)
#pragma unroll
            for (int m = 0; m < 4; ++m) { const int row = row0 + ai * HALF + m * 16; const float r = r_[ai][m];
#pragma unroll
                for (int bj = 0; bj < 2; ++bj) { const f32x4 v0 = acc[ai][bj][m][0] * r, v1 = acc[ai][bj][m][1] * r;
                    u32x4 w; w.x = cvt_pk_bf16(v0[0], v0[1]); w.y = cvt_pk_bf16(v0[2], v0[3]); w.z = cvt_pk_bf16(v1[0], v1[1]); w.w = cvt_pk_bf16(v1[2], v1[3]);
                    bf16_t* p = cmp ? cb + ((size_t)((row / T) * 2 + bj) * T + (row % T)) * 128 + wc * 32 + 8 * fq
                                    : O + (size_t)row * ldc + col0 + bj * HALF;
                    *(u32x4*)p = w; } }
    }
};
__device__ __forceinline__ float gelu_tanh(float x) { const float y = 0.7978845608028654f * (x + 0.044715f * x * x * x); return x * __builtin_amdgcn_rcpf(1.f + __expf(-2.f * y)); }
struct EpiGeluBf16 {
    static constexpr bool PERM = true;
    bf16_t* O; int ldc; const float* bias;
    __device__ __forceinline__ void prefetch(const Unit&, int) const {}
    __device__ __forceinline__ void operator()(const f32x4 (&acc)[2][2][4][2], const Unit& u, int wr, int wc, int, int) const {
        const int ol_ = opaque_tid() & 63, fr = ol_ & 15, fq = ol_ >> 4;
        const int row0 = u.pm * BM + wr * 64 + fr, col0 = u.pn * BM + wc * 32 + 8 * fq;
#pragma unroll
        for (int bj = 0; bj < 2; ++bj) { f32x4 b0 = (f32x4){0.f, 0.f, 0.f, 0.f}, b1 = b0;
#pragma unroll 8
            for (int pp = 0; pp < 32; ++pp) { b0 += *(const f32x4*)(bias + pp * 256 + col0 + bj * HALF); b1 += *(const f32x4*)(bias + pp * 256 + col0 + bj * HALF + 4); }
#pragma unroll
            for (int ai = 0; ai < 2; ++ai)
#pragma unroll
                for (int m = 0; m < 4; ++m) { const f32x4 v0 = acc[ai][bj][m][0] + b0, v1 = acc[ai][bj][m][1] + b1;
                    u32x4 w; w.x = cvt_pk_bf16(gelu_tanh(v0[0]), gelu_tanh(v0[1])); w.y = cvt_pk_bf16(gelu_tanh(v0[2]), gelu_tanh(v0[3]));
                    w.z = cvt_pk_bf16(gelu_tanh(v1[0]), gelu_tanh(v1[1])); w.w = cvt_pk_bf16(gelu_tanh(v1[2]), gelu_tanh(v1[3]));
                    *(u32x4*)(O + (size_t)(row0 + ai * HALF + m * 16) * ldc + col0 + bj * HALF) = w; } }
    }
};
}

namespace nsa {
using namespace att;
constexpr int IMP_LD = 257, SC_LD = 65;
constexpr int L_IMP = 2 * att::KVBUF, L_SC = L_IMP + 64 * IMP_LD * 4  , L_WS = L_SC + 64 * SC_LD * 4, L_TAB = L_WS + 2048, L_BM = L_TAB + 8 * 129 * 4, L_QI = L_BM + 512, L_GATE = L_QI + 16  , L_ENDN = L_GATE + 4096;
static_assert(L_ENDN <= LDS_BARW && (L_IMP % 16) == 0 && L_IMP + 2 * att::KVBUF <= L_SC, "nsa lds");

template <int MODE>
__device__ __forceinline__ void branch_out(const f32x16* o, const float* rs, float* __restrict__ accw, bf16_t* __restrict__ Ow, int ldo, int, int) {
    const int l_ = opaque_tid() & 63, r32 = l_ & 31, hi = l_ >> 5;
    float* base = accw + 4 * hi * 128 + r32;
    float a[16][4];
    if (MODE != 0) {
#pragma unroll
        for (int r = 0; r < 16; ++r)
#pragma unroll
            for (int d0 = 0; d0 < 4; ++d0) a[r][d0] = base[((r & 3) + 8 * (r >> 2)) * 128 + d0 * 32];
    }
    if (MODE != 2) {
#pragma unroll
        for (int r = 0; r < 16; ++r)
#pragma unroll
            for (int d0 = 0; d0 < 4; ++d0) { const float v = o[d0][r] * rs[r]; base[((r & 3) + 8 * (r >> 2)) * 128 + d0 * 32] = (MODE == 0) ? v : a[r][d0] + v; }
    } else {
        unsigned w[16][4];
#pragma unroll
        for (int r = 0; r < 16; ++r)
#pragma unroll
            for (int d0 = 0; d0 < 4; ++d0) { const float v = o[d0][r] * rs[r] + a[r][d0]; const float vn = DPPF(v, 0xB1); w[r][d0] = cvt_pk_bf16(v, vn); }
        if ((r32 & 1) == 0) {
#pragma unroll
            for (int r = 0; r < 16; ++r) { const int orow = crow(r, hi);
#pragma unroll
                for (int d0 = 0; d0 < 4; ++d0) *(unsigned*)(Ow + (size_t)(orow >> 2) * ldo + (orow & 3) * 128 + d0 * 32 + r32) = w[r][d0]; }
        }
    }
}

__device__ __forceinline__ void nsa_item(const Frame& F, int item, const bf16_t* __restrict__ proj, bf16_t* __restrict__ mix, const float* __restrict__ relb) {
    LAS unsigned char* lds = F.lds;
    const int tid = opaque_tid(), wid = __builtin_amdgcn_readfirstlane(tid >> 6), lane = tid & 63, r32 = lane & 31, hi = lane >> 5;
    unsigned char* ws = F.ws;
    LAS float* al_l = (LAS float*)(lds + L_WS) + wid * 64;
    LAS float* tab = (LAS float*)(lds + L_TAB);
    LAS float* IMP = (LAS float*)(lds + L_IMP);
    LAS float* SC = (LAS float*)(lds + L_SC);
    LAS unsigned* BM = (LAS unsigned*)(lds + L_BM);
    const int vb0 = (int)(uintptr_t)(lds + L_V) + v_rd_base(lane);
    constexpr int LD = OD_NP;
    const int qb = 63 - (item >> 4), bg = item & 15, b = bg >> 1, g = bg & 1;
    const int P0 = qb * 64, qlo = P0 + wid * 8, qhi = qlo + 7, ql = wid * 8 + (r32 >> 2), hl = r32 & 3, head = g * 4 + hl, qpos = qlo + (r32 >> 2), cur = qb;
    float* accw = (float*)(ws + WS_NSAACC) + ((size_t)F.bid * 256 + wid * 32) * 128;
    __syncthreads();
    for (int i = tid; i < 64 * IMP_LD; i += NTHR) IMP[i] = 0.f;
    if (tid < 128) BM[tid] = 0u;
    const size_t qrow = (size_t)(b * T + qpos) * LD;
    bf16x8 qr[8];
#pragma unroll
    for (int d0 = 0; d0 < 8; ++d0) qr[d0] = *(const bf16x8*)(proj + qrow + OC_QC + head * 128 + d0 * 16 + hi * 8);
    { u32x2 gg; gg.x = (unsigned)proj[qrow + OC_GATE + head] | ((unsigned)proj[qrow + OC_GATE + 8 + head] << 16); gg.y = proj[qrow + OC_GATE + 16 + head];
      *(LAS u32x2*)(lds + L_GATE + tid * 8) = gg; }
#define gate01_ (((const LAS unsigned*)(lds + L_GATE))[opaque_tid() * 2])
#define gate2_  (((const LAS unsigned*)(lds + L_GATE))[opaque_tid() * 2 + 1])
#define NSA_GATE(br) sigmoidf_((br) == 0 ? bflo(gate01_) : (br) == 1 ? bfhi(gate01_) : bflo(gate2_))
    const LAS float* tb = tab + head * 129;
    const float NEG = -__builtin_inff();

    const bf16_t* KCg = (const bf16_t*)(ws + WS_KC) + (size_t)(bg * 256) * 256;
    const bf16_t* VCg = KCg + (size_t)4096 * 256;
    const int cmax = (qpos - 31) >> 4;
    const int cmax_wg = (P0 + 63 - 31) >> 4;
    const int nct = (cmax_wg >> 6) + 1;
    float m_reg = -1e30f, l_reg = 0.f;
    {
        const KvOff kc = kv_dma_off(tid, 256);
        kv_dma(lds, KCg, VCg, 256, kc, wid);
        float inv_l = 0.f, mL = 0.f;
        f32x16 o[4] = {};
        for (int s = 0; s < 2 * nct; ++s) {
            const int jt = s < nct ? s : s - nct, bo = (s & 1) * KVBUF;
            asm volatile("s_waitcnt vmcnt(0)" ::: "memory");
            RING_BAR();
            if (s + 1 < 2 * nct) { const int jn = (s + 1 < nct) ? s + 1 : s + 1 - nct; kv_dma(lds + (bo ^ KVBUF), KCg + (size_t)(jn * 64) * 256, VCg + (size_t)(jn * 64) * 256, 256, kc, wid); }
            if (s == nct) { inv_l = l_reg > 0.f ? 1.f / l_reg : 0.f; mL = -m_reg * C2; }
            f32x16 p0, p1; qkt(p0, p1, lds + bo, r32, hi, qr);
            if (s < nct) {
#pragma unroll
                for (int r = 0; r < 16; ++r) { const int c = jt * 64 + crow(r, hi); if (c > cmax) p0[r] = NEG; if (c + 32 > cmax) p1[r] = NEG; }
                float mn, alpha; partialSM(p0, p1, m_reg, mn, alpha);
                l_reg = l_reg * alpha + row_sum(p0, p1);
            } else {
                LAS float* ib = IMP + ql * IMP_LD + jt * 64 + 4 * hi;
#pragma unroll
                for (int r = 0; r < 16; ++r) { const int c = jt * 64 + crow(r, hi);
                    p0[r] = (c <= cmax) ? __builtin_amdgcn_exp2f(fmaf(p0[r], C2, mL)) * inv_l : 0.f;
                    p1[r] = (c + 32 <= cmax) ? __builtin_amdgcn_exp2f(fmaf(p1[r], C2, mL)) * inv_l : 0.f;
                    float s0 = p0[r], s1 = p1[r];
                    s0 += DPPF(s0, 0xB1); s1 += DPPF(s1, 0xB1); s0 += DPPF(s0, 0x4E); s1 += DPPF(s1, 0x4E);
                    if (hl == 0) { ib[(r & 3) + 8 * (r >> 2)] = s0; ib[(r & 3) + 8 * (r >> 2) + 32] = s1; } }
                bf16x8 pa0, pa1, pa2, pa3; pack_p(p0, p1, pa0, pa1, pa2, pa3);
                pv_tile(o, vb0 + bo, pa0, pa1, pa2, pa3);
            }
        }
        float rs[16]; lanes_to_rows(NSA_GATE(0), rs, al_l, r32, hi);
        branch_out<0>(o, rs, accw, nullptr, 0, r32, hi);
    }
    __syncthreads();
    {
        const int q = tid & 63, j0 = (tid >> 6) * 8;
        const LAS float* ip = IMP + q * IMP_LD;
#pragma unroll
        for (int e = 0; e < 8; ++e) { const int j = j0 + e;
            const float left = (j > 0) ? ip[4 * j - 1] : 0.f;
            const float blk = left + 2.f * (ip[4 * j] + ip[4 * j + 1] + ip[4 * j + 2]) + ip[4 * j + 3];
            const bool forced = (j == 0) || (j == cur) || (j == cur - 1);
            SC[q * SC_LD + j] = forced ? 1e9f : (j > cur ? -1e9f : blk); }
    }
    __syncthreads();
    {
        const int q = tid & 63, j0 = (tid >> 6) * 8;
        unsigned long long mine[8]; int rank[8];
#define NSA_KEY(sc_, j_) ((((unsigned long long)(__float_as_uint(sc_) ^ ((__float_as_uint(sc_) >> 31) ? 0xffffffffu : 0x80000000u))) << 6) | (unsigned)(63 - (j_)))
#pragma unroll
        for (int e = 0; e < 8; ++e) { const float v = SC[q * SC_LD + j0 + e]; mine[e] = NSA_KEY(v, j0 + e); rank[e] = 0; }
#pragma unroll 2
        for (int jj = 0; jj <= cur; ++jj) { const float sv = SC[q * SC_LD + jj]; const unsigned long long ks = NSA_KEY(sv, jj);
#pragma unroll
            for (int e = 0; e < 8; ++e) rank[e] += (ks > mine[e]) ? 1 : 0; }
#undef NSA_KEY
        unsigned bits = 0u;
#pragma unroll
        for (int e = 0; e < 8; ++e) if (rank[e] < 8 && (j0 + e) <= cur) bits |= 1u << e;
        if (bits) __hip_atomic_fetch_or(BM + q * 2 + (j0 >> 5), bits << (j0 & 31), __ATOMIC_RELAXED, __HIP_MEMORY_SCOPE_WORKGROUP);
    }
    __syncthreads();
    unsigned wu_lo, wu_hi, gu_lo, gu_hi;
    { unsigned a = BM[ql * 2], c = BM[ql * 2 + 1];
#pragma unroll
      for (int o_ = 1; o_ < 32; o_ <<= 1) { a |= shx(a, o_); c |= shx(c, o_); }
      wu_lo = __builtin_amdgcn_readfirstlane(a); wu_hi = __builtin_amdgcn_readfirstlane(c);
      unsigned a2 = BM[lane * 2], c2 = BM[lane * 2 + 1];
#pragma unroll
      for (int o_ = 1; o_ < 64; o_ <<= 1) { a2 |= shx(a2, o_); c2 |= shx(c2, o_); }
      gu_lo = __builtin_amdgcn_readfirstlane(a2); gu_hi = __builtin_amdgcn_readfirstlane(c2); }
    {
        const int tid = opaque_tid(), lane = tid & 63, r32 = lane & 31, hi = lane >> 5, qpos = qlo + (r32 >> 2), ql = wid * 8 + (r32 >> 2);
        const int vb0 = (int)(uintptr_t)(lds + L_V) + v_rd_base(lane);
        const KvOff ko = kv_dma_off(tid, LD);
        const bf16_t* Kg = proj + (size_t)(b * T) * LD + OC_KSEL + g * 128;
        const bf16_t* Vg = proj + (size_t)(b * T) * LD + OC_VSEL + g * 128;
        m_reg = -1e30f; l_reg = 0.f; f32x16 o[4] = {};
        unsigned long long remI = ((unsigned long long)gu_hi << 32) | gu_lo, remC = remI;
        const int nT = __builtin_popcountll(remI);
#define SEL_ISSUE(k_) do { const int jn = __builtin_ctzll(remI); remI &= remI - 1; kv_dma(lds + ((k_) & 3) * KVBUF, Kg + (size_t)(jn * 64) * LD, Vg + (size_t)(jn * 64) * LD, LD, ko, wid); } while (0)
        int jt = 0, kb = 0;
        dual_attn<4, 4>(nT, wid, lds, vb0, qr, o, m_reg, l_reg, al_l, r32, hi,
            [&](int k) { SEL_ISSUE(k); },
            [&](int) { jt = __builtin_ctzll(remC); remC &= remC - 1; kb = jt * 64; return ((jt < 32 ? wu_lo >> jt : wu_hi >> (jt - 32)) & 1u) != 0u; },
            [&](int, f32x16& p0, f32x16& p1) {
                const bool mysel = ((BM[ql * 2 + (jt >> 5)] >> (jt & 31)) & 1u) != 0u;
                const int dq = qpos - kb - 4 * hi;
                if (qlo - kb >= 190) {
                    const float tc = tb[127];
#pragma unroll
                    for (int r = 0; r < 16; ++r) { p0[r] = mysel ? p0[r] + tc : NEG; p1[r] = mysel ? p1[r] + tc : NEG; }
                } else {
#pragma unroll
                for (int r = 0; r < 16; ++r) { const int c = (r & 3) + 8 * (r >> 2); const int d0_ = dq - c, d1_ = dq - c - 32;
                    float t0 = tb[min(max(d0_, 0), 127)], t1 = tb[min(max(d1_, 0), 127)];
                    asm("" : "+v"(t0), "+v"(t1));
                    p0[r] = (mysel && d0_ >= 0) ? p0[r] + t0 : NEG; p1[r] = (mysel && d1_ >= 0) ? p1[r] + t1 : NEG; }
                }
            });
#undef SEL_ISSUE
        float rs[16]; lanes_to_rows(l_reg > 0.f ? NSA_GATE(1) * __builtin_amdgcn_rcpf(l_reg) : 0.f, rs, al_l, r32, hi);
        branch_out<1>(o, rs, accw, nullptr, 0, r32, hi);
    }
    {
        const int tid = opaque_tid(), lane = tid & 63, r32 = lane & 31, hi = lane >> 5, qpos = qlo + (r32 >> 2);
        const int vb0 = (int)(uintptr_t)(lds + L_V) + v_rd_base(lane);
        const KvOff ko = kv_dma_off(tid, LD);
        const bf16_t* Kg = proj + (size_t)(b * T) * LD + OC_KWIN + g * 128;
        const bf16_t* Vg = proj + (size_t)(b * T) * LD + OC_VWIN + g * 128;
        m_reg = -1e30f; l_reg = 0.f; f32x16 o[4] = {};
        const int jt0 = (qb >= 8 ? qb - 8 : 0), nT = qb - jt0 + 1;
#define WIN_ISSUE(k_) kv_dma(lds + ((k_) & 3) * KVBUF, Kg + (size_t)((jt0 + (k_)) * 64) * LD, Vg + (size_t)((jt0 + (k_)) * 64) * LD, LD, ko, wid)
        __syncthreads();
        int kb = 0;
        dual_attn<4, 4>(nT, wid, lds, vb0, qr, o, m_reg, l_reg, al_l, r32, hi,
            [&](int k) { WIN_ISSUE(k); },
            [&](int s) { kb = (jt0 + s) * 64; return kb <= qhi && kb + 63 >= qlo - 511; },
            [&](int, f32x16& p0, f32x16& p1) {
                const int dq = qpos - kb - 4 * hi;
                if (qlo - kb >= 190 && qhi - kb <= 511) {
                    const float tc = tb[127];
#pragma unroll
                    for (int r = 0; r < 16; ++r) { p0[r] += tc; p1[r] += tc; }
                } else {
#pragma unroll
                for (int r = 0; r < 16; ++r) { const int c = (r & 3) + 8 * (r >> 2); const int d0_ = dq - c, d1_ = dq - c - 32;
                    float t0 = tb[min(max(d0_, 0), 127)], t1 = tb[min(max(d1_, 0), 127)];
                    asm("" : "+v"(t0), "+v"(t1));
                    p0[r] = ((unsigned)d0_ < 512u) ? p0[r] + t0 : NEG; p1[r] = ((unsigned)d1_ < 512u) ? p1[r] + t1 : NEG; }
                }
            });
#undef WIN_ISSUE
        float rs[16]; lanes_to_rows(l_reg > 0.f ? NSA_GATE(2) * __builtin_amdgcn_rcpf(l_reg) : 0.f, rs, al_l, r32, hi);
        branch_out<2>(o, rs, accw, mix + (size_t)(b * T + qlo) * D + g * 512, D, r32, hi);
    }
#undef NSA_GATE
#undef gate01_
#undef gate2_
}

__device__ __forceinline__ void odd_attn_phase(const Frame& F, const bf16_t* __restrict__ proj, bf16_t* __restrict__ mix, const float* __restrict__ relb, const float* __restrict__ gnorm, unsigned* __restrict__ qhead) {
    for (int bh = F.bid; bh < NB * 8; bh += F.G) gdn::scan_item(F, bh, proj, mix, gnorm);
    LAS int* qi = (LAS int*)(F.lds + L_QI);
    __syncthreads();
    for (int i = opaque_tid(); i < 8 * 129; i += NTHR) { const int hd = i / 129, dist = i - hd * 129; ((LAS float*)(F.lds + L_TAB))[i] = relb[att::t5_bucket(dist < 128 ? dist : 127) * 8 + hd] * INV_SCALE; }
    for (;;) {
        __syncthreads();
        if (threadIdx.x == 0) *qi = (int)__hip_atomic_fetch_add(qhead, 1u, __ATOMIC_RELAXED, __HIP_MEMORY_SCOPE_AGENT);
        __syncthreads();
        const int item = __builtin_amdgcn_readfirstlane(*qi);
        if (item >= 1024) break;
        nsa_item(F, item, proj, mix, relb);
    }
    __syncthreads();
}
}

#define N_ODD_PHASES 5
#define odd_mixer_phases \
    PH_BEGIN { pg8::Gemm g{RES, (const bf16_t*)(ws + WS_W_OD_IN + j * SZ_W_OD_IN), M, OD_NP, D, D}; pg8::StaticOrder S; S.init(M, OD_NP, F.G, F.bid); \
               pg8::EpiProjOdd E{PROJ, OD_NP, (bf16_t*)(ws + WS_KCMP), (bf16_t*)(ws + WS_VCMP), RSTD}; pg8::gemm_phase(F.lds, g, S, E); } PH_END \
    PH_BEGIN { for (int kv = 0; kv < 2; ++kv) { \
                 { pg8::Gemm g{(const bf16_t*)(ws + (kv ? WS_VCMP : WS_KCMP)), (const bf16_t*)(ws + WS_W_C1 + (j * 2 + kv) * SZ_W_C1), 4096, 256, 4096, 2048}; \
                   pg8::StaticOrder S; S.init(4096, 256, F.G, (F.bid + F.G - 16 * kv) % F.G); \
                   pg8::EpiGeluBf16 E{(bf16_t*)(ws + WS_CHID) + (size_t)kv * 4096 * 256, 256, (const float*)(ws + WS_C1B) + (j * 2 + kv) * 32 * 256}; pg8::gemm_phase(F.lds, g, S, E); } \
                 asm volatile("s_waitcnt vmcnt(0)" ::: "memory"); __syncthreads();     \
                 { pg8::Gemm g{(const bf16_t*)(ws + WS_CHID) + (size_t)kv * 4096 * 256, (const bf16_t*)(ws + WS_W_C2 + (j * 2 + kv) * SZ_W_C2), 4096, 256, 256, 256}; \
                   pg8::StaticOrder S; S.init(4096, 256, F.G, (F.bid + F.G - 16 * kv) % F.G); \
                   pg8::EpiStoreBf16 E{(bf16_t*)(ws + WS_KC) + (size_t)kv * 4096 * 256, 256, nullptr}; pg8::gemm_phase(F.lds, g, S, E); } } \
               gdn::chunk_phase(F, PROJ, F.in[I_OD_CONVW] + (size_t)j * 4 * 3072, F.in[I_OD_ALOG] + j * 8, F.in[I_OD_DTB] + j * 8, F.ctl + CW_QUEUE + 64 * (2 + j)); } PH_END \
    PH_BEGIN nsa::odd_attn_phase(F, PROJ, HB, F.in[I_RELB], F.in[I_OD_GNORM] + j * 128, F.ctl + CW_QUEUE + 64 * j); PH_END \
    PH_BEGIN { pg8::Gemm g{HB, (const bf16_t*)(ws + WS_W_OD_OUT + j * SZ_W_OUT), M, D, D, D}; pg8::StaticOrder S; S.init(M, D, F.G, F.bid); \
               pg8::EpiAddRes E{RES, D}; pg8::gemm_phase(F.lds, g, S, E); } PH_END \
    PH_BEGIN rowstat_phase(F, RES, RSTD); PH_END
struct Args { const float* in[22]; float* out; unsigned char* ws; int ph_lo, ph_hi; };

#ifndef MIXERS
#define MIXERS 3
#endif

__global__ void __launch_bounds__(NTHR, 2) mega(Args args) {
    extern __shared__ __attribute__((aligned(16))) unsigned char lds_raw[];
    Frame F;
    F.lds = (LAS unsigned char*)lds_raw;
    F.G = gridDim.x; F.bid = blockIdx.x;
    F.in = (const float* const*)__builtin_amdgcn_kernarg_segment_ptr();
    F.out = args.out; F.ws = args.ws; F.ctl = (unsigned*)(args.ws + WS_CTL);
    const int lo = args.ph_lo, hi = args.ph_hi;
    volatile LAS unsigned* barw = (volatile LAS unsigned*)(F.lds + LDS_BARW);
    if (TID < 4) barw[TID] = 0u;
    __syncthreads();
    XcdBarrier bar; bar.bar = F.ctl + CW_BAR; bar.x = 0; bar.st = barw;
    if (hi - lo > 1) bar = xcd_barrier_post(F.ctl + CW_BAR, barw);
    int ph = 0;
#define PH_BEGIN if (lo <= ph && ph < hi) {
#define PH_END   if (ph + 1 < hi) xcd_barrier(bar); } ++ph;
    unsigned char* ws = F.ws;
    bf16_t* HB = (bf16_t*)F.out;
    bf16_t* RES = (bf16_t*)(ws + WS_RES);
    float* RSTD = F.out + (size_t)M * D / 2;
    bf16_t* PROJ = (bf16_t*)(ws + WS_PROJ);

    PH_BEGIN p0_prologue(F); PH_END
    PH_BEGIN rowstat_f_phase(F, RES, RSTD, (const bf16_t*)(ws + WS_W_EV_IN) + (size_t)EC_F * D, PROJ); PH_END

    for (int layer = 0; layer < 4; ++layer) {
        const int j = layer >> 1;
        if ((layer & 1) == 0) {
#if (MIXERS & 1)
            even_mixer_phases
#endif
        } else {
#if (MIXERS & 2)
            odd_mixer_phases
#endif
        }
        PH_BEGIN {
            pg8::Gemm g{RES, (const bf16_t*)(ws + WS_W_UP + layer * SZ_W_UP), M, FF2, D, D};
            pg8::StaticOrder S; S.init(M, FF2, F.G, F.bid);
            pg8::EpiFfnGate E{(bf16_t*)(ws + WS_ACT), F.in[I_F_CONVW] + (size_t)layer * 3 * FF, F.in[I_F_CONVB] + (size_t)layer * FF,
                              (float*)(ws + WS_TAIL), (float*)(ws + WS_HEADG), (float*)(ws + WS_HEADU), F.lds + 131072, RSTD};
            pg8::gemm_phase(F.lds, g, S, E);
        } PH_END
        PH_BEGIN
            ffn_fixup_phase(F, (bf16_t*)(ws + WS_ACT), (const float*)(ws + WS_TAIL), (const float*)(ws + WS_HEADG), (const float*)(ws + WS_HEADU),
                            F.in[I_F_CONVW] + (size_t)layer * 3 * FF, F.in[I_F_CONVB] + (size_t)layer * FF);
        PH_END
        PH_BEGIN {
            pg8::Gemm g{(const bf16_t*)(ws + WS_ACT), (const bf16_t*)(ws + WS_W_DN + layer * SZ_W_DN), M, D, FF, FF};
            pg8::StaticOrder S; S.init(M, D, F.G, F.bid);
            pg8::EpiAddRes E{RES, D};
            pg8::gemm_phase(F.lds, g, S, E);
        } PH_END
        if (layer == 1) { PH_BEGIN rowstat_f_phase(F, RES, RSTD, (const bf16_t*)(ws + WS_W_EV_IN + SZ_W_EV_IN) + (size_t)EC_F * D, PROJ); PH_END }
        else if (layer < 3) { PH_BEGIN rowstat_phase(F, RES, RSTD); PH_END }
        else { PH_BEGIN final_norm_phase(F, RES, F.out, F.in[I_NFIN]); PH_END }
    }
#undef PH_BEGIN
#undef PH_END
}

static int count_phases() {
    int ph = 2;
    for (int layer = 0; layer < 4; ++layer) {
        if ((layer & 1) == 0) { if (MIXERS & 1) ph += N_EVEN_PHASES; } else { if (MIXERS & 2) ph += N_ODD_PHASES; }
        ph += 3; ph += 1;
    }
    return ph;
}

#ifndef N_LAUNCH_MODE
#define N_LAUNCH_MODE 0
#endif

extern "C" void kernel_launch(void* const* d_in, const int* in_sizes, int n_in, void* d_out, int out_size, void* d_ws, size_t ws_size, hipStream_t stream) {
    static int grid = 0;
    if (grid == 0) {
        if (n_in != 22 || out_size != M * D || ws_size < WS_END) { fprintf(stderr, "kernel_launch: unexpected shapes (n_in %d out %d ws %zu need %zu)\n", n_in, out_size, ws_size, (size_t)WS_END); grid = -1; return; }
        int dev = 0, cus = 0, per_cu = 0;
        if (hipGetDevice(&dev) != hipSuccess || hipDeviceGetAttribute(&cus, hipDeviceAttributeMultiprocessorCount, dev) != hipSuccess) { grid = -1; return; }
        if (hipFuncSetAttribute((const void*)mega, hipFuncAttributeMaxDynamicSharedMemorySize, LDS_BYTES) != hipSuccess) { fprintf(stderr, "kernel_launch: hipFuncSetAttribute failed\n"); grid = -1; return; }
        if (hipOccupancyMaxActiveBlocksPerMultiprocessor(&per_cu, (const void*)mega, NTHR, LDS_BYTES) != hipSuccess || per_cu < 1) { fprintf(stderr, "kernel_launch: occupancy query says %d\n", per_cu); }
        (void)hipGetLastError();
        grid = cus;
    }
    if (grid < 0) return;
    (void)hipMemsetAsync((char*)d_ws + WS_CTL, 0, CTL_BYTES, stream);
    Args a{};
    for (int i = 0; i < 22; ++i) a.in[i] = (const float*)d_in[i];
    a.out = (float*)d_out; a.ws = (unsigned char*)d_ws;
    const int nph = count_phases();
#if N_LAUNCH_MODE == 1
    a.ph_lo = 0; a.ph_hi = nph;
    hipLaunchKernelGGL(mega, dim3(grid), dim3(NTHR), LDS_BYTES, stream, a);
#else
    for (int p = 0; p < nph; ++p) { a.ph_lo = p; a.ph_hi = p + 1; hipLaunchKernelGGL(mega, dim3(grid), dim3(NTHR), LDS_BYTES, stream, a); }
#endif
}
```

```cpp
#define MIXERS 3
#define N_LAUNCH_MODE 1
#include <hip/hip_runtime.h>
#include <cstdio>
#include <cstdint>

#define LAS __attribute__((address_space(3)))
typedef unsigned short bf16_t;
typedef short bf16x8 __attribute__((ext_vector_type(8)));
typedef short s16x4 __attribute__((ext_vector_type(4)));
typedef float f32x2 __attribute__((ext_vector_type(2)));
typedef float f32x4 __attribute__((ext_vector_type(4)));
typedef float f32x16 __attribute__((ext_vector_type(16)));
typedef unsigned u32x2 __attribute__((ext_vector_type(2)));
typedef unsigned u32x4 __attribute__((ext_vector_type(4)));

constexpr int NB = 8, T = 4096, M = NB * T, D = 2048, HD = 128;
constexpr int EV_N = 4616, EV_NP = 4864, OD_N = 6696, OD_NP = 6912, FF = 5632, FF2 = 11264;
constexpr int MH = M / 2;
constexpr int NTHR = 512, NWAVE = 8;
constexpr int LDS_BYTES = 159744;
constexpr int LDS_BARW = LDS_BYTES - 16;
constexpr float EPS = 1e-6f;
constexpr float SCALE = 0.08838834764831845f;
constexpr float INV_SCALE = 11.313708498984761f;
constexpr float LOG2E = 1.4426950408889634f;

constexpr int EC_QA = 0, EC_QB = 1024, EC_KA = 2048, EC_VA = 2304, EC_KB = 2560, EC_VB = 3584, EC_F = 4608;
constexpr int OC_QC = 0, OC_QD = 1024, OC_KCMP = 2048, OC_VCMP = 2304, OC_KSEL = 2560, OC_VSEL = 2816, OC_KWIN = 3072, OC_VWIN = 3328,
              OC_KD = 3584, OC_VD = 4608, OC_Z = 5632, OC_GATE = 6656, OC_BETA = 6680, OC_A = 6688;

__host__ __device__ inline int ev_src(int n) {
    if (n < 1024) return n;
    if (n < 2048) return n - 1024 + 1536;
    if (n < 2304) return n - 2048 + 1024;
    if (n < 2560) return n - 2304 + 1280;
    if (n < 3584) return n - 2560 + 2560;
    if (n < 4608) return n - 3584 + 3584;
    if (n < 4616) return n;
    return -1;
}
__host__ __device__ inline int od_src(int n) {
    if (n < 1024) return n;
    if (n < 2048) return n - 1024 + 2584;
    if (n < 3584) return n - 2048 + 1024;
    if (n < 4608) return n - 3584 + 3608;
    if (n < 5632) return n - 4608 + 4632;
    if (n < 6656) return n - 5632 + 5672;
    if (n < 6680) return n - 6656 + 2560;
    if (n < 6688) return n - 6680 + 5656;
    if (n < 6696) return n - 6688 + 5664;
    return -1;
}

constexpr size_t al256(size_t x) { return (x + 255) & ~(size_t)255; }
constexpr size_t WS_CTL = 0, CTL_BYTES = 65536;
constexpr size_t SZ_W_EV_IN = (size_t)EV_NP * D * 2, SZ_W_OUT = (size_t)D * D * 2, SZ_W_OD_IN = (size_t)OD_NP * D * 2,
                 SZ_W_UP = (size_t)FF2 * D * 2, SZ_W_DN = (size_t)D * FF * 2, SZ_W_C1 = (size_t)256 * 4096 * 2, SZ_W_C2 = (size_t)256 * 256 * 2;
constexpr size_t WS_W_EV_IN = WS_CTL + CTL_BYTES;
constexpr size_t WS_W_EV_OUT = WS_W_EV_IN + 2 * SZ_W_EV_IN;
constexpr size_t WS_W_OD_IN = WS_W_EV_OUT + 2 * SZ_W_OUT;
constexpr size_t WS_W_OD_OUT = WS_W_OD_IN + 2 * SZ_W_OD_IN;
constexpr size_t WS_W_UP = WS_W_OD_OUT + 2 * SZ_W_OUT;
constexpr size_t WS_W_DN = WS_W_UP + 4 * SZ_W_UP;
constexpr size_t WS_W_C1 = WS_W_DN + 4 * SZ_W_DN;
constexpr size_t WS_W_C2 = WS_W_C1 + 4 * SZ_W_C1;
constexpr size_t WS_C1B = WS_W_C2 + 4 * SZ_W_C2;
constexpr size_t WS_HB = WS_C1B + 131072;
constexpr size_t WS_RES = WS_HB;
constexpr size_t SZ_HB = (size_t)M * D * 2;
constexpr size_t WS_R = WS_HB + SZ_HB;
constexpr size_t SZ_PROJ = (size_t)M * OD_NP * 2;
constexpr size_t WS_PROJ = WS_R;
constexpr size_t WS_R2 = WS_R + SZ_PROJ;
constexpr size_t WS_CF = WS_R2;
constexpr size_t SZ_CMPBUF = (size_t)(16 * T + 64) * 128 * 2;
constexpr size_t WS_KCMP = WS_R2, WS_VCMP = al256(WS_KCMP + SZ_CMPBUF);
constexpr int NCHUNK = NB * 8 * (T / 64);
constexpr size_t SZ_G16 = (size_t)NCHUNK * 64 * 128 * 2;
constexpr size_t WS_G_U = al256(WS_VCMP + SZ_CMPBUF), WS_G_W = WS_G_U + SZ_G16, WS_G_QG = WS_G_W + SZ_G16, WS_G_KT = WS_G_QG + SZ_G16;
constexpr size_t WS_G_ATT = WS_G_KT + SZ_G16;
constexpr size_t WS_G_GL = WS_G_ATT + (size_t)NCHUNK * 64 * 64 * 2;
constexpr size_t WS_CHID = al256(WS_G_GL + (size_t)NCHUNK * 4);
constexpr size_t WS_KC = WS_CHID + (size_t)2 * 4096 * 256 * 2;
constexpr size_t WS_NSAACC = WS_KC + (size_t)2 * 4096 * 256 * 2;
constexpr size_t WS_R_END_ODD = WS_NSAACC + (size_t)256 * 256 * 128 * 4;
constexpr size_t SZ_HALO = (size_t)(M / 256) * 2 * FF * 4;
constexpr size_t WS_ACT = WS_R, WS_TAIL = WS_ACT + (size_t)M * FF * 2, WS_HEADG = WS_TAIL + SZ_HALO, WS_HEADU = WS_HEADG + SZ_HALO, WS_R_END_FFN = WS_HEADU + SZ_HALO;
constexpr size_t WS_END = (WS_R_END_ODD > WS_R_END_FFN ? WS_R_END_ODD : WS_R_END_FFN);

constexpr int CW_BAR = 0;
constexpr int CW_QUEUE = 4096;
constexpr int CW_NORM = 8192;

typedef __bf16 bf16v2_ __attribute__((ext_vector_type(2)));
__device__ __forceinline__ unsigned cvt_pk_bf16(float lo, float hi) { const f32x2 v = {lo, hi}; const bf16v2_ r = __builtin_convertvector(v, bf16v2_); return __builtin_bit_cast(unsigned, r); }
__device__ __forceinline__ bf16_t f2bf(float f) { return (bf16_t)(cvt_pk_bf16(f, 0.f) & 0xffffu); }
__device__ __forceinline__ float bf2f(bf16_t b) { return __uint_as_float(((unsigned)b) << 16); }
__device__ __forceinline__ float bflo(unsigned w) { return __uint_as_float(w << 16); }
__device__ __forceinline__ float bfhi(unsigned w) { return __uint_as_float(w & 0xffff0000u); }
__device__ __forceinline__ int opaque_tid() { int t = threadIdx.x; asm volatile("" : "+v"(t)); return t; }
__device__ __forceinline__ int olane() { return opaque_tid() & 63; }
__device__ __forceinline__ float shx(float v, int m) { return __builtin_bit_cast(float, __builtin_amdgcn_ds_bpermute((olane() ^ m) << 2, __builtin_bit_cast(int, v))); }
__device__ __forceinline__ unsigned shx(unsigned v, int m) { return (unsigned)__builtin_amdgcn_ds_bpermute((olane() ^ m) << 2, (int)v); }
__device__ __forceinline__ float shu(float v, int d) { const int l = olane(), s = l - d; return __builtin_bit_cast(float, __builtin_amdgcn_ds_bpermute((s < 0 ? l : s) << 2, __builtin_bit_cast(int, v))); }
#define DPPF(x, ctrl) __builtin_bit_cast(float, __builtin_amdgcn_update_dpp(0, __builtin_bit_cast(int, (x)), (ctrl), 0xf, 0xf, true))
__device__ __forceinline__ float row16_sum(float x) { x += DPPF(x, 0x128); x += DPPF(x, 0x124); x += DPPF(x, 0x122); x += DPPF(x, 0x121); return x; }
__device__ __forceinline__ float row8_sum(float x) { x += DPPF(x, 0xB1); x += DPPF(x, 0x4E); x += DPPF(x, 0x141); return x; }
__device__ __forceinline__ float wave_sum(float v) { v = row16_sum(v); v += shx(v, 16); v += shx(v, 32); return v; }
__device__ __forceinline__ float sigmoidf_(float x) { return __builtin_amdgcn_rcpf(1.f + __expf(-x)); }
__device__ __forceinline__ float siluf_(float x) { return x * __builtin_amdgcn_rcpf(1.f + __expf(-x)); }

#define XB_TMO      128
#define XB_XCNT(j)  (256  + 64 * (j))
#define XB_XSUB(j)  (1280 + 64 * (j))
#define XB_XGEN(j)  (2304 + 64 * (j))
#define XB_TOP      3328
#define XB_TOPGEN   3392
#define XCD_BAR_WORDS 3456
#define XB_SPIN_CAP (1u << 24)

__device__ __forceinline__ unsigned xb_ld(unsigned* p)              { return __hip_atomic_load(p, __ATOMIC_RELAXED, __HIP_MEMORY_SCOPE_AGENT); }
__device__ __forceinline__ unsigned xb_add(unsigned* p, unsigned v) { return __hip_atomic_fetch_add(p, v, __ATOMIC_RELAXED, __HIP_MEMORY_SCOPE_AGENT); }
__device__ __forceinline__ unsigned xb_xcc_id() { return (unsigned)__builtin_amdgcn_s_getreg((3 << 11) | 20) & 0xFu; }
#define XB_SPIN(cond, bar) do { unsigned _sp = 0; while (cond) { __builtin_amdgcn_s_sleep(1); \
    if ((++_sp & 255u) == 0u) { if (xb_ld(&(bar)[XB_TMO])) break; if (_sp > XB_SPIN_CAP) { atomicAdd(&(bar)[XB_TMO], 1u); break; } } } } while (0)

struct XcdBarrier { unsigned* bar; unsigned x; volatile LAS unsigned* st; };

__device__ __forceinline__ XcdBarrier xcd_barrier_post(unsigned* bar, volatile LAS unsigned* st) {
    XcdBarrier b; b.bar = bar; b.x = xb_xcc_id(); b.st = st;
    if (threadIdx.x == 0) (void)xb_add(&bar[XB_XCNT(b.x)], 1u);
    return b;
}
__device__ __forceinline__ void xcd_barrier_complete(unsigned* bar, unsigned x, unsigned& nloc, unsigned& nx) {
    const unsigned G = gridDim.x * gridDim.y * gridDim.z;
    unsigned sum, cnt, mine, sp = 0u;
    for (;;) {
        sum = 0u; cnt = 0u; mine = 0u;
#pragma unroll
        for (unsigned j = 0; j < 16; ++j) { const unsigned c = xb_ld(&bar[XB_XCNT(j)]); sum += c; cnt += (c > 0u) ? 1u : 0u; mine = (j == x) ? c : mine; }
        if (sum == G) break;
        __builtin_amdgcn_s_sleep(1);
        if ((++sp & 255u) == 0u) { if (xb_ld(&bar[XB_TMO])) break; if (sp > XB_SPIN_CAP) { atomicAdd(&bar[XB_TMO], 1u); break; } }
    }
    nloc = mine > 0u ? mine : 1u; nx = cnt > 0u ? cnt : 1u;
}
__device__ __forceinline__ void xcd_barrier(const XcdBarrier& b) {
    asm volatile("s_waitcnt vmcnt(0)" ::: "memory");
    __syncthreads();
    if (threadIdx.x == 0) {
        unsigned* bar = b.bar;
        __builtin_amdgcn_s_waitcnt(0);
        unsigned nloc = b.st[0], nx = b.st[1];
        if (nloc == 0u) { xcd_barrier_complete(bar, b.x, nloc, nx); b.st[0] = nloc; b.st[1] = nx; }
        const unsigned old = xb_add(&bar[XB_XSUB(b.x)], 1u);
        const unsigned gen = old / nloc;
        if (old + 1u == (gen + 1u) * nloc) {
            __builtin_amdgcn_fence(__ATOMIC_RELEASE, "agent");
            asm volatile("s_waitcnt vmcnt(0)" ::: "memory");
            const unsigned og = xb_add(&bar[XB_TOP], 1u);
            const unsigned tg = og / nx;
            if (og + 1u == (tg + 1u) * nx) xb_add(&bar[XB_TOPGEN], 1u);
            else XB_SPIN(xb_ld(&bar[XB_TOPGEN]) == tg, bar);
            __builtin_amdgcn_fence(__ATOMIC_ACQUIRE, "agent");
            xb_add(&bar[XB_XGEN(b.x)], 1u);
            asm volatile("s_waitcnt vmcnt(0)" ::: "memory");
        } else {
            XB_SPIN(xb_ld(&bar[XB_XGEN(b.x)]) == gen, bar);
            __builtin_amdgcn_fence(__ATOMIC_ACQUIRE, "agent");
            asm volatile("s_waitcnt vmcnt(0)" ::: "memory");
        }
    }
    __syncthreads();
}

namespace pg8 {
constexpr int BM = 256, BK = 64, HALF = 128, HTB = HALF * BK * 2, STAGE_BYTES = 8 * HTB, NXCD = 8, WGM = 4;
__host__ __device__ __forceinline__ int lds_byte(int r, int c) { const int st = (r >> 4) * 2 + (c >> 5), rr = r & 15, cc = c & 31, ob = rr * 64 + cc * 2; return st * 1024 + (ob ^ (((ob >> 9) & 1) << 5)); }
__host__ __device__ __forceinline__ void stage_rc(int b, int& R, int& C) { const int st = b / 1024, sb = b % 1024, swz = sb ^ (((sb >> 9) & 1) << 5); R = (st >> 1) * 16 + swz / 64; C = (st & 1) * 32 + (swz % 64) / 2; }
__host__ __device__ __forceinline__ int perm32(int rho) { const int n = rho >> 4, i = rho & 15; return 8 * (i >> 2) + 4 * n + (i & 3); }

struct Unit { int pm, pn; };
struct Gemm { const bf16_t* A; const bf16_t* Bt; int M, N, K, lda; };

struct StaticOrder {
    int nM, nN, nwg, G, c;
    __host__ __device__ void init(int M_, int N_, int G_, int c_) { nM = M_ / BM; nN = N_ / BM; nwg = nM * nN; G = G_; c = c_; }
    __host__ __device__ bool next(int i, Unit& u) const {
        const long L = (long)i * G + c; if (L >= nwg) return false;
        int wgid = (int)L; { const int q = nwg / NXCD, r = nwg % NXCD, xcd = wgid % NXCD, off = wgid / NXCD; wgid = (xcd < r ? xcd * (q + 1) : r * (q + 1) + (xcd - r) * q) + off; }
        const int nig = WGM * nN, gid = wgid / nig, fm = gid * WGM, gsz = (nM - fm) < WGM ? (nM - fm) : WGM;
        u.pm = fm + ((wgid % nig) % gsz); u.pn = (wgid % nig) / gsz; return true;
    }
    __device__ __forceinline__ void a_ready(const Unit&) const {}
    __device__ __forceinline__ void done(const Unit&) const {}
};

constexpr int L_RSPF = 131072 + 4096;
__device__ __forceinline__ void rs_prefetch(const float* rs, int pm, int ui) {
    const int t = opaque_tid(), w = __builtin_amdgcn_readfirstlane(t >> 6);
    extern __shared__ __attribute__((aligned(16))) unsigned char lds_dyn_[];
    if (w < 4) __builtin_amdgcn_global_load_lds((const unsigned*)(rs + pm * BM + t), (LAS unsigned*)((LAS unsigned char*)lds_dyn_ + L_RSPF + (ui & 1) * 1024 + w * 256), 4, 0, 0);
}
__device__ __forceinline__ void rs_read(float (&r_)[2][4], int ui, int wr, int fr) {
    extern __shared__ __attribute__((aligned(16))) unsigned char lds_dyn_[];
    const LAS float* rl = (const LAS float*)((LAS unsigned char*)lds_dyn_ + L_RSPF + (ui & 1) * 1024) + wr * 64 + fr;
#pragma unroll
    for (int ai = 0; ai < 2; ++ai)
#pragma unroll
        for (int m = 0; m < 4; ++m) r_[ai][m] = rl[ai * HALF + m * 16];
}
struct EpiStoreBf16 {
    static constexpr bool PERM = true;
    bf16_t* O; int ldc; const float* rs;
    __device__ __forceinline__ void prefetch(const Unit& u, int ui) const { if (rs) rs_prefetch(rs, u.pm, ui); }
    __device__ __forceinline__ void operator()(const f32x4 (&acc)[2][2][4][2], const Unit& u, int wr, int wc, int ui, int) const {
        const int ol_ = opaque_tid() & 63, fr = ol_ & 15, fq = ol_ >> 4;
        const int row0 = u.pm * BM + wr * 64 + fr, col0 = u.pn * BM + wc * 32 + 8 * fq;
        float r_[2][4];
        if (rs) rs_read(r_, ui, wr, fr);
        else {
#pragma unroll
            for (int ai = 0; ai < 2; ++ai)
#pragma unroll
                for (int m = 0; m < 4; ++m) r_[ai][m] = 1.f;
        }
#pragma unroll
        for (int ai = 0; ai < 2; ++ai)
#pragma unroll
            for (int m = 0; m < 4; ++m) { bf16_t* rowp = O + (size_t)(row0 + ai * HALF + m * 16) * ldc + col0; const float r = r_[ai][m];
#pragma unroll
                for (int bj = 0; bj < 2; ++bj) { const f32x4 v0 = acc[ai][bj][m][0] * r, v1 = acc[ai][bj][m][1] * r;
                    u32x4 w; w.x = cvt_pk_bf16(v0[0], v0[1]); w.y = cvt_pk_bf16(v0[2], v0[3]); w.z = cvt_pk_bf16(v1[0], v1[1]); w.w = cvt_pk_bf16(v1[2], v1[3]);
                    *(u32x4*)(rowp + bj * HALF) = w; } }
    }
};
struct EpiAddRes {
    static constexpr bool PERM = true;
    bf16_t* C; int ldc;
    __device__ __forceinline__ void prefetch(const Unit&, int) const {}
    __device__ __forceinline__ void operator()(const f32x4 (&acc)[2][2][4][2], const Unit& u, int wr, int wc, int, int) const {
        const int ol_ = opaque_tid() & 63, fr = ol_ & 15, fq = ol_ >> 4;
        const int row0 = u.pm * BM + wr * 64 + fr, col0 = u.pn * BM + wc * 32 + 8 * fq;
        u32x4 cin[2][4][2];
#pragma unroll
        for (int ai = 0; ai < 2; ++ai)
#pragma unroll
            for (int m = 0; m < 4; ++m)
#pragma unroll
                for (int bj = 0; bj < 2; ++bj) cin[ai][m][bj] = *(const u32x4*)(C + (size_t)(row0 + ai * HALF + m * 16) * ldc + col0 + bj * HALF);
#pragma unroll
        for (int ai = 0; ai < 2; ++ai)
#pragma unroll
            for (int m = 0; m < 4; ++m)
#pragma unroll
                for (int bj = 0; bj < 2; ++bj) { const u32x4 c = cin[ai][m][bj]; const f32x4 v0 = acc[ai][bj][m][0], v1 = acc[ai][bj][m][1];
                    u32x4 w; w.x = cvt_pk_bf16(bflo(c.x) + v0[0], bfhi(c.x) + v0[1]); w.y = cvt_pk_bf16(bflo(c.y) + v0[2], bfhi(c.y) + v0[3]);
                    w.z = cvt_pk_bf16(bflo(c.z) + v1[0], bfhi(c.z) + v1[1]); w.w = cvt_pk_bf16(bflo(c.w) + v1[2], bfhi(c.w) + v1[3]);
                    *(u32x4*)(C + (size_t)(row0 + ai * HALF + m * 16) * ldc + col0 + bj * HALF) = w; }
    }
};
struct EpiFfnGate {
    static constexpr bool PERM = true;
    bf16_t* act; const float* cw; const float* cb; float* tail; float* headg; float* headu; LAS unsigned char* hl; const float* rs;
    __device__ __forceinline__ void prefetch(const Unit& u, int ui) const { rs_prefetch(rs, u.pm, ui); }
    __device__ __forceinline__ void operator()(f32x4 (&acc)[2][2][4][2], const Unit& u, int wr, int wc, int ui, int) const {
        const int ol_ = opaque_tid() & 63, fr = ol_ & 15, fq = ol_ >> 4;
        { float r_[2][4];
          rs_read(r_, ui, wr, fr);
#pragma unroll
          for (int ai = 0; ai < 2; ++ai)
#pragma unroll
              for (int bj = 0; bj < 2; ++bj)
#pragma unroll
                  for (int m = 0; m < 4; ++m) { acc[ai][bj][m][0] *= r_[ai][m]; acc[ai][bj][m][1] *= r_[ai][m]; } }
        const int col = u.pn * 128 + wc * 32 + 8 * fq;
        if (fr >= 14) {
#pragma unroll
            for (int ai = 0; ai < 2; ++ai) { LAS f32x4* s = (LAS f32x4*)(hl + ((((ai * 2 + wr) * 4 + wc) * 8 + fq * 2 + (fr - 14)) * 32));
                s[0] = acc[ai][1][3][0]; s[1] = acc[ai][1][3][1]; }
        }
        asm volatile("s_waitcnt lgkmcnt(0)" ::: "memory"); __builtin_amdgcn_s_barrier(); asm volatile("" ::: "memory");
        __builtin_amdgcn_s_barrier(); asm volatile("" ::: "memory");
        float w0[8], w1[8], w2[8], bb[8];
        { const f32x4 a0 = *(const f32x4*)(cw + col), a1 = *(const f32x4*)(cw + col + 4), b0 = *(const f32x4*)(cw + FF + col), b1 = *(const f32x4*)(cw + FF + col + 4),
                      c0 = *(const f32x4*)(cw + 2 * FF + col), c1 = *(const f32x4*)(cw + 2 * FF + col + 4), d0 = *(const f32x4*)(cb + col), d1 = *(const f32x4*)(cb + col + 4);
#pragma unroll
          for (int e = 0; e < 4; ++e) { w0[e] = a0[e] * -LOG2E; w0[4 + e] = a1[e] * -LOG2E; w1[e] = b0[e] * -LOG2E; w1[4 + e] = b1[e] * -LOG2E; w2[e] = c0[e] * -LOG2E; w2[4 + e] = c1[e] * -LOG2E; bb[e] = d0[e] * -LOG2E; bb[4 + e] = d1[e] * -LOG2E; } }
#pragma unroll
        for (int ai = 0; ai < 2; ++ai) {
            f32x4 hal[2] = {(f32x4){0.f, 0.f, 0.f, 0.f}, (f32x4){0.f, 0.f, 0.f, 0.f}};
            if (!(ai == 0 && wr == 0) && fr >= 14) {
                const int sai = (wr == 1) ? ai : 0, swr = (wr == 1) ? 0 : 1;
                const LAS f32x4* s = (const LAS f32x4*)(hl + ((((sai * 2 + swr) * 4 + wc) * 8 + fq * 2 + (fr - 14)) * 32));
                hal[0] = s[0]; hal[1] = s[1];
            }
#pragma unroll
            for (int m = 0; m < 4; ++m) {
                const int row = u.pm * BM + ai * HALF + wr * 64 + m * 16 + fr;
                float o[8], z[8], g1[8], g2[8];
#pragma unroll
                for (int k = 0; k < 8; ++k) { const int n = k >> 2, e = k & 3;
                    const float gc = acc[ai][1][m][n][e], gp = (m == 0) ? hal[n][e] : acc[ai][1][m - 1][n][e];
                    const int gci = __builtin_bit_cast(int, gc), gpi = __builtin_bit_cast(int, gp);
                    const int r1 = __builtin_amdgcn_update_dpp(0, gpi, 0x121, 0xf, 0xf, true), r2 = __builtin_amdgcn_update_dpp(0, gpi, 0x122, 0xf, 0xf, true);
                    g1[k] = __builtin_bit_cast(float, __builtin_amdgcn_update_dpp(r1, gci, 0x111, 0xf, 0xf, false));
                    g2[k] = __builtin_bit_cast(float, __builtin_amdgcn_update_dpp(r2, gci, 0x112, 0xf, 0xf, false)); }
#pragma unroll
                for (int k = 0; k < 8; ++k) z[k] = w0[k] * g2[k] + bb[k];
#pragma unroll
                for (int k = 0; k < 8; ++k) z[k] += w1[k] * g1[k];
#pragma unroll
                for (int k = 0; k < 8; ++k) z[k] += w2[k] * acc[ai][1][m][k >> 2][k & 3];
#pragma unroll
                for (int k = 0; k < 8; ++k) o[k] = __builtin_amdgcn_exp2f(z[k]);
#pragma unroll
                for (int k = 0; k < 8; ++k) o[k] += 1.f;
#pragma unroll
                for (int k = 0; k < 8; ++k) o[k] = __builtin_amdgcn_rcpf(o[k]);
#pragma unroll
                for (int k = 0; k < 8; ++k) z[k] *= acc[ai][0][m][k >> 2][k & 3];
#pragma unroll
                for (int k = 0; k < 8; ++k) o[k] *= z[k];
                u32x4 w; w.x = cvt_pk_bf16(o[0], o[1]); w.y = cvt_pk_bf16(o[2], o[3]); w.z = cvt_pk_bf16(o[4], o[5]); w.w = cvt_pk_bf16(o[6], o[7]);
                *(u32x4*)(act + (size_t)row * FF + col) = w;
            }
        }
        if (wr == 1 && fr >= 14) { float* t = tail + ((size_t)u.pm * 2 + (fr - 14)) * FF + col; *(f32x4*)t = acc[1][1][3][0]; *(f32x4*)(t + 4) = acc[1][1][3][1]; }
        if (wr == 0 && fr < 2) { float* hg = headg + ((size_t)u.pm * 2 + fr) * FF + col; *(f32x4*)hg = acc[0][1][0][0]; *(f32x4*)(hg + 4) = acc[0][1][0][1];
                                 float* hu = headu + ((size_t)u.pm * 2 + fr) * FF + col; *(f32x4*)hu = acc[0][0][0][0]; *(f32x4*)(hu + 4) = acc[0][0][0][1]; }
    }
};

template <class Epi, class Sched>
__device__ __forceinline__ void gemm_phase(LAS unsigned char* lds, const Gemm g, const Sched& S, const Epi& E) {
    const int tid = opaque_tid(), wid = __builtin_amdgcn_readfirstlane(tid >> 6), lane = tid & 63, wr = wid >> 2, wc = wid & 3, fr = lane & 15, fq = lane >> 4;
    const int K = g.K, nt = K / BK, lda = g.lda;
    unsigned voffA[2], voffB[2];
#pragma unroll
    for (int i = 0; i < 2; ++i) { int R, C; stage_rc(tid * 16 + i * 8192, R, C); const int Rb = Epi::PERM ? ((R & ~31) + perm32(R & 31)) : R;
        voffA[i] = (unsigned)(R * lda + C) * 2u; voffB[i] = (unsigned)(Rb * K + C) * 2u; }
    const size_t kstep = (size_t)(BK * 2);
    const size_t hstepA = (size_t)HALF * lda * 2, hstepB = (size_t)HALF * K * 2;
    const size_t tstepA = 2 * hstepA, tstepB = 2 * hstepB;
    const unsigned ldsw = (unsigned)wid * 1024u;
    const int aoff = lds_byte(wr * 64 + fr, fq * 8), boff = lds_byte(wc * 32 + fr, fq * 8);
#define PG8_SA(b, h) (((b) * 2 + (h)) * HTB)
#define PG8_SB(b, h) ((4 + (b) * 2 + (h)) * HTB)
#define PG8_STAGE(bufoff, gbase, voff) do { _Pragma("unroll") for (int _i = 0; _i < 2; ++_i) \
        __builtin_amdgcn_global_load_lds((const unsigned*)((const char*)(gbase) + (voff)[_i]), (LAS unsigned*)(lds + (bufoff) + ldsw + _i * 8192), 16, 0, 0); } while (0)
#define PG8_LDA(dst, b, h) do { _Pragma("unroll") for (int m = 0; m < 4; ++m) _Pragma("unroll") for (int k = 0; k < 2; ++k) dst[m][k] = *(const LAS bf16x8*)(lds + PG8_SA(b, h) + aoff + m * 2048 + k * 1024); } while (0)
#define PG8_LDB(dst, b, h) do { _Pragma("unroll") for (int n = 0; n < 2; ++n) _Pragma("unroll") for (int k = 0; k < 2; ++k) dst[n][k] = *(const LAS bf16x8*)(lds + PG8_SB(b, h) + boff + n * 2048 + k * 1024); } while (0)
#define PG8_MMA(ai, bj, At, Bt) do { __builtin_amdgcn_s_setprio(1); _Pragma("unroll") for (int m = 0; m < 4; ++m) _Pragma("unroll") for (int n = 0; n < 2; ++n) _Pragma("unroll") for (int k = 0; k < 2; ++k) \
        acc[ai][bj][m][n] = __builtin_amdgcn_mfma_f32_16x16x32_bf16(Bt[n][k], At[m][k], acc[ai][bj][m][n], 0, 0, 0); __builtin_amdgcn_s_setprio(0); } while (0)
#define PG8_WAIT_V(n) asm volatile("s_waitcnt vmcnt(" #n ")" ::: "memory")
#define PG8_WAIT_L(n) asm volatile("s_waitcnt lgkmcnt(" #n ")" ::: "memory")
#define PG8_BAR __builtin_amdgcn_s_barrier()
#define PG8_SCHED __builtin_amdgcn_sched_barrier(0)
    Unit cur, nxt; int ui = 0;
    if (!S.next(0, cur)) return;
    f32x4 acc[2][2][4][2];
#pragma unroll
    for (int a = 0; a < 2; ++a)
#pragma unroll
        for (int b = 0; b < 2; ++b)
#pragma unroll
            for (int m = 0; m < 4; ++m)
#pragma unroll
                for (int n = 0; n < 2; ++n) acc[a][b][m][n] = (f32x4){0.f, 0.f, 0.f, 0.f};
    bf16x8 At[4][2], B0[2][2], B1[2][2];
    const char* cA = (const char*)g.A + (size_t)cur.pm * tstepA; const char* cB = (const char*)g.Bt + (size_t)cur.pn * tstepB;
    S.a_ready(cur);
    PG8_STAGE(PG8_SB(0, 0), cB, voffB); PG8_STAGE(PG8_SA(0, 0), cA, voffA); PG8_STAGE(PG8_SB(0, 1), cB + hstepB, voffB); PG8_STAGE(PG8_SA(0, 1), cA + hstepA, voffA);
    if (wr == 1) PG8_BAR;
    PG8_WAIT_V(4); PG8_BAR;
    PG8_STAGE(PG8_SB(1, 0), cB + kstep, voffB); PG8_STAGE(PG8_SA(1, 0), cA + kstep, voffA); PG8_STAGE(PG8_SB(1, 1), cB + hstepB + kstep, voffB);
    PG8_WAIT_V(6); PG8_BAR;
    for (;;) {
        E.prefetch(cur, ui);
        const bool has_next = S.next(ui + 1, nxt);
        const char* nA = has_next ? (const char*)g.A + (size_t)nxt.pm * tstepA : cA; const char* nB = has_next ? (const char*)g.Bt + (size_t)nxt.pn * tstepB : cB;
        for (int t = 0; t < nt; t += 2) {
            const bool last = (t == nt - 2);
            const char* a1 = cA + (size_t)(t + 1) * kstep;
            const char* a2 = last ? nA : cA + (size_t)(t + 2) * kstep; const char* b2 = last ? nB : cB + (size_t)(t + 2) * kstep;
            const char* a3 = a2 + kstep; const char* b3 = b2 + kstep;
            if (last && has_next) S.a_ready(nxt);
            PG8_LDB(B0, 0, 0); PG8_SCHED; PG8_LDA(At, 0, 0); PG8_STAGE(PG8_SA(1, 1), a1 + hstepA, voffA);
            PG8_WAIT_L(8); PG8_BAR; PG8_WAIT_L(0); PG8_MMA(0, 0, At, B0); PG8_BAR; PG8_SCHED;
            PG8_LDB(B1, 0, 1); PG8_STAGE(PG8_SB(0, 0), b2, voffB);
            PG8_BAR; PG8_WAIT_L(0); PG8_MMA(0, 1, At, B1); PG8_BAR;
            PG8_LDA(At, 0, 1); PG8_STAGE(PG8_SA(0, 0), a2, voffA);
            PG8_BAR; PG8_WAIT_L(0); PG8_MMA(1, 0, At, B0); PG8_BAR; PG8_SCHED;
            PG8_STAGE(PG8_SB(0, 1), b2 + hstepB, voffB);
            PG8_WAIT_V(6); PG8_BAR; PG8_MMA(1, 1, At, B1); PG8_BAR;
            PG8_LDB(B0, 1, 0); PG8_SCHED; PG8_LDA(At, 1, 0); PG8_STAGE(PG8_SA(0, 1), a2 + hstepA, voffA);
            PG8_WAIT_L(8); PG8_BAR; PG8_WAIT_L(0); PG8_MMA(0, 0, At, B0); PG8_BAR; PG8_SCHED;
            PG8_LDB(B1, 1, 1); PG8_STAGE(PG8_SB(1, 0), b3, voffB);
            PG8_BAR; PG8_WAIT_L(0); PG8_MMA(0, 1, At, B1); PG8_BAR;
            PG8_LDA(At, 1, 1); PG8_STAGE(PG8_SA(1, 0), a3, voffA);
            PG8_BAR; PG8_WAIT_L(0); PG8_MMA(1, 0, At, B0); PG8_BAR; PG8_SCHED;
            PG8_STAGE(PG8_SB(1, 1), b3 + hstepB, voffB);
            PG8_WAIT_V(6); PG8_BAR; PG8_MMA(1, 1, At, B1); PG8_BAR;
        }
        E(acc, cur, wr, wc, ui, fq);
        S.done(cur);
        if (!has_next) break;
#pragma unroll
        for (int a = 0; a < 2; ++a)
#pragma unroll
            for (int b = 0; b < 2; ++b)
#pragma unroll
                for (int m = 0; m < 4; ++m)
#pragma unroll
                    for (int n = 0; n < 2; ++n) acc[a][b][m][n] = (f32x4){0.f, 0.f, 0.f, 0.f};
        cur = nxt; cA = nA; cB = nB; ++ui;
    }
    PG8_WAIT_V(0);
    if (wr == 0) PG8_BAR;
    PG8_BAR;
#undef PG8_SA
#undef PG8_SB
#undef PG8_STAGE
#undef PG8_LDA
#undef PG8_LDB
#undef PG8_MMA
#undef PG8_WAIT_V
#undef PG8_WAIT_L
#undef PG8_BAR
#undef PG8_SCHED
}
}
struct Frame {
    LAS unsigned char* lds; int G, bid;
    const float* const* in; float* out; unsigned char* ws; unsigned* ctl;
};
#define TID (opaque_tid())
#define LANE (opaque_tid() & 63)
#define WAVE (__builtin_amdgcn_readfirstlane(opaque_tid() >> 6))
enum { I_X = 0, I_RELB, I_NMIX, I_NFFN, I_NFIN, I_EV_WIN, I_EV_BF, I_EV_SINK, I_EV_WOUT, I_OD_WIN, I_OD_CPOS, I_OD_CW1, I_OD_CW2, I_OD_CONVW, I_OD_ALOG, I_OD_DTB,
       I_OD_GNORM, I_OD_WOUT, I_F_WUP, I_F_CONVW, I_F_CONVB, I_F_WDN };

template <int MAP>
__device__ __forceinline__ int cvt_map(int n, int srcN) {
    if (MAP == 0) return (n < srcN) ? n : -1;
    if (MAP == 1) return ev_src(n);
    if (MAP == 2) return od_src(n);
    return ((n & 255) < 128) ? (n >> 8) * 128 + (n & 127) : FF + (n >> 8) * 128 + (n & 127);
}
template <int MAP>
__device__ __forceinline__ void cvt_load(f32x4 (&v)[8], const float* __restrict__ src, int srcN, const float* __restrict__ gain, int k0, int n0, int tid) {
    const int n4 = (tid & 31) * 4, s = cvt_map<MAP>(n0 + n4, srcN);
    const int sc = s >= 0 ? s : 0;
    const float keep = (MAP == 3) ? ((((n0 + n4) & 255) < 128) ? -0.6931471805599453f : 1.f) : (s >= 0 ? 1.f : 0.f);
    float gv[8];
#pragma unroll
    for (int e = 0; e < 8; ++e) { const int kk = e * 16 + (tid >> 5);
        v[e] = *(const f32x4*)(src + (size_t)(k0 + kk) * srcN + sc);
        gv[e] = gain ? gain[k0 + kk] : 1.f; }
#pragma unroll
    for (int e = 0; e < 8; ++e) v[e] *= gv[e] * keep;
}
template <int MAP>
__device__ __forceinline__ void cvt_transpose(const Frame& F, const float* __restrict__ src, int srcN, int K, int Npad, const float* __restrict__ gain, bf16_t* __restrict__ dst) {
    LAS float* tile = (LAS float*)F.lds;
    const int tid = TID, tk = K / 128, tn = Npad / 128, ntile = tk * tn;
    int t = F.bid;
    f32x4 v[8];
    if (t < ntile) cvt_load<MAP>(v, src, srcN, gain, (t % tk) * 128, (t / tk) * 128, tid);
    for (; t < ntile; t += F.G) {
        const int k0 = (t % tk) * 128, n0 = (t / tk) * 128;
        __syncthreads();
#pragma unroll
        for (int e = 0; e < 8; ++e) *(LAS f32x4*)(tile + (e * 16 + (tid >> 5)) * 132 + (tid & 31) * 4) = v[e];
        __syncthreads();
        const int tnx = t + F.G;
        if (tnx < ntile) cvt_load<MAP>(v, src, srcN, gain, (tnx % tk) * 128, (tnx / tk) * 128, tid);
        { const int nn = tid & 127, kq = (tid >> 7) * 32;
          bf16_t* d = dst + (size_t)(n0 + nn) * K + k0 + kq;
#pragma unroll
          for (int q = 0; q < 4; ++q) { float x[8];
#pragma unroll
              for (int i = 0; i < 8; ++i) x[i] = tile[(kq + q * 8 + i) * 132 + nn];
              u32x4 w; w.x = cvt_pk_bf16(x[0], x[1]); w.y = cvt_pk_bf16(x[2], x[3]); w.z = cvt_pk_bf16(x[4], x[5]); w.w = cvt_pk_bf16(x[6], x[7]);
              *(u32x4*)(d + q * 8) = w; } }
    }
    __syncthreads();
}

__device__ __forceinline__ void rownorm_phase(const Frame& F, const float* __restrict__ src, bf16_t* __restrict__ cpy, float* __restrict__ rstd_out) {
    for (int row = F.bid * NWAVE + WAVE; row < M; row += F.G * NWAVE) {
        const float* p = src + (size_t)row * D + LANE * 4;
        f32x4 v[8]; float ss = 0.f;
        u32x2 c[8];
#pragma unroll
        for (int i = 0; i < 8; ++i) { v[i] = *(const f32x4*)(p + i * 256); c[i].x = cvt_pk_bf16(v[i][0], v[i][1]); c[i].y = cvt_pk_bf16(v[i][2], v[i][3]);
            ss += bflo(c[i].x) * bflo(c[i].x) + bfhi(c[i].x) * bfhi(c[i].x) + bflo(c[i].y) * bflo(c[i].y) + bfhi(c[i].y) * bfhi(c[i].y); }
        ss = wave_sum(ss);
        if (LANE == 0) rstd_out[row] = rsqrtf(ss * (1.f / D) + EPS);
#pragma unroll
        for (int i = 0; i < 8; ++i) *(u32x2*)(cpy + (size_t)row * D + LANE * 4 + i * 256) = c[i];
    }
}
__device__ __forceinline__ void rowstat_phase(const Frame& F, const bf16_t* __restrict__ res, float* __restrict__ rstd_out) {
    for (int row0 = (F.bid * NWAVE + WAVE) * 4; row0 < M; row0 += F.G * NWAVE * 4) {
        u32x4 v[4][4];
#pragma unroll
        for (int r = 0; r < 4; ++r)
#pragma unroll
            for (int i = 0; i < 4; ++i) v[r][i] = *(const u32x4*)(res + (size_t)(row0 + r) * D + LANE * 8 + i * 512);
        float ss[4];
#pragma unroll
        for (int r = 0; r < 4; ++r) { ss[r] = 0.f;
#pragma unroll
            for (int i = 0; i < 4; ++i) { const u32x4 x = v[r][i];
                ss[r] += bflo(x.x) * bflo(x.x) + bfhi(x.x) * bfhi(x.x) + bflo(x.y) * bflo(x.y) + bfhi(x.y) * bfhi(x.y) + bflo(x.z) * bflo(x.z) + bfhi(x.z) * bfhi(x.z) + bflo(x.w) * bflo(x.w) + bfhi(x.w) * bfhi(x.w); }
            ss[r] = wave_sum(ss[r]); }
        if (LANE < 4) rstd_out[row0 + LANE] = rsqrtf((LANE == 0 ? ss[0] : LANE == 1 ? ss[1] : LANE == 2 ? ss[2] : ss[3]) * (1.f / D) + EPS);
    }
}
__device__ __forceinline__ void rowstat_f_phase(const Frame& F, const bf16_t* __restrict__ res, float* __restrict__ rstd_out, const bf16_t* __restrict__ wf  , bf16_t* __restrict__ proj) {
    LAS unsigned char* lds = F.lds;
    __syncthreads();
    for (int i = TID; i < 8 * D / 8; i += NTHR) *(LAS u32x4*)(lds + i * 16) = *(const u32x4*)(wf + (size_t)i * 8);
    __syncthreads();
    const int l = LANE, r = l & 15, kq = l >> 4;
    for (int blk = F.bid * NWAVE + WAVE; blk < M / 16; blk += F.G * NWAVE) {
        const bf16_t* rowp = res + (size_t)(blk * 16 + r) * D + kq * 8;
        f32x4 acc = {0.f, 0.f, 0.f, 0.f}; float ss = 0.f;
#pragma unroll 1
        for (int s0 = 0; s0 < 64; s0 += 32) {
            u32x4 a[32];
#pragma unroll
            for (int s = 0; s < 32; ++s) a[s] = *(const u32x4*)(rowp + (s0 + s) * 32);
#pragma unroll
            for (int s = 0; s < 32; ++s) { const u32x4 x = a[s];
                ss += bflo(x.x) * bflo(x.x) + bfhi(x.x) * bfhi(x.x) + bflo(x.y) * bflo(x.y) + bfhi(x.y) * bfhi(x.y) + bflo(x.z) * bflo(x.z) + bfhi(x.z) * bfhi(x.z) + bflo(x.w) * bflo(x.w) + bfhi(x.w) * bfhi(x.w);
                u32x4 b = *(const LAS u32x4*)(lds + (r & 7) * 4096 + ((s0 + s) * 32 + kq * 8) * 2);
                if (r >= 8) b = (u32x4){0u, 0u, 0u, 0u};
                u32x4 xa = x;
                acc = __builtin_amdgcn_mfma_f32_16x16x32_bf16(*reinterpret_cast<bf16x8*>(&xa), *reinterpret_cast<bf16x8*>(&b), acc, 0, 0, 0); }
        }
        ss += shx(ss, 16); ss += shx(ss, 32);
        const float rstd = rsqrtf(ss * (1.f / D) + EPS);
        if (kq == 0) rstd_out[blk * 16 + r] = rstd;
#pragma unroll
        for (int reg = 0; reg < 4; ++reg) { const float rr = __builtin_bit_cast(float, __builtin_amdgcn_ds_bpermute((4 * kq + reg) << 2, __builtin_bit_cast(int, rstd)));
            if (r < 8) proj[(size_t)(blk * 16 + 4 * kq + reg) * EV_NP + EC_F + r] = f2bf(acc[reg] * rr); }
    }
    __syncthreads();
}
__device__ __forceinline__ void final_norm_phase(const Frame& F, const bf16_t* __restrict__ res, float* __restrict__ out, const float* __restrict__ g) {
    for (int row0 = (F.bid * NWAVE + WAVE) * 2; row0 < M; row0 += F.G * NWAVE * 2) {
        u32x4 v[2][4];
#pragma unroll
        for (int r = 0; r < 2; ++r)
#pragma unroll
            for (int i = 0; i < 4; ++i) v[r][i] = *(const u32x4*)(res + (size_t)(row0 + r) * D + LANE * 8 + i * 512);
#pragma unroll
        for (int r = 0; r < 2; ++r) {
            float ss = 0.f;
#pragma unroll
            for (int i = 0; i < 4; ++i) { const u32x4 x = v[r][i];
                ss += bflo(x.x) * bflo(x.x) + bfhi(x.x) * bfhi(x.x) + bflo(x.y) * bflo(x.y) + bfhi(x.y) * bfhi(x.y) + bflo(x.z) * bflo(x.z) + bfhi(x.z) * bfhi(x.z) + bflo(x.w) * bflo(x.w) + bfhi(x.w) * bfhi(x.w); }
            ss = wave_sum(ss);
            const float rstd = rsqrtf(ss * (1.f / D) + EPS);
#pragma unroll
            for (int i = 0; i < 4; ++i) { const u32x4 x = v[r][i];
                const f32x4 g0 = *(const f32x4*)(g + LANE * 8 + i * 512), g1 = *(const f32x4*)(g + LANE * 8 + i * 512 + 4);
                float* o = out + (size_t)(row0 + r) * D + LANE * 8 + i * 512;
                *(f32x4*)o = (f32x4){bflo(x.x), bfhi(x.x), bflo(x.y), bfhi(x.y)} * rstd * g0;
                *(f32x4*)(o + 4) = (f32x4){bflo(x.z), bfhi(x.z), bflo(x.w), bfhi(x.w)} * rstd * g1; }
        }
    }
}

__device__ __forceinline__ void ffn_fixup_phase(const Frame& F, bf16_t* __restrict__ act, const float* __restrict__ tail, const float* __restrict__ headg, const float* __restrict__ headu,
                                                const float* __restrict__ cw, const float* __restrict__ cb) {
    constexpr int C4 = FF / 4, NPM = M / 256;
    for (int idx = F.bid * NTHR + TID; idx < NPM * 2 * C4; idx += F.G * NTHR) {
        const int c = (idx % C4) * 4, r = (idx / C4) & 1, pm = idx / (2 * C4);
        if ((pm & 15) == 0) continue;
        const f32x4 t0 = *(const f32x4*)(tail + ((size_t)(pm - 1) * 2 + 0) * FF + c), t1 = *(const f32x4*)(tail + ((size_t)(pm - 1) * 2 + 1) * FF + c);
        const f32x4 h0 = *(const f32x4*)(headg + ((size_t)pm * 2 + 0) * FF + c), h1 = *(const f32x4*)(headg + ((size_t)pm * 2 + 1) * FF + c);
        const f32x4 uu = *(const f32x4*)(headu + ((size_t)pm * 2 + r) * FF + c);
        const f32x4 gm2 = r == 0 ? t0 : t1, gm1 = r == 0 ? t1 : h0, g0 = r == 0 ? h0 : h1;
        const f32x4 w0 = *(const f32x4*)(cw + c), w1 = *(const f32x4*)(cw + FF + c), w2 = *(const f32x4*)(cw + 2 * FF + c), bb = *(const f32x4*)(cb + c);
        float o[4];
#pragma unroll
        for (int e = 0; e < 4; ++e) { const float z = w0[e] * gm2[e] + w1[e] * gm1[e] + w2[e] * g0[e] + bb[e]; o[e] = siluf_(z) * (uu[e] * -LOG2E); }
        u32x2 w; w.x = cvt_pk_bf16(o[0], o[1]); w.y = cvt_pk_bf16(o[2], o[3]);
        *(u32x2*)(act + (size_t)(pm * 256 + r) * FF + c) = w;
    }
}

__device__ __forceinline__ void p0_prologue(const Frame& F) {
    unsigned char* ws = F.ws;
    for (int j = 0; j < 2; ++j) {
        cvt_transpose<1>(F, F.in[I_EV_WIN] + (size_t)j * D * EV_N, EV_N, D, EV_NP, F.in[I_NMIX] + (size_t)(2 * j) * D, (bf16_t*)(ws + WS_W_EV_IN + j * SZ_W_EV_IN));
        cvt_transpose<0>(F, F.in[I_EV_WOUT] + (size_t)j * D * D, D, D, D, nullptr, (bf16_t*)(ws + WS_W_EV_OUT + j * SZ_W_OUT));
        cvt_transpose<2>(F, F.in[I_OD_WIN] + (size_t)j * D * OD_N, OD_N, D, OD_NP, F.in[I_NMIX] + (size_t)(2 * j + 1) * D, (bf16_t*)(ws + WS_W_OD_IN + j * SZ_W_OD_IN));
        cvt_transpose<0>(F, F.in[I_OD_WOUT] + (size_t)j * D * D, D, D, D, nullptr, (bf16_t*)(ws + WS_W_OD_OUT + j * SZ_W_OUT));
        for (int kv = 0; kv < 2; ++kv) {
            cvt_transpose<0>(F, F.in[I_OD_CW1] + (size_t)(j * 2 + kv) * 4096 * 256, 256, 4096, 256, nullptr, (bf16_t*)(ws + WS_W_C1 + (j * 2 + kv) * SZ_W_C1));
            cvt_transpose<0>(F, F.in[I_OD_CW2] + (size_t)(j * 2 + kv) * 256 * 128, 128, 256, 256, nullptr, (bf16_t*)(ws + WS_W_C2 + (j * 2 + kv) * SZ_W_C2));
        }
    }
    for (int l = 0; l < 4; ++l) {
        cvt_transpose<3>(F, F.in[I_F_WUP] + (size_t)l * D * FF2, FF2, D, FF2, F.in[I_NFFN] + (size_t)l * D, (bf16_t*)(ws + WS_W_UP + l * SZ_W_UP));
        cvt_transpose<0>(F, F.in[I_F_WDN] + (size_t)l * FF * D, D, FF, D, nullptr, (bf16_t*)(ws + WS_W_DN + l * SZ_W_DN));
    }
    if (F.bid < 64) {
        const int tid = TID, jk = F.bid >> 4, part = (F.bid & 15) * 2 + (tid >> 8), n = tid & 255;
        const float* pe = F.in[I_OD_CPOS] + (size_t)jk * 4096 + part * 128; const float* w1 = F.in[I_OD_CW1] + ((size_t)jk * 4096 + part * 128) * 256 + n;
        float s = 0.f;
        for (int i0 = 0; i0 < 128; i0 += 16) {
            float a[16], b[16];
#pragma unroll
            for (int u = 0; u < 16; ++u) { a[u] = pe[i0 + u]; b[u] = w1[(size_t)(i0 + u) * 256]; }
#pragma unroll
            for (int u = 0; u < 16; ++u) s += a[u] * b[u];
        }
        ((float*)(ws + WS_C1B))[(jk * 32 + part) * 256 + n] = s;
    }
    rownorm_phase(F, F.in[I_X], (bf16_t*)(ws + WS_RES), F.out + (size_t)M * D / 2);
}
namespace att {
constexpr int KVBLK = 64, SHM_K = KVBLK * 128 * 2, SHM_V = KVBLK * 128 * 2;
constexpr int KVBUF = SHM_V + SHM_K;
constexpr int L_V = 0, L_K = SHM_V;
constexpr int EL_WS = 4 * KVBUF, EL_CFR = EL_WS + 2048, EL_TAB = EL_CFR + 8192  , EL_MISC = EL_TAB + 4096, EL_END = EL_MISC + 256;
static_assert(EL_END <= LDS_BARW, "even attention lds");
#define KSWZ_F(row) (((row) & 7) | ((((row) >> 4) & 1) << 3))
#define KSWZ(row, colB) ((row) * 256 + ((colB) ^ (KSWZ_F(row) << 4)))
#define SBAR() __builtin_amdgcn_sched_barrier(0)
__device__ __forceinline__ int v_st(int k, int c) { const int kk = (k & ~0xC) | ((k & 4) << 1) | ((k & 8) >> 1); return ((kk >> 3) * 4 + (c >> 5)) * 512 + ((kk & 7) * 32 + (c & 31)) * 2; }
__device__ __forceinline__ int v_rd_base(int lane) { return ((lane & 3) << 3) | (((lane >> 2) & 3) << 6) | (((lane >> 4) & 1) << 5) | (((lane >> 5) & 1) << 8); }
constexpr int v_rd_off(int d0, int ks, int half) { return d0 * 512 + ks * 4096 + half * 2048; }
__device__ __forceinline__ int crow(int r, int hi) { return (r & 3) + 8 * (r >> 2) + 4 * hi; }
constexpr float C2 = LOG2E * SCALE;

struct KvOff { unsigned k, v; };
__device__ __forceinline__ KvOff kv_dma_off(int tid, int ld) {
    const int row = tid >> 4, cch = (tid & 15) ^ KSWZ_F(row);
    const int kk = ((tid >> 7) << 3) | ((tid >> 2) & 7), key = (kk & ~0xC) | ((kk & 4) << 1) | ((kk & 8) >> 1), col = ((tid >> 5) & 3) * 32 + (tid & 3) * 8;
    KvOff o; o.k = (unsigned)(row * ld + cch * 8) * 2u; o.v = (unsigned)(key * ld + col) * 2u; return o;
}
__device__ __forceinline__ void kv_dma(LAS unsigned char* buf, const bf16_t* __restrict__ Kg, const bf16_t* __restrict__ Vg, int ld, KvOff o, int wid) {
    const char* k0 = (const char*)Kg; const char* k1 = (const char*)(Kg + (size_t)32 * ld);
    const char* v0 = (const char*)Vg; const char* v1 = (const char*)(Vg + (size_t)32 * ld);
    LAS unsigned char* l = buf + wid * 1024;
    __builtin_amdgcn_global_load_lds((const unsigned*)(k0 + o.k), (LAS unsigned*)(l + L_K), 16, 0, 0);
    __builtin_amdgcn_global_load_lds((const unsigned*)(k1 + o.k), (LAS unsigned*)(l + L_K + 8192), 16, 0, 0);
    __builtin_amdgcn_global_load_lds((const unsigned*)(v0 + o.v), (LAS unsigned*)(l + L_V), 16, 0, 0);
    __builtin_amdgcn_global_load_lds((const unsigned*)(v1 + o.v), (LAS unsigned*)(l + L_V + 8192), 16, 0, 0);
}
template <int NI> __device__ __forceinline__ void dma_wait(int ahead) {
    if (ahead >= 2) { if (NI == 4) asm volatile("s_waitcnt vmcnt(8)" ::: "memory"); else asm volatile("s_waitcnt vmcnt(10)" ::: "memory"); }
    else if (ahead == 1) { if (NI == 4) asm volatile("s_waitcnt vmcnt(4)" ::: "memory"); else asm volatile("s_waitcnt vmcnt(5)" ::: "memory"); }
    else asm volatile("s_waitcnt vmcnt(0)" ::: "memory");
}
#define RING_BAR() do { asm volatile("s_waitcnt lgkmcnt(0)" ::: "memory"); __builtin_amdgcn_s_barrier(); asm volatile("" ::: "memory"); } while (0)
template <int NSET = 4>
__device__ __forceinline__ void qkt(f32x16& p0, f32x16& p1, LAS unsigned char* lds, int r32, int hi, const bf16x8* qr) {
    p0 = f32x16{}; p1 = f32x16{};
    int ad[4];
#pragma unroll
    for (int dd = 0; dd < 4; ++dd) ad[dd] = (int)(uintptr_t)(lds + L_K + KSWZ(r32, (dd * 16 + hi * 8) * 2));
    bf16x8 k0[NSET], k1[NSET];
#define KRD(dst, a_, off_) asm volatile("ds_read_b128 %0, %1 offset:%2" : "=&v"(dst) : "v"(a_), "i"(off_) : "memory")
#define KWAIT(n_, x_, y_) asm volatile("s_waitcnt lgkmcnt(" #n_ ")" : "+v"(x_), "+v"(y_) :: "memory")
#define KISSUE(d_) do { if ((d_) < 4) { KRD(k0[(d_) % NSET], ad[(d_) & 3], 0); KRD(k1[(d_) % NSET], ad[(d_) & 3], 32 * 256); } \
                        else { const int a2_ = ad[(d_) & 3] ^ 128;         \
                               KRD(k0[(d_) % NSET], a2_, 0); KRD(k1[(d_) % NSET], a2_, 32 * 256); } } while (0)
#pragma unroll
    for (int d0 = 0; d0 < NSET; ++d0) KISSUE(d0);
#define KWAITN(n_, x_, y_) do { if ((n_) == 6) KWAIT(6, x_, y_); else if ((n_) == 4) KWAIT(4, x_, y_); else if ((n_) == 2) KWAIT(2, x_, y_); else KWAIT(0, x_, y_); } while (0)
#define QK_STEP(d0_) do { constexpr int inflight_ = ((8 - (d0_)) < NSET ? (8 - (d0_)) : NSET) - 1; KWAITN(2 * inflight_, k0[(d0_) % NSET], k1[(d0_) % NSET]); \
        p0 = __builtin_amdgcn_mfma_f32_32x32x16_bf16(k0[(d0_) % NSET], qr[d0_], p0, 0, 0, 0); p1 = __builtin_amdgcn_mfma_f32_32x32x16_bf16(k1[(d0_) % NSET], qr[d0_], p1, 0, 0, 0); \
        if ((d0_) + NSET < 8) KISSUE((d0_) + NSET); } while (0)
    QK_STEP(0); QK_STEP(1); QK_STEP(2); QK_STEP(3); QK_STEP(4); QK_STEP(5); QK_STEP(6); QK_STEP(7);
#undef KWAITN
#undef QK_STEP
#undef KISSUE
#undef KWAIT
#undef KRD
}
__device__ __forceinline__ void partialSM(f32x16& p0, f32x16& p1, float& m_reg, float& mn, float& alpha) {
    float mx[4] = {p0[0], p0[1], p0[2], p0[3]};
#pragma unroll
    for (int r = 4; r < 16; ++r) mx[r & 3] = fmaxf(mx[r & 3], p0[r]);
#pragma unroll
    for (int r = 0; r < 16; ++r) mx[r & 3] = fmaxf(mx[r & 3], p1[r]);
    float pmax = fmaxf(fmaxf(mx[0], mx[1]), fmaxf(mx[2], mx[3]));
    { auto rr = __builtin_amdgcn_permlane32_swap(__float_as_uint(pmax), __float_as_uint(pmax), false, false);
      pmax = fmaxf(__uint_as_float(rr[0]), __uint_as_float(rr[1])); }
    if (__any((pmax - m_reg) * C2 > 8.f)) { mn = fmaxf(m_reg, pmax); alpha = __builtin_amdgcn_exp2f((m_reg - mn) * C2); m_reg = mn; }
    else { mn = m_reg; alpha = 1.f; }
    const float mnL = -mn * C2;
#pragma unroll
    for (int r = 0; r < 16; ++r) p0[r] = __builtin_amdgcn_exp2f(fmaf(p0[r], C2, mnL));
#pragma unroll
    for (int r = 0; r < 16; ++r) p1[r] = __builtin_amdgcn_exp2f(fmaf(p1[r], C2, mnL));
}
__device__ __forceinline__ void pack_p(const f32x16& p0, const f32x16& p1, bf16x8& pa0, bf16x8& pa1, bf16x8& pa2, bf16x8& pa3) {
#define PK4(P, B_, OUT) do { unsigned a0 = cvt_pk_bf16(P[B_+0], P[B_+1]), a1 = cvt_pk_bf16(P[B_+2], P[B_+3]);                          \
        unsigned b0 = cvt_pk_bf16(P[B_+4], P[B_+5]), b1 = cvt_pk_bf16(P[B_+6], P[B_+7]);                                             \
        auto r0 = __builtin_amdgcn_permlane32_swap(a0, b0, false, false); auto r1 = __builtin_amdgcn_permlane32_swap(a1, b1, false, false); \
        u32x4 w = {r0[0], r1[0], r0[1], r1[1]}; OUT = *reinterpret_cast<bf16x8*>(&w); } while (0)
    PK4(p0, 0, pa0); PK4(p0, 8, pa1); PK4(p1, 0, pa2); PK4(p1, 8, pa3);
#undef PK4
}
__device__ __forceinline__ float row_sum(const f32x16& p0, const f32x16& p1) {
    float sm[4] = {0.f, 0.f, 0.f, 0.f};
#pragma unroll
    for (int r = 0; r < 16; ++r) sm[r & 3] += p0[r] + p1[r];
    const float ps = (sm[0] + sm[1]) + (sm[2] + sm[3]);
    auto rr = __builtin_amdgcn_permlane32_swap(__float_as_uint(ps), __float_as_uint(ps), false, false);
    return __uint_as_float(rr[0]) + __uint_as_float(rr[1]);
}
__device__ __forceinline__ void pv_tile(f32x16* o, int vb0, bf16x8 pa0, bf16x8 pa1, bf16x8 pa2, bf16x8 pa3) {
#define TRRD(dst, off) asm volatile("ds_read_b64_tr_b16 %0, %1 offset:%2" : "=&v"(dst) : "v"(vb0), "i"(off) : "memory")
    s16x4 l[2][4], h[2][4];
#define PV_RD(d0, st) do { constexpr int b_ = L_V + v_rd_off(d0, 0, 0); \
        TRRD(l[st][0], b_); TRRD(h[st][0], b_ + 2048); TRRD(l[st][1], b_ + 4096); TRRD(h[st][1], b_ + 6144); TRRD(l[st][2], b_ + 8192); TRRD(h[st][2], b_ + 10240); TRRD(l[st][3], b_ + 12288); TRRD(h[st][3], b_ + 14336); } while (0)
#define PV_WAIT(n_, st) asm volatile("s_waitcnt lgkmcnt(" #n_ ")" : "+v"(l[st][0]), "+v"(h[st][0]), "+v"(l[st][1]), "+v"(h[st][1]), "+v"(l[st][2]), "+v"(h[st][2]), "+v"(l[st][3]), "+v"(h[st][3]) :: "memory")
#define PV_MM(d0, st) do { \
        o[d0] = __builtin_amdgcn_mfma_f32_32x32x16_bf16(pa0, (bf16x8){l[st][0][0], l[st][0][1], l[st][0][2], l[st][0][3], h[st][0][0], h[st][0][1], h[st][0][2], h[st][0][3]}, o[d0], 0, 0, 0);   \
        o[d0] = __builtin_amdgcn_mfma_f32_32x32x16_bf16(pa1, (bf16x8){l[st][1][0], l[st][1][1], l[st][1][2], l[st][1][3], h[st][1][0], h[st][1][1], h[st][1][2], h[st][1][3]}, o[d0], 0, 0, 0);   \
        o[d0] = __builtin_amdgcn_mfma_f32_32x32x16_bf16(pa2, (bf16x8){l[st][2][0], l[st][2][1], l[st][2][2], l[st][2][3], h[st][2][0], h[st][2][1], h[st][2][2], h[st][2][3]}, o[d0], 0, 0, 0);   \
        o[d0] = __builtin_amdgcn_mfma_f32_32x32x16_bf16(pa3, (bf16x8){l[st][3][0], l[st][3][1], l[st][3][2], l[st][3][3], h[st][3][0], h[st][3][1], h[st][3][2], h[st][3][3]}, o[d0], 0, 0, 0); } while (0)
    PV_RD(0, 0); PV_RD(1, 1);
    PV_WAIT(8, 0); PV_MM(0, 0); PV_RD(2, 0);
    PV_WAIT(8, 1); PV_MM(1, 1); PV_RD(3, 1);
    PV_WAIT(8, 0); PV_MM(2, 0);
    PV_WAIT(0, 1); PV_MM(3, 1);
#undef PV_MM
#undef PV_WAIT
#undef PV_RD
#undef TRRD
}
__device__ __forceinline__ void rescale_o(f32x16* o, float alpha, LAS float* al_l, int r32, int hi) {
    if (__any(alpha < 1.f)) {
        if (hi == 0) al_l[r32] = alpha;
        asm volatile("s_waitcnt lgkmcnt(0)" ::: "memory");
#pragma unroll
        for (int r = 0; r < 16; ++r) { const float a = al_l[crow(r, hi)];
#pragma unroll
            for (int d = 0; d < 4; ++d) o[d][r] *= a; }
        asm volatile("s_waitcnt lgkmcnt(0)" ::: "memory");
    }
}
__device__ __forceinline__ void sm_pv_step(f32x16& p0, f32x16& p1, f32x16* o, float& m_reg, float& l_reg, LAS float* al_l, int vb0, int r32, int hi) {
    float mn, alpha;
    partialSM(p0, p1, m_reg, mn, alpha);
    rescale_o(o, alpha, al_l, r32, hi);
    l_reg = l_reg * alpha + row_sum(p0, p1);
    bf16x8 pa0, pa1, pa2, pa3; pack_p(p0, p1, pa0, pa1, pa2, pa3);
    pv_tile(o, vb0, pa0, pa1, pa2, pa3);
}
__device__ __forceinline__ void lanes_to_rows(float x, float* vals, LAS float* xl, int r32, int hi) {
    if (hi == 0) xl[r32] = x;
    asm volatile("s_waitcnt lgkmcnt(0)" ::: "memory");
#pragma unroll
    for (int r = 0; r < 16; ++r) vals[r] = xl[crow(r, hi)];
    asm volatile("s_waitcnt lgkmcnt(0)" ::: "memory");
}
template <int NI, class Issue, class Active, class Fixup>
__device__ __forceinline__ void pingpong_attn(int nT, int wid, LAS unsigned char* lds, int vb0, const bf16x8* qr, f32x16* o, float& m_reg, float& l_reg, LAS float* al_l, int r32, int hi,
                                              Issue issue, Active active, Fixup fixup) {
    const bool grpB = wid >= 4;
    issue(0); if (nT > 1) issue(1);
    dma_wait<NI>(nT > 1 ? 1 : 0);
    RING_BAR();
    if (grpB) RING_BAR();
    bf16x8 pa0 = {}, pa1 = {}, pa2 = {}, pa3 = {}; bool act_prev = false;
    f32x16 p0 = {}, p1 = {};
    for (int s = 0; s <= nT; ++s) {
        if (s + 2 < nT) issue(s + 2);
        if (act_prev) pv_tile(o, vb0 + ((s - 1) & 3) * KVBUF, pa0, pa1, pa2, pa3);
        bool act = false;
        if (s < nT) { act = active(s); if (act) qkt(p0, p1, lds + (s & 3) * KVBUF, r32, hi, qr); }
        if (s + 1 < nT) dma_wait<NI>(s + 2 < nT ? 1 : 0);
        RING_BAR();
        if (s < nT) {
            if (act) { fixup(s, p0, p1); float mn, alpha; partialSM(p0, p1, m_reg, mn, alpha); rescale_o(o, alpha, al_l, r32, hi); l_reg = l_reg * alpha + row_sum(p0, p1);
                       pack_p(p0, p1, pa0, pa1, pa2, pa3); }
            act_prev = act;
            RING_BAR();
        }
    }
    if (!grpB) RING_BAR();
}
template <int NI, int NSET, class Issue, class Active, class Fixup>
__device__ __forceinline__ void dual_attn(int nT, int wid, LAS unsigned char* lds, int vb0, const bf16x8* qr, f32x16* o, float& m_reg, float& l_reg, LAS float* al_l, int r32, int hi,
                                          Issue issue, Active active, Fixup fixup) {
    const int nS = (nT + 1) >> 1;
    issue(0); if (nT > 1) issue(1);
    for (int s = 0; s < nS; ++s) {
        asm volatile("s_waitcnt vmcnt(0)" ::: "memory");
        RING_BAR();
        if (2 * s + 2 < nT) issue(2 * s + 2);
        if (2 * s + 3 < nT) issue(2 * s + 3);
        const int sa = (2 * s) & 3;
        const float NEGI = -__builtin_inff();
        f32x16 p0, p1, p2, p3;
        const bool acta = active(2 * s);
        if (acta) { qkt<NSET>(p0, p1, lds + sa * KVBUF, r32, hi, qr); fixup(2 * s, p0, p1); }
        else {
#pragma unroll
            for (int r = 0; r < 16; ++r) { p0[r] = NEGI; p1[r] = NEGI; } }
        if (NSET == 2) __builtin_amdgcn_sched_barrier(0);
        bool actb = false;
        if (2 * s + 1 < nT) actb = active(2 * s + 1);
        if (actb) { qkt<NSET>(p2, p3, lds + (sa + 1) * KVBUF, r32, hi, qr); fixup(2 * s + 1, p2, p3); }
        else {
#pragma unroll
            for (int r = 0; r < 16; ++r) { p2[r] = NEGI; p3[r] = NEGI; } }
        if (!acta && !actb) continue;
        float mx[4] = {p0[0], p0[1], p0[2], p0[3]};
#pragma unroll
        for (int r = 4; r < 16; ++r) mx[r & 3] = fmaxf(mx[r & 3], p0[r]);
#pragma unroll
        for (int r = 0; r < 16; ++r) mx[r & 3] = fmaxf(mx[r & 3], fmaxf(p1[r], fmaxf(p2[r], p3[r])));
        float pmax = fmaxf(fmaxf(mx[0], mx[1]), fmaxf(mx[2], mx[3]));
        { auto rr = __builtin_amdgcn_permlane32_swap(__float_as_uint(pmax), __float_as_uint(pmax), false, false);
          pmax = fmaxf(__uint_as_float(rr[0]), __uint_as_float(rr[1])); }
        float mn = m_reg, alpha = 1.f;
        if (__any((pmax - m_reg) * C2 > 8.f)) { mn = fmaxf(m_reg, pmax); alpha = __builtin_amdgcn_exp2f((m_reg - mn) * C2); m_reg = mn; }
        const float mnL = -mn * C2;
#pragma unroll
        for (int r = 0; r < 16; ++r) { p0[r] = __builtin_amdgcn_exp2f(fmaf(p0[r], C2, mnL)); p1[r] = __builtin_amdgcn_exp2f(fmaf(p1[r], C2, mnL));
                                       p2[r] = __builtin_amdgcn_exp2f(fmaf(p2[r], C2, mnL)); p3[r] = __builtin_amdgcn_exp2f(fmaf(p3[r], C2, mnL)); }
        rescale_o(o, alpha, al_l, r32, hi);
        { float sm[4] = {0.f, 0.f, 0.f, 0.f};
#pragma unroll
          for (int r = 0; r < 16; ++r) sm[r & 3] += (p0[r] + p1[r]) + (p2[r] + p3[r]);
          const float ps = (sm[0] + sm[1]) + (sm[2] + sm[3]);
          auto rr = __builtin_amdgcn_permlane32_swap(__float_as_uint(ps), __float_as_uint(ps), false, false);
          l_reg = l_reg * alpha + (__uint_as_float(rr[0]) + __uint_as_float(rr[1])); }
        if (acta) { bf16x8 a0, a1, a2, a3; pack_p(p0, p1, a0, a1, a2, a3); pv_tile(o, vb0 + sa * KVBUF, a0, a1, a2, a3); }
        if (actb) { bf16x8 b0, b1, b2, b3; pack_p(p2, p3, b0, b1, b2, b3); pv_tile(o, vb0 + (sa + 1) * KVBUF, b0, b1, b2, b3); }
    }
}
__device__ __forceinline__ void store_o_bf16(const f32x16* o, const float* rs, bf16_t* __restrict__ Ow, int ldo, int r32, int hi) {
    unsigned w[16][4];
#pragma unroll
    for (int r = 0; r < 16; ++r)
#pragma unroll
        for (int d0 = 0; d0 < 4; ++d0) { const float v = o[d0][r] * rs[r]; const float vn = DPPF(v, 0xB1); w[r][d0] = cvt_pk_bf16(v, vn); }
    if ((r32 & 1) == 0) {
#pragma unroll
        for (int r = 0; r < 16; ++r)
#pragma unroll
            for (int d0 = 0; d0 < 4; ++d0) *(unsigned*)(Ow + (size_t)crow(r, hi) * ldo + d0 * 32 + r32) = w[r][d0];
    }
}
__device__ __forceinline__ int t5_bucket(int n) {
    if (n < 16) return n;
    const float lr = logf((float)n / 16.f) / 2.0794415416798357f;
    const int v = 16 + (int)(lr * 16.f);
    return v < 31 ? v : 31;
}
}

__device__ __forceinline__ void fox_norm_phase(const Frame& F, const bf16_t* __restrict__ proj, unsigned* __restrict__ nrm) {
    const int tid = TID, sub = tid & 15, rl = tid >> 4;
    for (int it = F.bid; it < 256; it += F.G) {
        const int bh = it >> 2, qtr = it & 3, b = bh >> 3, h = bh & 7;
        float mq = 0.f, mk = 0.f;
        for (int r0 = 0; r0 < 1024; r0 += 256) {
            u32x4 qv[8], kv[8];
#pragma unroll
            for (int u = 0; u < 8; ++u) { const size_t row = (size_t)(b * T + qtr * 1024 + r0 + u * 32 + rl) * EV_NP;
                qv[u] = *(const u32x4*)(proj + row + EC_QB + h * 128 + sub * 8); kv[u] = *(const u32x4*)(proj + row + EC_KB + h * 128 + sub * 8); }
#pragma unroll
            for (int u = 0; u < 8; ++u) { const u32x4 q = qv[u], k = kv[u];
                float sq = bflo(q.x) * bflo(q.x) + bfhi(q.x) * bfhi(q.x) + bflo(q.y) * bflo(q.y) + bfhi(q.y) * bfhi(q.y) + bflo(q.z) * bflo(q.z) + bfhi(q.z) * bfhi(q.z) + bflo(q.w) * bflo(q.w) + bfhi(q.w) * bfhi(q.w);
                float sk = bflo(k.x) * bflo(k.x) + bfhi(k.x) * bfhi(k.x) + bflo(k.y) * bflo(k.y) + bfhi(k.y) * bfhi(k.y) + bflo(k.z) * bflo(k.z) + bfhi(k.z) * bfhi(k.z) + bflo(k.w) * bflo(k.w) + bfhi(k.w) * bfhi(k.w);
                sq = row16_sum(sq); sk = row16_sum(sk);
                mq = fmaxf(mq, sq); mk = fmaxf(mk, sk); }
        }
#pragma unroll
        for (int o = 16; o < 64; o <<= 1) { mq = fmaxf(mq, shx(mq, o)); mk = fmaxf(mk, shx(mk, o)); }
        if ((tid & 63) == 0) { atomicMax(nrm + bh * 2, __float_as_uint(mq)); atomicMax(nrm + bh * 2 + 1, __float_as_uint(mk)); }
    }
}
__device__ __forceinline__ void fscan_phase(const Frame& F, const bf16_t* __restrict__ proj, const float* __restrict__ bforget, float* __restrict__ cf) {
    LAS float* red = (LAS float*)F.lds;
    const int tid = TID;
    for (int it = F.bid; it < NB * 8; it += F.G) {
        const int b = it >> 3, h = it & 7; const float bf = bforget[h];
        float v[8]; float s = 0.f;
#pragma unroll
        for (int i = 0; i < 8; ++i) { const int t = tid * 8 + i; const float x = bf2f(proj[(size_t)(b * T + t) * EV_NP + EC_F + h]) + bf;
            const float ls = fminf(x, 0.f) - log1pf(__expf(-fabsf(x))); s += ls; v[i] = s; }
        __syncthreads();
        red[tid] = s;
        __syncthreads();
        if (tid < 64) { float a = 0.f;
            float loc[8];
#pragma unroll
            for (int i = 0; i < 8; ++i) { a += red[tid * 8 + i]; loc[i] = a; }
            float incl = a;
#pragma unroll
            for (int o = 1; o < 64; o <<= 1) { const float n = shu(incl, o); if (tid >= o) incl += n; }
            const float excl = incl - a;
#pragma unroll
            for (int i = 0; i < 8; ++i) red[tid * 8 + i] = excl + loc[i];
        }
        __syncthreads();
        const float base = tid > 0 ? red[tid - 1] : 0.f;
#pragma unroll
        for (int i = 0; i < 8; ++i) cf[(size_t)it * T + tid * 8 + i] = base + v[i];
    }
    __syncthreads();
}

__device__ __forceinline__ void even_attn_phase(const Frame& F, const bf16_t* __restrict__ proj, bf16_t* __restrict__ mix, const float* __restrict__ cf, const float* __restrict__ relb, const float* __restrict__ sinks, const unsigned* __restrict__ nrm, unsigned* __restrict__ qhead) {
    using namespace att;
    LAS unsigned char* lds = F.lds;
    const int tid = opaque_tid(), wid = __builtin_amdgcn_readfirstlane(tid >> 6), lane = tid & 63, r32 = lane & 31, hi = lane >> 5;
    LAS float* al_l = (LAS float*)(lds + EL_WS) + wid * 64;
    LAS float* cfr = (LAS float*)(lds + EL_CFR) + wid * 64;
    LAS float* tab = (LAS float*)(lds + EL_TAB);
    constexpr int LD = EV_NP;
    LAS int* qi = (LAS int*)(lds + EL_MISC);
    for (int i = tid; i < 1024; i += NTHR) tab[i] = relb[t5_bucket(i & 127) * 8 + (i >> 7)] * INV_SCALE;
    for (;;) {
        __syncthreads();
        if (threadIdx.x == 0) *qi = (int)__hip_atomic_fetch_add(qhead, 1u, __ATOMIC_RELAXED, __HIP_MEMORY_SCOPE_AGENT);
        __syncthreads();
        const int it = __builtin_amdgcn_readfirstlane(*qi);
        if (it >= 2048) break;
        const int tid = opaque_tid(), lane = tid & 63, r32 = lane & 31, hi = lane >> 5;
        const int vb0 = (int)(uintptr_t)(lds + L_V) + v_rd_base(lane);
        const KvOff ko = kv_dma_off(tid, LD);
        if (it < 1024) {
            const int qb = 15 - (it >> 6), bh = it & 63;
            const int b = bh >> 3, h = bh & 7, P0 = qb * 256, qpos0 = P0 + wid * 32;
            const bf16_t* Qg = proj + (size_t)(b * T + qpos0 + r32) * LD + EC_QB + h * 128;
            const bf16_t* Kg = proj + (size_t)(b * T) * LD + EC_KB + h * 128;
            const bf16_t* Vg = proj + (size_t)(b * T) * LD + EC_VB + h * 128;
            const float* cfh = cf + (size_t)(b * 8 + h) * T;
            bf16x8 qr[8];
#pragma unroll
            for (int d0 = 0; d0 < 8; ++d0) qr[d0] = *(const bf16x8*)(Qg + d0 * 16 + hi * 8);
            const float crefS = cfh[P0 + 255] * INV_SCALE;
            float m_reg = -1e30f, l_reg = 0.f; f32x16 o[4] = {};
            const int ntile = 4 * qb + 4;
            int jlo;
            { const float bnd = 2.f * sqrtf(__uint_as_float(nrm[(b * 8 + h) * 2]) * __uint_as_float(nrm[(b * 8 + h) * 2 + 1])) * SCALE * 1.02f + cfh[P0];
              const bool keep = (lane >= 4 * qb) || (bnd - cfh[lane * 64 + 63] >= -36.f);
              jlo = __builtin_amdgcn_readfirstlane(__builtin_ctzll(__ballot(keep))); }
            const int nT = ntile - jlo;
#define FOX_ISSUE(k_) do { const int t_ = jlo + (k_), s_ = (k_) & 3; kv_dma(lds + s_ * KVBUF, Kg + (size_t)(t_ * 64) * LD, Vg + (size_t)(t_ * 64) * LD, LD, ko, wid); \
                __builtin_amdgcn_global_load_lds((const unsigned*)(cfh + t_ * 64 + lane), (LAS unsigned*)(cfr + s_ * 512), 4, 0, 0); } while (0)
            __syncthreads();
            int kb = 0; const LAS float* kbb = cfr;
            pingpong_attn<5>(nT, wid, lds, vb0, qr, o, m_reg, l_reg, al_l, r32, hi,
                [&](int k) { FOX_ISSUE(k); },
                [&](int s) { kb = (jlo + s) * 64; kbb = cfr + (s & 3) * 512; return kb <= qpos0 + 31; },
                [&](int, f32x16& p0, f32x16& p1) {
#pragma unroll
                    for (int g4 = 0; g4 < 4; ++g4) { const f32x4 b0 = *(const LAS f32x4*)(kbb + 8 * g4 + 4 * hi), b1 = *(const LAS f32x4*)(kbb + 32 + 8 * g4 + 4 * hi);
#pragma unroll
                        for (int i = 0; i < 4; ++i) { p0[4 * g4 + i] += fmaf(b0[i], -INV_SCALE, crefS); p1[4 * g4 + i] += fmaf(b1[i], -INV_SCALE, crefS); } }
                    if (kb + 63 > qpos0) {
                        const int dq = qpos0 + r32 - kb - 4 * hi; const float NEG = -__builtin_inff();
#pragma unroll
                        for (int r = 0; r < 16; ++r) { const int c = (r & 3) + 8 * (r >> 2); if (dq - c < 0) p0[r] = NEG; if (dq - c - 32 < 0) p1[r] = NEG; }
                    }
                });
#undef FOX_ISSUE
            float rs[16]; lanes_to_rows(__builtin_amdgcn_rcpf(l_reg), rs, al_l, r32, hi);
            store_o_bf16(o, rs, mix + (size_t)(b * T + qpos0) * D + 1024 + h * 128, D, r32, hi);
        } else {
            const int i2 = it - 1024, qb = i2 & 63, bg = i2 >> 6, b = bg >> 1, g = bg & 1;
            const int hl = wid >> 1, head = g * 4 + hl, P0 = qb * 64, qpos0 = P0 + (wid & 1) * 32;
            const bf16_t* Qg = proj + (size_t)(b * T + qpos0 + r32) * LD + EC_QA + head * 128;
            const bf16_t* Kg = proj + (size_t)(b * T) * LD + EC_KA + g * 128;
            const bf16_t* Vg = proj + (size_t)(b * T) * LD + EC_VA + g * 128;
            bf16x8 qr[8];
#pragma unroll
            for (int d0 = 0; d0 < 8; ++d0) qr[d0] = *(const bf16x8*)(Qg + d0 * 16 + hi * 8);
            float m_reg = sinks[head] * INV_SCALE, l_reg = 1.f; f32x16 o[4] = {};
            const LAS float* tb = tab + head * 128;
            const int jt0 = (qb >= 2 ? qb - 2 : 0), nT = qb - jt0 + 1;
            __syncthreads();
            int kb = 0;
            pingpong_attn<4>(nT, wid, lds, vb0, qr, o, m_reg, l_reg, al_l, r32, hi,
                [&](int k) { kv_dma(lds + (k & 3) * KVBUF, Kg + (size_t)((jt0 + k) * 64) * LD, Vg + (size_t)((jt0 + k) * 64) * LD, LD, ko, wid); },
                [&](int s) { kb = (jt0 + s) * 64; return kb <= qpos0 + 31 && kb + 63 >= qpos0 - 127; },
                [&](int, f32x16& p0, f32x16& p1) {
                    const int dq = qpos0 + r32 - kb - 4 * hi; const float NEG = -__builtin_inff();
#pragma unroll
                    for (int r = 0; r < 16; ++r) { const int c = (r & 3) + 8 * (r >> 2); const int d0_ = dq - c, d1_ = dq - c - 32;
                        float t0 = tb[d0_ & 127], t1 = tb[d1_ & 127];
                        asm("" : "+v"(t0), "+v"(t1));
                        p0[r] = ((unsigned)d0_ < 128u) ? p0[r] + t0 : NEG; p1[r] = ((unsigned)d1_ < 128u) ? p1[r] + t1 : NEG; }
                });
            float rs[16]; lanes_to_rows(__builtin_amdgcn_rcpf(l_reg), rs, al_l, r32, hi);
            store_o_bf16(o, rs, mix + (size_t)(b * T + qpos0) * D + head * 128, D, r32, hi);
        }
    }
    __syncthreads();
}

#define N_EVEN_PHASES 5
#define even_mixer_phases \
    PH_BEGIN { pg8::Gemm g{RES, (const bf16_t*)(ws + WS_W_EV_IN + j * SZ_W_EV_IN), M, EC_F, D, D}; pg8::StaticOrder S; S.init(M, EC_F, F.G, F.bid);     \
               pg8::EpiStoreBf16 E{PROJ, EV_NP, RSTD}; pg8::gemm_phase(F.lds, g, S, E); } PH_END \
    PH_BEGIN fscan_phase(F, PROJ, F.in[I_EV_BF] + j * 8, (float*)(ws + WS_CF)); fox_norm_phase(F, PROJ, F.ctl + CW_NORM + j * 128); PH_END \
    PH_BEGIN even_attn_phase(F, PROJ, HB, (const float*)(ws + WS_CF), F.in[I_RELB], F.in[I_EV_SINK] + j * 8, F.ctl + CW_NORM + j * 128, F.ctl + CW_QUEUE + 64 * (4 + j)); PH_END \
    PH_BEGIN { pg8::Gemm g{HB, (const bf16_t*)(ws + WS_W_EV_OUT + j * SZ_W_OUT), M, D, D, D}; pg8::StaticOrder S; S.init(M, D, F.G, F.bid); \
               pg8::EpiAddRes E{RES, D}; pg8::gemm_phase(F.lds, g, S, E); } PH_END \
    PH_BEGIN rowstat_phase(F, RES, RSTD); PH_END
namespace gdn {
constexpr int RLD = 260, AMLD = 68;
constexpr int L_R = 0, L_KB16 = 64 * RLD * 4, L_QB16 = L_KB16 + 64 * 272, L_AM = L_QB16 + 64 * 272, L_GAM = L_AM + 64 * AMLD * 4, L_BETA = L_GAM + 256, L_BEG = L_BETA + 256, L_END = L_BEG + 256, L_WL = L_END + 16  , L_END2 = L_WL + 3 * 4 * 128 * 4;
static_assert(L_END2 <= LDS_BARW && (L_KB16 % 16) == 0 && (L_AM % 16) == 0 && (L_WL % 16) == 0, "gdn lds");
constexpr int RS16 = 272;

__device__ __forceinline__ void chunk_phase(const Frame& F, const bf16_t* __restrict__ proj, const float* __restrict__ convw, const float* __restrict__ alog, const float* __restrict__ dtb, unsigned* __restrict__ qhead) {
    LAS unsigned char* lds = F.lds;
    unsigned char* ws = F.ws;
    bf16_t* Ug = (bf16_t*)(ws + WS_G_U); bf16_t* Wg = (bf16_t*)(ws + WS_G_W); bf16_t* QGg = (bf16_t*)(ws + WS_G_QG); bf16_t* KTg = (bf16_t*)(ws + WS_G_KT);
    bf16_t* ATg = (bf16_t*)(ws + WS_G_ATT); float* GLg = (float*)(ws + WS_G_GL);
    LAS float* R = (LAS float*)(lds + L_R);
    LAS float* AM = (LAS float*)(lds + L_AM); LAS float* GAM = (LAS float*)(lds + L_GAM); LAS float* BETA = (LAS float*)(lds + L_BETA); LAS float* BEG = (LAS float*)(lds + L_BEG);
    LAS int* qi = (LAS int*)(lds + L_END);
    u32x4 xv[3][2][4]; f32x4 wld = (f32x4){0.f, 0.f, 0.f, 0.f}; unsigned blr = 0u, alr = 0u;
#define CH_LOADS(ci_) do { const int n_ = (ci_) & 63, bh_ = (ci_) >> 6, b_ = bh_ >> 3, h_ = bh_ & 7, t0_ = n_ * 64; \
        const int tl_ = opaque_tid(), c0_ = (tl_ & 15) * 8, i0_ = tl_ >> 4;     \
        _Pragma("unroll") for (int which = 0; which < 3; ++which) {             \
            const int pcol = (which == 0 ? OC_QD : which == 1 ? OC_KD : OC_VD) + h_ * 128; \
            _Pragma("unroll") for (int e = 0; e < 2; ++e) \
                _Pragma("unroll") for (int jj = 0; jj < 4; ++jj) { const int t = t0_ + i0_ + e * 32 - 3 + jj, tc = t < 0 ? 0 : t;         \
                    xv[which][e][jj] = *(const u32x4*)(proj + (size_t)(b_ * T + tc) * OD_NP + pcol + c0_); } } \
        if (tl_ < 384) { const int wh = tl_ >> 7, jj = (tl_ & 127) >> 5, c4 = tl_ & 31; wld = *(const f32x4*)(convw + (size_t)jj * 3072 + wh * 1024 + h_ * 128 + c4 * 4); } \
        if (tl_ < 64) { const size_t row = (size_t)(b_ * T + t0_ + tl_) * OD_NP; blr = proj[row + OC_BETA + h_]; alr = proj[row + OC_A + h_]; } } while (0)
#define CH_STEP01(ci_) do { const int n = (ci_) & 63, bh = (ci_) >> 6, h = bh & 7, t0 = n * 64; const int tl = opaque_tid(), c0 = (tl & 15) * 8, i0 = tl >> 4; \
        LAS float* WL = (LAS float*)(lds + L_WL); \
        if (tl < 384) *(LAS f32x4*)(WL + ((tl >> 7) * 4 + ((tl & 127) >> 5)) * 128 + (tl & 31) * 4) = wld; \
        if (tl < 64) { \
            const float bl = __uint_as_float(blr << 16), al = __uint_as_float(alr << 16); const float x = al + dtb[h]; \
            const float sp = fmaxf(x, 0.f) + log1pf(__expf(-fabsf(x))); \
            float g = -__expf(alog[h]) * sp; \
        _Pragma("unroll") \
            for (int o = 1; o < 64; o <<= 1) { const float nb = shu(g, o); if (tl >= o) g += nb; } \
            const float be = sigmoidf_(bl); GAM[tl] = g; BETA[tl] = be; BEG[tl] = be * __expf(g); \
            if (tl == 63) GLg[ci_] = __expf(g); \
        } \
        __syncthreads(); \
        _Pragma("unroll") \
        for (int which = 0; which < 3; ++which) { \
            f32x4 wa[4], wb[4]; \
        _Pragma("unroll") \
            for (int jj = 0; jj < 4; ++jj) { wa[jj] = *(LAS f32x4*)(WL + (which * 4 + jj) * 128 + c0); wb[jj] = *(LAS f32x4*)(WL + (which * 4 + jj) * 128 + c0 + 4); } \
        _Pragma("unroll") \
            for (int e = 0; e < 2; ++e) { \
                const int i = i0 + e * 32; \
                float acc[8]; \
        _Pragma("unroll") \
                for (int q = 0; q < 8; ++q) acc[q] = 0.f; \
        _Pragma("unroll") \
                for (int jj = 0; jj < 4; ++jj) { \
                    const float vz = (t0 + i - 3 + jj >= 0) ? 1.f : 0.f; const u32x4 x = xv[which][e][jj]; \
                    const f32x4 a_ = wa[jj] * vz, b_ = wb[jj] * vz; \
                    acc[0] += a_[0] * bflo(x.x); acc[1] += a_[1] * bfhi(x.x); acc[2] += a_[2] * bflo(x.y); acc[3] += a_[3] * bfhi(x.y); \
                    acc[4] += b_[0] * bflo(x.z); acc[5] += b_[1] * bfhi(x.z); acc[6] += b_[2] * bflo(x.w); acc[7] += b_[3] * bfhi(x.w); \
                } \
                float ss = 0.f; \
        _Pragma("unroll") \
                for (int q = 0; q < 8; ++q) { acc[q] = siluf_(acc[q]); ss += acc[q] * acc[q]; } \
                if (which < 2) { \
                    ss = row16_sum(ss); \
                    const float rn = rsqrtf(ss + EPS) * (which == 0 ? SCALE : 1.f); \
        _Pragma("unroll") \
                    for (int q = 0; q < 8; ++q) acc[q] *= rn; \
                    u32x4 w; w.x = cvt_pk_bf16(acc[0], acc[1]); w.y = cvt_pk_bf16(acc[2], acc[3]); w.z = cvt_pk_bf16(acc[4], acc[5]); w.w = cvt_pk_bf16(acc[6], acc[7]); \
                    *(LAS u32x4*)(lds + (which == 0 ? L_QB16 : L_KB16) + i * RS16 + c0 * 2) = w; \
                } \
                if (which >= 1) { const float sc = (which == 1) ? BEG[i] : BETA[i]; LAS float* dst = R + i * RLD + (which == 1 ? 128 : 0) + c0; \
                    *(LAS f32x4*)dst = (f32x4){acc[0], acc[1], acc[2], acc[3]} * sc; *(LAS f32x4*)(dst + 4) = (f32x4){acc[4], acc[5], acc[6], acc[7]} * sc; } \
            } \
        } \
    } while (0)
    unsigned pend = 0u;
    if (threadIdx.x == 0) pend = __hip_atomic_fetch_add(qhead, 1u, __ATOMIC_RELAXED, __HIP_MEMORY_SCOPE_AGENT);
    __syncthreads();
    if (threadIdx.x == 0) { *qi = (int)pend; pend = __hip_atomic_fetch_add(qhead, 1u, __ATOMIC_RELAXED, __HIP_MEMORY_SCOPE_AGENT); }
    __syncthreads();
    int ci = __builtin_amdgcn_readfirstlane(*qi);
    if (ci < NCHUNK) { CH_LOADS(ci); CH_STEP01(ci); }
    if (threadIdx.x == 0) { *qi = (int)pend; pend = __hip_atomic_fetch_add(qhead, 1u, __ATOMIC_RELAXED, __HIP_MEMORY_SCOPE_AGENT); }
    for (;;) {
        if (ci >= NCHUNK) break;
        __syncthreads();
        const int ci_next = __builtin_amdgcn_readfirstlane(*qi);
        if (ci_next < NCHUNK) CH_LOADS(ci_next);
        {
            const int t2 = opaque_tid(), wid = __builtin_amdgcn_readfirstlane(t2 >> 6), lane = t2 & 63, r32 = lane & 31, hi = lane >> 5;
            const int mat = wid >> 2, ti = (wid >> 1) & 1, tj = wid & 1;
            f32x16 acc = {};
            if (!(ti == 0 && tj == 1)) {
                LAS unsigned char* xa = lds + (mat == 0 ? L_KB16 : L_QB16) + (32 * ti + r32) * RS16 + hi * 16;
                LAS unsigned char* xb = lds + L_KB16 + (32 * tj + r32) * RS16 + hi * 16;
#pragma unroll
                for (int ks = 0; ks < 8; ++ks) acc = __builtin_amdgcn_mfma_f32_32x32x16_bf16(*(LAS bf16x8*)(xa + ks * 32), *(LAS bf16x8*)(xb + ks * 32), acc, 0, 0, 0);
            }
            const int jc = 32 * tj + r32; const float gj = GAM[jc];
#pragma unroll
            for (int r = 0; r < 16; ++r) {
                const int i = 32 * ti + att::crow(r, hi);
                const float dec = __expf(fminf(GAM[i] - gj, 0.f));
                if (mat == 0) AM[i * AMLD + jc] = (jc < i) ? acc[r] * BETA[i] * dec : 0.f;
                else ATg[(size_t)ci * 4096 + i * 64 + jc] = f2bf((jc <= i) ? acc[r] * dec : 0.f);
            }
        }
        __syncthreads();
        const int tid3 = opaque_tid();
        {
            { const int i = tid3 >> 3, c0 = (tid3 & 7) * 16; const float eg = __expf(GAM[i]);
#pragma unroll
              for (int q8 = 0; q8 < 2; ++q8) { const u32x4 x = *(LAS u32x4*)(lds + L_QB16 + i * RS16 + (c0 + q8 * 8) * 2);
                  u32x4 w; w.x = cvt_pk_bf16(bflo(x.x) * eg, bfhi(x.x) * eg); w.y = cvt_pk_bf16(bflo(x.y) * eg, bfhi(x.y) * eg);
                  w.z = cvt_pk_bf16(bflo(x.z) * eg, bfhi(x.z) * eg); w.w = cvt_pk_bf16(bflo(x.w) * eg, bfhi(x.w) * eg);
                  *(u32x4*)(QGg + (size_t)ci * 8192 + i * 128 + c0 + q8 * 8) = w; } }
            { const int dk = tid3 >> 2, i0 = (tid3 & 3) * 16; const float gl = GAM[63];
#pragma unroll
              for (int q8 = 0; q8 < 2; ++q8) { float v[8];
#pragma unroll
                  for (int e = 0; e < 8; ++e) { const int i = i0 + q8 * 8 + e; v[e] = bf2f(*(LAS bf16_t*)(lds + L_KB16 + i * RS16 + dk * 2)) * __expf(gl - GAM[i]); }
                  u32x4 w; w.x = cvt_pk_bf16(v[0], v[1]); w.y = cvt_pk_bf16(v[2], v[3]); w.z = cvt_pk_bf16(v[4], v[5]); w.w = cvt_pk_bf16(v[6], v[7]);
                  *(u32x4*)(KTg + (size_t)ci * 8192 + dk * 64 + i0 + q8 * 8) = w; } }
        }
        {
            const int l3 = tid3 & 63, ln = l3 & 15, lk = l3 >> 4, w3 = __builtin_amdgcn_readfirstlane(tid3 >> 6);
            LAS float* Ro = R; LAS float* AMo = AM;
            asm volatile("" : "+v"(Ro), "+v"(AMo));
#pragma unroll
            for (int bb = 0; bb < 4; ++bb) {
                if (bb > 0) {
                    const int col0 = w3 * 32 + ln, col1 = col0 + 16;
                    f32x4 c0v, c1v;
#pragma unroll
                    for (int r = 0; r < 4; ++r) { c0v[r] = Ro[(16 * bb + 4 * lk + r) * RLD + col0]; c1v[r] = Ro[(16 * bb + 4 * lk + r) * RLD + col1]; }
#pragma unroll
                    for (int bp = 0; bp < bb; ++bp)
#pragma unroll
                        for (int s = 0; s < 4; ++s) {
                            const float am = -AMo[(16 * bb + ln) * AMLD + 16 * bp + 4 * s + lk];
                            const float x0 = Ro[(16 * bp + 4 * s + lk) * RLD + col0], x1 = Ro[(16 * bp + 4 * s + lk) * RLD + col1];
                            c0v = __builtin_amdgcn_mfma_f32_16x16x4f32(am, x0, c0v, 0, 0, 0);
                            c1v = __builtin_amdgcn_mfma_f32_16x16x4f32(am, x1, c1v, 0, 0, 0);
                        }
#pragma unroll
                    for (int r = 0; r < 4; ++r) { Ro[(16 * bb + 4 * lk + r) * RLD + col0] = c0v[r]; Ro[(16 * bb + 4 * lk + r) * RLD + col1] = c1v[r]; }
                    __syncthreads();
                }
                if (tid3 < 256) {
                    LAS float* rc = Ro + (16 * bb) * RLD + tid3;
                    float x[16];
#pragma unroll
                    for (int i = 0; i < 16; ++i) x[i] = rc[i * RLD];
#pragma unroll
                    for (int i = 1; i < 16; ++i) {
#pragma unroll
                        for (int j4 = 0; j4 < (i + 3) / 4; ++j4) {
                            const f32x4 am = *(LAS f32x4*)(AMo + (16 * bb + i) * AMLD + 16 * bb + j4 * 4);
#pragma unroll
                            for (int e = 0; e < 4; ++e) if (j4 * 4 + e < i) x[i] -= am[e] * x[j4 * 4 + e];
                        }
                    }
#pragma unroll
                    for (int i = 1; i < 16; ++i) rc[i * RLD] = x[i];
                }
                __syncthreads();
            }
        }
        if (threadIdx.x == 0) { *qi = (int)pend; pend = __hip_atomic_fetch_add(qhead, 1u, __ATOMIC_RELAXED, __HIP_MEMORY_SCOPE_AGENT); }
        {
            const int tid4 = opaque_tid();
#pragma unroll
            for (int e = 0; e < 4; ++e) { const int idx = tid4 + e * NTHR, i = idx >> 5, ch = idx & 31;
                const f32x4 a0 = *(LAS f32x4*)(R + i * RLD + ch * 8), a1 = *(LAS f32x4*)(R + i * RLD + ch * 8 + 4);
                const float sg = ch < 16 ? 1.f : -1.f;
                u32x4 w; w.x = cvt_pk_bf16(a0[0] * sg, a0[1] * sg); w.y = cvt_pk_bf16(a0[2] * sg, a0[3] * sg); w.z = cvt_pk_bf16(a1[0] * sg, a1[1] * sg); w.w = cvt_pk_bf16(a1[2] * sg, a1[3] * sg);
                *(u32x4*)((ch < 16 ? Ug : Wg) + (size_t)ci * 8192 + i * 128 + (ch & 15) * 8) = w; }
        }
        __syncthreads();
        if (ci_next < NCHUNK) CH_STEP01(ci_next);
        ci = ci_next;
    }
#undef CH_STEP01
#undef CH_LOADS
    __syncthreads();
}

__device__ __forceinline__ bf16x8 ld_afrag(const bf16_t* __restrict__ rowp, int hi) {
    const u32x2 a = *(const u32x2*)(rowp + 4 * hi), b = *(const u32x2*)(rowp + 8 + 4 * hi);
    u32x4 w = {a.x, a.y, b.x, b.y}; return *reinterpret_cast<bf16x8*>(&w);
}
__device__ __forceinline__ bf16x8 acc_bfrag(const f32x16& x, int s) {
    u32x4 w = {cvt_pk_bf16(x[8 * s + 0], x[8 * s + 1]), cvt_pk_bf16(x[8 * s + 2], x[8 * s + 3]), cvt_pk_bf16(x[8 * s + 4], x[8 * s + 5]), cvt_pk_bf16(x[8 * s + 6], x[8 * s + 7])};
    return *reinterpret_cast<bf16x8*>(&w);
}

constexpr int SL_W = 0, SL_QG = SL_W + 64 * 272, SL_KT = SL_QG + 64 * 272, SL_AT = SL_KT + 128 * 144, SL_U = SL_AT + 64 * 144, SL_OS = SL_U + 64 * 256, SL_END = SL_OS + 64 * 132 * 4;
static_assert(SL_END <= LDS_BARW, "scan lds");
__device__ __forceinline__ bf16x8 ld_afrag_lds(const LAS unsigned char* rowp, int hi) {
    const u32x2 a = *(const LAS u32x2*)(rowp + 8 * hi), b = *(const LAS u32x2*)(rowp + 16 + 8 * hi);
    u32x4 w = {a.x, a.y, b.x, b.y}; return *reinterpret_cast<bf16x8*>(&w);
}
__device__ __forceinline__ void scan_item(const Frame& F, int bh, const bf16_t* __restrict__ proj, bf16_t* __restrict__ mix, const float* __restrict__ gnorm) {
    LAS unsigned char* lds = F.lds;
    const int tid = opaque_tid(), wid = __builtin_amdgcn_readfirstlane(tid >> 6), lane = tid & 63, r32 = lane & 31, hi = lane >> 5;
    unsigned char* ws = F.ws;
    const bf16_t* Ug = (const bf16_t*)(ws + WS_G_U); const bf16_t* Wg = (const bf16_t*)(ws + WS_G_W); const bf16_t* QGg = (const bf16_t*)(ws + WS_G_QG); const bf16_t* KTg = (const bf16_t*)(ws + WS_G_KT);
    const bf16_t* ATg = (const bf16_t*)(ws + WS_G_ATT); const float* GLg = (const float*)(ws + WS_G_GL);
    LAS float* OS = (LAS float*)(lds + SL_OS);
    const int b = bh >> 3, h = bh & 7;
    const bool loader = wid >= 4;
    u32x4 st[18];
#define SCAN_LOAD(ci_) do { const size_t c_ = (size_t)(ci_); const int lt = opaque_tid() & 255;     \
        _Pragma("unroll") for (int e = 0; e < 4; ++e) { const int idx = lt + 256 * e; \
            st[e]      = *(const u32x4*)(Wg  + c_ * 8192 + (idx >> 4) * 128 + (idx & 15) * 8); \
            st[4 + e]  = *(const u32x4*)(QGg + c_ * 8192 + (idx >> 4) * 128 + (idx & 15) * 8); \
            st[8 + e]  = *(const u32x4*)(KTg + c_ * 8192 + (idx >> 3) * 64 + (idx & 7) * 8); \
            st[12 + e] = *(const u32x4*)(Ug  + c_ * 8192 + (idx >> 4) * 128 + (idx & 15) * 8); } \
        _Pragma("unroll") for (int e = 0; e < 2; ++e) { const int idx = lt + 256 * e; st[16 + e] = *(const u32x4*)(ATg + c_ * 4096 + (idx >> 3) * 64 + (idx & 7) * 8); } } while (0)
#define SCAN_STORE() do { const int lt = opaque_tid() & 255; \
        _Pragma("unroll") for (int e = 0; e < 4; ++e) { const int idx = lt + 256 * e; \
            *(LAS u32x4*)(lds + SL_W  + (idx >> 4) * 272 + (idx & 15) * 16) = st[e]; \
            *(LAS u32x4*)(lds + SL_QG + (idx >> 4) * 272 + (idx & 15) * 16) = st[4 + e]; \
            *(LAS u32x4*)(lds + SL_KT + (idx >> 3) * 144 + (idx & 7) * 16) = st[8 + e]; \
            *(LAS u32x4*)(lds + SL_U  + (idx >> 4) * 256 + (idx & 15) * 16) = st[12 + e]; } \
        _Pragma("unroll") for (int e = 0; e < 2; ++e) { const int idx = lt + 256 * e; *(LAS u32x4*)(lds + SL_AT + (idx >> 3) * 144 + (idx & 7) * 16) = st[16 + e]; } } while (0)
    const int ci0 = bh * 64;
    const int ni = tid >> 3, nc0 = (tid & 7) * 16;
    const bf16_t* zbase = proj + (size_t)(b * T + ni) * OD_NP + OC_Z + h * 128 + nc0;
    u32x4 z0 = *(const u32x4*)zbase, z1 = *(const u32x4*)(zbase + 8);
    float glv = GLg[ci0];
    if (loader) SCAN_LOAD(ci0);
    __syncthreads();
    if (loader) { SCAN_STORE(); SCAN_LOAD(ci0 + 1); }
    __syncthreads();
    f32x16 S[4] = {};
#pragma unroll 1
    for (int n = 0; n < 64; ++n) {
        if (!loader) {
            const int c0 = 32 * wid;
            bf16x8 vb[2][2];
#pragma unroll
            for (int mt = 0; mt < 2; ++mt) {
                f32x16 vn;
#pragma unroll
                for (int r = 0; r < 16; ++r) vn[r] = bf2f(*(const LAS bf16_t*)(lds + SL_U + (32 * mt + att::crow(r, hi)) * 256 + (c0 + r32) * 2));
                const LAS unsigned char* wrow = lds + SL_W + (32 * mt + r32) * 272;
#pragma unroll
                for (int kt = 0; kt < 4; ++kt)
#pragma unroll
                    for (int s = 0; s < 2; ++s) vn = __builtin_amdgcn_mfma_f32_32x32x16_bf16(ld_afrag_lds(wrow + (kt * 32 + s * 16) * 2, hi), acc_bfrag(S[kt], s), vn, 0, 0, 0);
                vb[mt][0] = acc_bfrag(vn, 0); vb[mt][1] = acc_bfrag(vn, 1);
            }
#pragma unroll
            for (int mt = 0; mt < 2; ++mt) {
                f32x16 oa = {};
                const LAS unsigned char* qrow = lds + SL_QG + (32 * mt + r32) * 272;
#pragma unroll
                for (int kt = 0; kt < 4; ++kt)
#pragma unroll
                    for (int s = 0; s < 2; ++s) oa = __builtin_amdgcn_mfma_f32_32x32x16_bf16(ld_afrag_lds(qrow + (kt * 32 + s * 16) * 2, hi), acc_bfrag(S[kt], s), oa, 0, 0, 0);
                const LAS unsigned char* arow = lds + SL_AT + (32 * mt + r32) * 144;
#pragma unroll
                for (int m2 = 0; m2 <= mt; ++m2)
#pragma unroll
                    for (int s = 0; s < 2; ++s) oa = __builtin_amdgcn_mfma_f32_32x32x16_bf16(ld_afrag_lds(arow + (m2 * 32 + s * 16) * 2, hi), vb[m2][s], oa, 0, 0, 0);
#pragma unroll
                for (int r = 0; r < 16; ++r) OS[(32 * mt + att::crow(r, hi)) * 132 + c0 + r32] = oa[r];
            }
#pragma unroll
            for (int kt = 0; kt < 4; ++kt) {
#pragma unroll
                for (int r = 0; r < 16; ++r) S[kt][r] *= glv;
                const LAS unsigned char* krow = lds + SL_KT + (32 * kt + r32) * 144;
#pragma unroll
                for (int m2 = 0; m2 < 2; ++m2)
#pragma unroll
                    for (int s = 0; s < 2; ++s) S[kt] = __builtin_amdgcn_mfma_f32_32x32x16_bf16(ld_afrag_lds(krow + (m2 * 32 + s * 16) * 2, hi), vb[m2][s], S[kt], 0, 0, 0);
            }
        }
        __syncthreads();
        {
            const int t = n * 64 + ni;
            float v[16]; float ss = 0.f;
#pragma unroll
            for (int q = 0; q < 4; ++q) { const f32x4 x = *(LAS f32x4*)(OS + ni * 132 + nc0 + q * 4); v[q * 4] = x[0]; v[q * 4 + 1] = x[1]; v[q * 4 + 2] = x[2]; v[q * 4 + 3] = x[3]; }
#pragma unroll
            for (int q = 0; q < 16; ++q) ss += v[q] * v[q];
            ss += shx(ss, 1); ss += shx(ss, 2); ss += shx(ss, 4);
            const float rn = rsqrtf(ss * (1.f / 128.f) + EPS);
            const float z[16] = {bflo(z0.x), bfhi(z0.x), bflo(z0.y), bfhi(z0.y), bflo(z0.z), bfhi(z0.z), bflo(z0.w), bfhi(z0.w),
                                 bflo(z1.x), bfhi(z1.x), bflo(z1.y), bfhi(z1.y), bflo(z1.z), bfhi(z1.z), bflo(z1.w), bfhi(z1.w)};
            float y[16];
#pragma unroll
            for (int q = 0; q < 16; ++q) y[q] = v[q] * rn * gnorm[nc0 + q] * siluf_(z[q]);
            u32x4 w0, w1;
            w0.x = cvt_pk_bf16(y[0], y[1]); w0.y = cvt_pk_bf16(y[2], y[3]); w0.z = cvt_pk_bf16(y[4], y[5]); w0.w = cvt_pk_bf16(y[6], y[7]);
            w1.x = cvt_pk_bf16(y[8], y[9]); w1.y = cvt_pk_bf16(y[10], y[11]); w1.z = cvt_pk_bf16(y[12], y[13]); w1.w = cvt_pk_bf16(y[14], y[15]);
            bf16_t* mrow = mix + (size_t)(b * T + t) * D + 1024 + h * 128 + nc0;
            *(u32x4*)mrow = w0; *(u32x4*)(mrow + 8) = w1;
            if (n + 1 < 64) { const bf16_t* zn = zbase + (size_t)((n + 1) * 64) * OD_NP; z0 = *(const u32x4*)zn; z1 = *(const u32x4*)(zn + 8); glv = GLg[ci0 + n + 1]; }
        }
        if (loader && n + 1 < 64) { SCAN_STORE(); if (n + 2 < 64) SCAN_LOAD(ci0 + n + 2); }
        __syncthreads();
    }
#undef SCAN_LOAD
#undef SCAN_STORE
}
}
namespace pg8 {
struct EpiProjOdd {
    static constexpr bool PERM = true;
    bf16_t* O; int ldc; bf16_t* kcmp; bf16_t* vcmp; const float* rs;
    __device__ __forceinline__ void prefetch(const Unit& u, int ui) const { rs_prefetch(rs, u.pm, ui); }
    __device__ __forceinline__ void operator()(const f32x4 (&acc)[2][2][4][2], const Unit& u, int wr, int wc, int ui, int) const {
        const int ol_ = opaque_tid() & 63, fr = ol_ & 15, fq = ol_ >> 4;
        const int row0 = u.pm * BM + wr * 64 + fr, col0 = u.pn * BM + wc * 32 + 8 * fq;
        const bool cmp = (u.pn == 8 || u.pn == 9);
        bf16_t* cb = (u.pn == 8) ? kcmp : vcmp;
        float r_[2][4];
        rs_read(r_, ui, wr, fr);
#pragma unroll
        for (int ai = 0; ai < 2; ++ai)
#pragma unroll
            for (int m = 0; m < 4; ++m) { const int row = row0 + ai * HALF + m * 16; const float r = r_[ai][m];
#pragma unroll
                for (int bj = 0; bj < 2; ++bj) { const f32x4 v0 = acc[ai][bj][m][0] * r, v1 = acc[ai][bj][m][1] * r;
                    u32x4 w; w.x = cvt_pk_bf16(v0[0], v0[1]); w.y = cvt_pk_bf16(v0[2], v0[3]); w.z = cvt_pk_bf16(v1[0], v1[1]); w.w = cvt_pk_bf16(v1[2], v1[3]);
                    bf16_t* p = cmp ? cb + ((size_t)((row / T) * 2 + bj) * T + (row % T)) * 128 + wc * 32 + 8 * fq
                                    : O + (size_t)row * ldc + col0 + bj * HALF;
                    *(u32x4*)p = w; } }
    }
};
__device__ __forceinline__ float gelu_tanh(float x) { const float y = 0.7978845608028654f * (x + 0.044715f * x * x * x); return x * __builtin_amdgcn_rcpf(1.f + __expf(-2.f * y)); }
struct EpiGeluBf16 {
    static constexpr bool PERM = true;
    bf16_t* O; int ldc; const float* bias;
    __device__ __forceinline__ void prefetch(const Unit&, int) const {}
    __device__ __forceinline__ void operator()(const f32x4 (&acc)[2][2][4][2], const Unit& u, int wr, int wc, int, int) const {
        const int ol_ = opaque_tid() & 63, fr = ol_ & 15, fq = ol_ >> 4;
        const int row0 = u.pm * BM + wr * 64 + fr, col0 = u.pn * BM + wc * 32 + 8 * fq;
#pragma unroll
        for (int bj = 0; bj < 2; ++bj) { f32x4 b0 = (f32x4){0.f, 0.f, 0.f, 0.f}, b1 = b0;
#pragma unroll 8
            for (int pp = 0; pp < 32; ++pp) { b0 += *(const f32x4*)(bias + pp * 256 + col0 + bj * HALF); b1 += *(const f32x4*)(bias + pp * 256 + col0 + bj * HALF + 4); }
#pragma unroll
            for (int ai = 0; ai < 2; ++ai)
#pragma unroll
                for (int m = 0; m < 4; ++m) { const f32x4 v0 = acc[ai][bj][m][0] + b0, v1 = acc[ai][bj][m][1] + b1;
                    u32x4 w; w.x = cvt_pk_bf16(gelu_tanh(v0[0]), gelu_tanh(v0[1])); w.y = cvt_pk_bf16(gelu_tanh(v0[2]), gelu_tanh(v0[3]));
                    w.z = cvt_pk_bf16(gelu_tanh(v1[0]), gelu_tanh(v1[1])); w.w = cvt_pk_bf16(gelu_tanh(v1[2]), gelu_tanh(v1[3]));
                    *(u32x4*)(O + (size_t)(row0 + ai * HALF + m * 16) * ldc + col0 + bj * HALF) = w; } }
    }
};
}

namespace nsa {
using namespace att;
constexpr int IMP_LD = 257, SC_LD = 65;
constexpr int L_IMP = 2 * att::KVBUF, L_SC = L_IMP + 64 * IMP_LD * 4  , L_WS = L_SC + 64 * SC_LD * 4, L_TAB = L_WS + 2048, L_BM = L_TAB + 8 * 129 * 4, L_QI = L_BM + 512, L_GATE = L_QI + 16  , L_ENDN = L_GATE + 4096;
static_assert(L_ENDN <= LDS_BARW && (L_IMP % 16) == 0 && L_IMP + 2 * att::KVBUF <= L_SC, "nsa lds");

template <int MODE>
__device__ __forceinline__ void branch_out(const f32x16* o, const float* rs, float* __restrict__ accw, bf16_t* __restrict__ Ow, int ldo, int, int) {
    const int l_ = opaque_tid() & 63, r32 = l_ & 31, hi = l_ >> 5;
    float* base = accw + 4 * hi * 128 + r32;
    float a[16][4];
    if (MODE != 0) {
#pragma unroll
        for (int r = 0; r < 16; ++r)
#pragma unroll
            for (int d0 = 0; d0 < 4; ++d0) a[r][d0] = base[((r & 3) + 8 * (r >> 2)) * 128 + d0 * 32];
    }
    if (MODE != 2) {
#pragma unroll
        for (int r = 0; r < 16; ++r)
#pragma unroll
            for (int d0 = 0; d0 < 4; ++d0) { const float v = o[d0][r] * rs[r]; base[((r & 3) + 8 * (r >> 2)) * 128 + d0 * 32] = (MODE == 0) ? v : a[r][d0] + v; }
    } else {
        unsigned w[16][4];
#pragma unroll
        for (int r = 0; r < 16; ++r)
#pragma unroll
            for (int d0 = 0; d0 < 4; ++d0) { const float v = o[d0][r] * rs[r] + a[r][d0]; const float vn = DPPF(v, 0xB1); w[r][d0] = cvt_pk_bf16(v, vn); }
        if ((r32 & 1) == 0) {
#pragma unroll
            for (int r = 0; r < 16; ++r) { const int orow = crow(r, hi);
#pragma unroll
                for (int d0 = 0; d0 < 4; ++d0) *(unsigned*)(Ow + (size_t)(orow >> 2) * ldo + (orow & 3) * 128 + d0 * 32 + r32) = w[r][d0]; }
        }
    }
}

__device__ __forceinline__ void nsa_item(const Frame& F, int item, const bf16_t* __restrict__ proj, bf16_t* __restrict__ mix, const float* __restrict__ relb) {
    LAS unsigned char* lds = F.lds;
    const int tid = opaque_tid(), wid = __builtin_amdgcn_readfirstlane(tid >> 6), lane = tid & 63, r32 = lane & 31, hi = lane >> 5;
    unsigned char* ws = F.ws;
    LAS float* al_l = (LAS float*)(lds + L_WS) + wid * 64;
    LAS float* tab = (LAS float*)(lds + L_TAB);
    LAS float* IMP = (LAS float*)(lds + L_IMP);
    LAS float* SC = (LAS float*)(lds + L_SC);
    LAS unsigned* BM = (LAS unsigned*)(lds + L_BM);
    const int vb0 = (int)(uintptr_t)(lds + L_V) + v_rd_base(lane);
    constexpr int LD = OD_NP;
    const int qb = 63 - (item >> 4), bg = item & 15, b = bg >> 1, g = bg & 1;
    const int P0 = qb * 64, qlo = P0 + wid * 8, qhi = qlo + 7, ql = wid * 8 + (r32 >> 2), hl = r32 & 3, head = g * 4 + hl, qpos = qlo + (r32 >> 2), cur = qb;
    float* accw = (float*)(ws + WS_NSAACC) + ((size_t)F.bid * 256 + wid * 32) * 128;
    __syncthreads();
    for (int i = tid; i < 64 * IMP_LD; i += NTHR) IMP[i] = 0.f;
    if (tid < 128) BM[tid] = 0u;
    const size_t qrow = (size_t)(b * T + qpos) * LD;
    bf16x8 qr[8];
#pragma unroll
    for (int d0 = 0; d0 < 8; ++d0) qr[d0] = *(const bf16x8*)(proj + qrow + OC_QC + head * 128 + d0 * 16 + hi * 8);
    { u32x2 gg; gg.x = (unsigned)proj[qrow + OC_GATE + head] | ((unsigned)proj[qrow + OC_GATE + 8 + head] << 16); gg.y = proj[qrow + OC_GATE + 16 + head];
      *(LAS u32x2*)(lds + L_GATE + tid * 8) = gg; }
#define gate01_ (((const LAS unsigned*)(lds + L_GATE))[opaque_tid() * 2])
#define gate2_  (((const LAS unsigned*)(lds + L_GATE))[opaque_tid() * 2 + 1])
#define NSA_GATE(br) sigmoidf_((br) == 0 ? bflo(gate01_) : (br) == 1 ? bfhi(gate01_) : bflo(gate2_))
    const LAS float* tb = tab + head * 129;
    const float NEG = -__builtin_inff();

    const bf16_t* KCg = (const bf16_t*)(ws + WS_KC) + (size_t)(bg * 256) * 256;
    const bf16_t* VCg = KCg + (size_t)4096 * 256;
    const int cmax = (qpos - 31) >> 4;
    const int cmax_wg = (P0 + 63 - 31) >> 4;
    const int nct = (cmax_wg >> 6) + 1;
    float m_reg = -1e30f, l_reg = 0.f;
    {
        const KvOff kc = kv_dma_off(tid, 256);
        kv_dma(lds, KCg, VCg, 256, kc, wid);
        float inv_l = 0.f, mL = 0.f;
        f32x16 o[4] = {};
        for (int s = 0; s < 2 * nct; ++s) {
            const int jt = s < nct ? s : s - nct, bo = (s & 1) * KVBUF;
            asm volatile("s_waitcnt vmcnt(0)" ::: "memory");
            RING_BAR();
            if (s + 1 < 2 * nct) { const int jn = (s + 1 < nct) ? s + 1 : s + 1 - nct; kv_dma(lds + (bo ^ KVBUF), KCg + (size_t)(jn * 64) * 256, VCg + (size_t)(jn * 64) * 256, 256, kc, wid); }
            if (s == nct) { inv_l = l_reg > 0.f ? 1.f / l_reg : 0.f; mL = -m_reg * C2; }
            f32x16 p0, p1; qkt(p0, p1, lds + bo, r32, hi, qr);
            if (s < nct) {
#pragma unroll
                for (int r = 0; r < 16; ++r) { const int c = jt * 64 + crow(r, hi); if (c > cmax) p0[r] = NEG; if (c + 32 > cmax) p1[r] = NEG; }
                float mn, alpha; partialSM(p0, p1, m_reg, mn, alpha);
                l_reg = l_reg * alpha + row_sum(p0, p1);
            } else {
                LAS float* ib = IMP + ql * IMP_LD + jt * 64 + 4 * hi;
#pragma unroll
                for (int r = 0; r < 16; ++r) { const int c = jt * 64 + crow(r, hi);
                    p0[r] = (c <= cmax) ? __builtin_amdgcn_exp2f(fmaf(p0[r], C2, mL)) * inv_l : 0.f;
                    p1[r] = (c + 32 <= cmax) ? __builtin_amdgcn_exp2f(fmaf(p1[r], C2, mL)) * inv_l : 0.f;
                    float s0 = p0[r], s1 = p1[r];
                    s0 += DPPF(s0, 0xB1); s1 += DPPF(s1, 0xB1); s0 += DPPF(s0, 0x4E); s1 += DPPF(s1, 0x4E);
                    if (hl == 0) { ib[(r & 3) + 8 * (r >> 2)] = s0; ib[(r & 3) + 8 * (r >> 2) + 32] = s1; } }
                bf16x8 pa0, pa1, pa2, pa3; pack_p(p0, p1, pa0, pa1, pa2, pa3);
                pv_tile(o, vb0 + bo, pa0, pa1, pa2, pa3);
            }
        }
        float rs[16]; lanes_to_rows(NSA_GATE(0), rs, al_l, r32, hi);
        branch_out<0>(o, rs, accw, nullptr, 0, r32, hi);
    }
    __syncthreads();
    {
        const int q = tid & 63, j0 = (tid >> 6) * 8;
        const LAS float* ip = IMP + q * IMP_LD;
#pragma unroll
        for (int e = 0; e < 8; ++e) { const int j = j0 + e;
            const float left = (j > 0) ? ip[4 * j - 1] : 0.f;
            const float blk = left + 2.f * (ip[4 * j] + ip[4 * j + 1] + ip[4 * j + 2]) + ip[4 * j + 3];
            const bool forced = (j == 0) || (j == cur) || (j == cur - 1);
            SC[q * SC_LD + j] = forced ? 1e9f : (j > cur ? -1e9f : blk); }
    }
    __syncthreads();
    {
        const int q = tid & 63, j0 = (tid >> 6) * 8;
        unsigned long long mine[8]; int rank[8];
#define NSA_KEY(sc_, j_) ((((unsigned long long)(__float_as_uint(sc_) ^ ((__float_as_uint(sc_) >> 31) ? 0xffffffffu : 0x80000000u))) << 6) | (unsigned)(63 - (j_)))
#pragma unroll
        for (int e = 0; e < 8; ++e) { const float v = SC[q * SC_LD + j0 + e]; mine[e] = NSA_KEY(v, j0 + e); rank[e] = 0; }
#pragma unroll 2
        for (int jj = 0; jj <= cur; ++jj) { const float sv = SC[q * SC_LD + jj]; const unsigned long long ks = NSA_KEY(sv, jj);
#pragma unroll
            for (int e = 0; e < 8; ++e) rank[e] += (ks > mine[e]) ? 1 : 0; }
#undef NSA_KEY
        unsigned bits = 0u;
#pragma unroll
        for (int e = 0; e < 8; ++e) if (rank[e] < 8 && (j0 + e) <= cur) bits |= 1u << e;
        if (bits) __hip_atomic_fetch_or(BM + q * 2 + (j0 >> 5), bits << (j0 & 31), __ATOMIC_RELAXED, __HIP_MEMORY_SCOPE_WORKGROUP);
    }
    __syncthreads();
    unsigned wu_lo, wu_hi, gu_lo, gu_hi;
    { unsigned a = BM[ql * 2], c = BM[ql * 2 + 1];
#pragma unroll
      for (int o_ = 1; o_ < 32; o_ <<= 1) { a |= shx(a, o_); c |= shx(c, o_); }
      wu_lo = __builtin_amdgcn_readfirstlane(a); wu_hi = __builtin_amdgcn_readfirstlane(c);
      unsigned a2 = BM[lane * 2], c2 = BM[lane * 2 + 1];
#pragma unroll
      for (int o_ = 1; o_ < 64; o_ <<= 1) { a2 |= shx(a2, o_); c2 |= shx(c2, o_); }
      gu_lo = __builtin_amdgcn_readfirstlane(a2); gu_hi = __builtin_amdgcn_readfirstlane(c2); }
    {
        const int tid = opaque_tid(), lane = tid & 63, r32 = lane & 31, hi = lane >> 5, qpos = qlo + (r32 >> 2), ql = wid * 8 + (r32 >> 2);
        const int vb0 = (int)(uintptr_t)(lds + L_V) + v_rd_base(lane);
        const KvOff ko = kv_dma_off(tid, LD);
        const bf16_t* Kg = proj + (size_t)(b * T) * LD + OC_KSEL + g * 128;
        const bf16_t* Vg = proj + (size_t)(b * T) * LD + OC_VSEL + g * 128;
        m_reg = -1e30f; l_reg = 0.f; f32x16 o[4] = {};
        unsigned long long remI = ((unsigned long long)gu_hi << 32) | gu_lo, remC = remI;
        const int nT = __builtin_popcountll(remI);
#define SEL_ISSUE(k_) do { const int jn = __builtin_ctzll(remI); remI &= remI - 1; kv_dma(lds + ((k_) & 3) * KVBUF, Kg + (size_t)(jn * 64) * LD, Vg + (size_t)(jn * 64) * LD, LD, ko, wid); } while (0)
        int jt = 0, kb = 0;
        dual_attn<4, 4>(nT, wid, lds, vb0, qr, o, m_reg, l_reg, al_l, r32, hi,
            [&](int k) { SEL_ISSUE(k); },
            [&](int) { jt = __builtin_ctzll(remC); remC &= remC - 1; kb = jt * 64; return ((jt < 32 ? wu_lo >> jt : wu_hi >> (jt - 32)) & 1u) != 0u; },
            [&](int, f32x16& p0, f32x16& p1) {
                const bool mysel = ((BM[ql * 2 + (jt >> 5)] >> (jt & 31)) & 1u) != 0u;
                const int dq = qpos - kb - 4 * hi;
                if (qlo - kb >= 190) {
                    const float tc = tb[127];
#pragma unroll
                    for (int r = 0; r < 16; ++r) { p0[r] = mysel ? p0[r] + tc : NEG; p1[r] = mysel ? p1[r] + tc : NEG; }
                } else {
#pragma unroll
                for (int r = 0; r < 16; ++r) { const int c = (r & 3) + 8 * (r >> 2); const int d0_ = dq - c, d1_ = dq - c - 32;
                    float t0 = tb[min(max(d0_, 0), 127)], t1 = tb[min(max(d1_, 0), 127)];
                    asm("" : "+v"(t0), "+v"(t1));
                    p0[r] = (mysel && d0_ >= 0) ? p0[r] + t0 : NEG; p1[r] = (mysel && d1_ >= 0) ? p1[r] + t1 : NEG; }
                }
            });
#undef SEL_ISSUE
        float rs[16]; lanes_to_rows(l_reg > 0.f ? NSA_GATE(1) * __builtin_amdgcn_rcpf(l_reg) : 0.f, rs, al_l, r32, hi);
        branch_out<1>(o, rs, accw, nullptr, 0, r32, hi);
    }
    {
        const int tid = opaque_tid(), lane = tid & 63, r32 = lane & 31, hi = lane >> 5, qpos = qlo + (r32 >> 2);
        const int vb0 = (int)(uintptr_t)(lds + L_V) + v_rd_base(lane);
        const KvOff ko = kv_dma_off(tid, LD);
        const bf16_t* Kg = proj + (size_t)(b * T) * LD + OC_KWIN + g * 128;
        const bf16_t* Vg = proj + (size_t)(b * T) * LD + OC_VWIN + g * 128;
        m_reg = -1e30f; l_reg = 0.f; f32x16 o[4] = {};
        const int jt0 = (qb >= 8 ? qb - 8 : 0), nT = qb - jt0 + 1;
#define WIN_ISSUE(k_) kv_dma(lds + ((k_) & 3) * KVBUF, Kg + (size_t)((jt0 + (k_)) * 64) * LD, Vg + (size_t)((jt0 + (k_)) * 64) * LD, LD, ko, wid)
        __syncthreads();
        int kb = 0;
        dual_attn<4, 4>(nT, wid, lds, vb0, qr, o, m_reg, l_reg, al_l, r32, hi,
            [&](int k) { WIN_ISSUE(k); },
            [&](int s) { kb = (jt0 + s) * 64; return kb <= qhi && kb + 63 >= qlo - 511; },
            [&](int, f32x16& p0, f32x16& p1) {
                const int dq = qpos - kb - 4 * hi;
                if (qlo - kb >= 190 && qhi - kb <= 511) {
                    const float tc = tb[127];
#pragma unroll
                    for (int r = 0; r < 16; ++r) { p0[r] += tc; p1[r] += tc; }
                } else {
#pragma unroll
                for (int r = 0; r < 16; ++r) { const int c = (r & 3) + 8 * (r >> 2); const int d0_ = dq - c, d1_ = dq - c - 32;
                    float t0 = tb[min(max(d0_, 0), 127)], t1 = tb[min(max(d1_, 0), 127)];
                    asm("" : "+v"(t0), "+v"(t1));
                    p0[r] = ((unsigned)d0_ < 512u) ? p0[r] + t0 : NEG; p1[r] = ((unsigned)d1_ < 512u) ? p1[r] + t1 : NEG; }
                }
            });
#undef WIN_ISSUE
        float rs[16]; lanes_to_rows(l_reg > 0.f ? NSA_GATE(2) * __builtin_amdgcn_rcpf(l_reg) : 0.f, rs, al_l, r32, hi);
        branch_out<2>(o, rs, accw, mix + (size_t)(b * T + qlo) * D + g * 512, D, r32, hi);
    }
#undef NSA_GATE
#undef gate01_
#undef gate2_
}

__device__ __forceinline__ void odd_attn_phase(const Frame& F, const bf16_t* __restrict__ proj, bf16_t* __restrict__ mix, const float* __restrict__ relb, const float* __restrict__ gnorm, unsigned* __restrict__ qhead) {
    for (int bh = F.bid; bh < NB * 8; bh += F.G) gdn::scan_item(F, bh, proj, mix, gnorm);
    LAS int* qi = (LAS int*)(F.lds + L_QI);
    __syncthreads();
    for (int i = opaque_tid(); i < 8 * 129; i += NTHR) { const int hd = i / 129, dist = i - hd * 129; ((LAS float*)(F.lds + L_TAB))[i] = relb[att::t5_bucket(dist < 128 ? dist : 127) * 8 + hd] * INV_SCALE; }
    for (;;) {
        __syncthreads();
        if (threadIdx.x == 0) *qi = (int)__hip_atomic_fetch_add(qhead, 1u, __ATOMIC_RELAXED, __HIP_MEMORY_SCOPE_AGENT);
        __syncthreads();
        const int item = __builtin_amdgcn_readfirstlane(*qi);
        if (item >= 1024) break;
        nsa_item(F, item, proj, mix, relb);
    }
    __syncthreads();
}
}

#define N_ODD_PHASES 5
#define odd_mixer_phases \
    PH_BEGIN { pg8::Gemm g{RES, (const bf16_t*)(ws + WS_W_OD_IN + j * SZ_W_OD_IN), M, OD_NP, D, D}; pg8::StaticOrder S; S.init(M, OD_NP, F.G, F.bid); \
               pg8::EpiProjOdd E{PROJ, OD_NP, (bf16_t*)(ws + WS_KCMP), (bf16_t*)(ws + WS_VCMP), RSTD}; pg8::gemm_phase(F.lds, g, S, E); } PH_END \
    PH_BEGIN { for (int kv = 0; kv < 2; ++kv) { \
                 { pg8::Gemm g{(const bf16_t*)(ws + (kv ? WS_VCMP : WS_KCMP)), (const bf16_t*)(ws + WS_W_C1 + (j * 2 + kv) * SZ_W_C1), 4096, 256, 4096, 2048}; \
                   pg8::StaticOrder S; S.init(4096, 256, F.G, (F.bid + F.G - 16 * kv) % F.G); \
                   pg8::EpiGeluBf16 E{(bf16_t*)(ws + WS_CHID) + (size_t)kv * 4096 * 256, 256, (const float*)(ws + WS_C1B) + (j * 2 + kv) * 32 * 256}; pg8::gemm_phase(F.lds, g, S, E); } \
                 asm volatile("s_waitcnt vmcnt(0)" ::: "memory"); __syncthreads();     \
                 { pg8::Gemm g{(const bf16_t*)(ws + WS_CHID) + (size_t)kv * 4096 * 256, (const bf16_t*)(ws + WS_W_C2 + (j * 2 + kv) * SZ_W_C2), 4096, 256, 256, 256}; \
                   pg8::StaticOrder S; S.init(4096, 256, F.G, (F.bid + F.G - 16 * kv) % F.G); \
                   pg8::EpiStoreBf16 E{(bf16_t*)(ws + WS_KC) + (size_t)kv * 4096 * 256, 256, nullptr}; pg8::gemm_phase(F.lds, g, S, E); } } \
               gdn::chunk_phase(F, PROJ, F.in[I_OD_CONVW] + (size_t)j * 4 * 3072, F.in[I_OD_ALOG] + j * 8, F.in[I_OD_DTB] + j * 8, F.ctl + CW_QUEUE + 64 * (2 + j)); } PH_END \
    PH_BEGIN nsa::odd_attn_phase(F, PROJ, HB, F.in[I_RELB], F.in[I_OD_GNORM] + j * 128, F.ctl + CW_QUEUE + 64 * j); PH_END \
    PH_BEGIN { pg8::Gemm g{HB, (const bf16_t*)(ws + WS_W_OD_OUT + j * SZ_W_OUT), M, D, D, D}; pg8::StaticOrder S; S.init(M, D, F.G, F.bid); \
               pg8::EpiAddRes E{RES, D}; pg8::gemm_phase(F.lds, g, S, E); } PH_END \
    PH_BEGIN rowstat_phase(F, RES, RSTD); PH_END
struct Args { const float* in[22]; float* out; unsigned char* ws; int ph_lo, ph_hi; };

#ifndef MIXERS
#define MIXERS 3
#endif

__global__ void __launch_bounds__(NTHR, 2) mega(Args args) {
    extern __shared__ __attribute__((aligned(16))) unsigned char lds_raw[];
    Frame F;
    F.lds = (LAS unsigned char*)lds_raw;
    F.G = gridDim.x; F.bid = blockIdx.x;
    F.in = (const float* const*)__builtin_amdgcn_kernarg_segment_ptr();
    F.out = args.out; F.ws = args.ws; F.ctl = (unsigned*)(args.ws + WS_CTL);
    const int lo = args.ph_lo, hi = args.ph_hi;
    volatile LAS unsigned* barw = (volatile LAS unsigned*)(F.lds + LDS_BARW);
    if (TID < 4) barw[TID] = 0u;
    __syncthreads();
    XcdBarrier bar; bar.bar = F.ctl + CW_BAR; bar.x = 0; bar.st = barw;
    if (hi - lo > 1) bar = xcd_barrier_post(F.ctl + CW_BAR, barw);
    int ph = 0;
#define PH_BEGIN if (lo <= ph && ph < hi) {
#define PH_END   if (ph + 1 < hi) xcd_barrier(bar); } ++ph;
    unsigned char* ws = F.ws;
    bf16_t* HB = (bf16_t*)F.out;
    bf16_t* RES = (bf16_t*)(ws + WS_RES);
    float* RSTD = F.out + (size_t)M * D / 2;
    bf16_t* PROJ = (bf16_t*)(ws + WS_PROJ);

    PH_BEGIN p0_prologue(F); PH_END
    PH_BEGIN rowstat_f_phase(F, RES, RSTD, (const bf16_t*)(ws + WS_W_EV_IN) + (size_t)EC_F * D, PROJ); PH_END

    for (int layer = 0; layer < 4; ++layer) {
        const int j = layer >> 1;
        if ((layer & 1) == 0) {
#if (MIXERS & 1)
            even_mixer_phases
#endif
        } else {
#if (MIXERS & 2)
            odd_mixer_phases
#endif
        }
        PH_BEGIN {
            pg8::Gemm g{RES, (const bf16_t*)(ws + WS_W_UP + layer * SZ_W_UP), M, FF2, D, D};
            pg8::StaticOrder S; S.init(M, FF2, F.G, F.bid);
            pg8::EpiFfnGate E{(bf16_t*)(ws + WS_ACT), F.in[I_F_CONVW] + (size_t)layer * 3 * FF, F.in[I_F_CONVB] + (size_t)layer * FF,
                              (float*)(ws + WS_TAIL), (float*)(ws + WS_HEADG), (float*)(ws + WS_HEADU), F.lds + 131072, RSTD};
            pg8::gemm_phase(F.lds, g, S, E);
        } PH_END
        PH_BEGIN
            ffn_fixup_phase(F, (bf16_t*)(ws + WS_ACT), (const float*)(ws + WS_TAIL), (const float*)(ws + WS_HEADG), (const float*)(ws + WS_HEADU),
                            F.in[I_F_CONVW] + (size_t)layer * 3 * FF, F.in[I_F_CONVB] + (size_t)layer * FF);
        PH_END
        PH_BEGIN {
            pg8::Gemm g{(const bf16_t*)(ws + WS_ACT), (const bf16_t*)(ws + WS_W_DN + layer * SZ_W_DN), M, D, FF, FF};
            pg8::StaticOrder S; S.init(M, D, F.G, F.bid);
            pg8::EpiAddRes E{RES, D};
            pg8::gemm_phase(F.lds, g, S, E);
        } PH_END
        if (layer == 1) { PH_BEGIN rowstat_f_phase(F, RES, RSTD, (const bf16_t*)(ws + WS_W_EV_IN + SZ_W_EV_IN) + (size_t)EC_F * D, PROJ); PH_END }
        else if (layer < 3) { PH_BEGIN rowstat_phase(F, RES, RSTD); PH_END }
        else { PH_BEGIN final_norm_phase(F, RES, F.out, F.in[I_NFIN]); PH_END }
    }
#undef PH_BEGIN
#undef PH_END
}

static int count_phases() {
    int ph = 2;
    for (int layer = 0; layer < 4; ++layer) {
        if ((layer & 1) == 0) { if (MIXERS & 1) ph += N_EVEN_PHASES; } else { if (MIXERS & 2) ph += N_ODD_PHASES; }
        ph += 3; ph += 1;
    }
    return ph;
}

#ifndef N_LAUNCH_MODE
#define N_LAUNCH_MODE 0
#endif

extern "C" void kernel_launch(void* const* d_in, const int* in_sizes, int n_in, void* d_out, int out_size, void* d_ws, size_t ws_size, hipStream_t stream) {
    static int grid = 0;
    if (grid == 0) {
        if (n_in != 22 || out_size != M * D || ws_size < WS_END) { fprintf(stderr, "kernel_launch: unexpected shapes (n_in %d out %d ws %zu need %zu)\n", n_in, out_size, ws_size, (size_t)WS_END); grid = -1; return; }
        int dev = 0, cus = 0, per_cu = 0;
        if (hipGetDevice(&dev) != hipSuccess || hipDeviceGetAttribute(&cus, hipDeviceAttributeMultiprocessorCount, dev) != hipSuccess) { grid = -1; return; }
        if (hipFuncSetAttribute((const void*)mega, hipFuncAttributeMaxDynamicSharedMemorySize, LDS_BYTES) != hipSuccess) { fprintf(stderr, "kernel_launch: hipFuncSetAttribute failed\n"); grid = -1; return; }
        if (hipOccupancyMaxActiveBlocksPerMultiprocessor(&per_cu, (const void*)mega, NTHR, LDS_BYTES) != hipSuccess || per_cu < 1) { fprintf(stderr, "kernel_launch: occupancy query says %d\n", per_cu); }
        (void)hipGetLastError();
        grid = cus;
    }
    if (grid < 0) return;
    (void)hipMemsetAsync((char*)d_ws + WS_CTL, 0, CTL_BYTES, stream);
    Args a{};
    for (int i = 0; i < 22; ++i) a.in[i] = (const float*)d_in[i];
    a.out = (float*)d_out; a.ws = (unsigned char*)d_ws;
    const int nph = count_phases();
#if N_LAUNCH_MODE == 1
    a.ph_lo = 0; a.ph_hi = nph;
    hipLaunchKernelGGL(mega, dim3(grid), dim3(NTHR), LDS_BYTES, stream, a);
#else
    for (int p = 0; p < nph; ++p) { a.ph_lo = p; a.ph_hi = p + 1; hipLaunchKernelGGL(mega, dim3(grid), dim3(NTHR), LDS_BYTES, stream, a); }
#endif
}
```

```cpp
#define MIXERS 3
#define N_LAUNCH_MODE 1
#include <hip/hip_runtime.h>
#include <cstdio>
#include <cstdint>

#define LAS __attribute__((address_space(3)))
typedef unsigned short bf16_t;
typedef short bf16x8 __attribute__((ext_vector_type(8)));
typedef short s16x4 __attribute__((ext_vector_type(4)));
typedef float f32x2 __attribute__((ext_vector_type(2)));
typedef float f32x4 __attribute__((ext_vector_type(4)));
typedef float f32x16 __attribute__((ext_vector_type(16)));
typedef unsigned u32x2 __attribute__((ext_vector_type(2)));
typedef unsigned u32x4 __attribute__((ext_vector_type(4)));

constexpr int NB = 8, T = 4096, M = NB * T, D = 2048, HD = 128;
constexpr int EV_N = 4616, EV_NP = 4864, OD_N = 6696, OD_NP = 6912, FF = 5632, FF2 = 11264;
constexpr int MH = M / 2;
constexpr int NTHR = 512, NWAVE = 8;
constexpr int LDS_BYTES = 159744;
constexpr int LDS_BARW = LDS_BYTES - 16;
constexpr float EPS = 1e-6f;
constexpr float SCALE = 0.08838834764831845f;
constexpr float INV_SCALE = 11.313708498984761f;
constexpr float LOG2E = 1.4426950408889634f;

constexpr int EC_QA = 0, EC_QB = 1024, EC_KA = 2048, EC_VA = 2304, EC_KB = 2560, EC_VB = 3584, EC_F = 4608;
constexpr int OC_QC = 0, OC_QD = 1024, OC_KCMP = 2048, OC_VCMP = 2304, OC_KSEL = 2560, OC_VSEL = 2816, OC_KWIN = 3072, OC_VWIN = 3328,
              OC_KD = 3584, OC_VD = 4608, OC_Z = 5632, OC_GATE = 6656, OC_BETA = 6680, OC_A = 6688;

__host__ __device__ inline int ev_src(int n) {
    if (n < 1024) return n;
    if (n < 2048) return n - 1024 + 1536;
    if (n < 2304) return n - 2048 + 1024;
    if (n < 2560) return n - 2304 + 1280;
    if (n < 3584) return n - 2560 + 2560;
    if (n < 4608) return n - 3584 + 3584;
    if (n < 4616) return n;
    return -1;
}
__host__ __device__ inline int od_src(int n) {
    if (n < 1024) return n;
    if (n < 2048) return n - 1024 + 2584;
    if (n < 3584) return n - 2048 + 1024;
    if (n < 4608) return n - 3584 + 3608;
    if (n < 5632) return n - 4608 + 4632;
    if (n < 6656) return n - 5632 + 5672;
    if (n < 6680) return n - 6656 + 2560;
    if (n < 6688) return n - 6680 + 5656;
    if (n < 6696) return n - 6688 + 5664;
    return -1;
}

constexpr size_t al256(size_t x) { return (x + 255) & ~(size_t)255; }
constexpr size_t WS_CTL = 0, CTL_BYTES = 65536;
constexpr size_t SZ_W_EV_IN = (size_t)EV_NP * D * 2, SZ_W_OUT = (size_t)D * D * 2, SZ_W_OD_IN = (size_t)OD_NP * D * 2,
                 SZ_W_UP = (size_t)FF2 * D * 2, SZ_W_DN = (size_t)D * FF * 2, SZ_W_C1 = (size_t)256 * 4096 * 2, SZ_W_C2 = (size_t)256 * 256 * 2;
constexpr size_t WS_W_EV_IN = WS_CTL + CTL_BYTES;
constexpr size_t WS_W_EV_OUT = WS_W_EV_IN + 2 * SZ_W_EV_IN;
constexpr size_t WS_W_OD_IN = WS_W_EV_OUT + 2 * SZ_W_OUT;
constexpr size_t WS_W_OD_OUT = WS_W_OD_IN + 2 * SZ_W_OD_IN;
constexpr size_t WS_W_UP = WS_W_OD_OUT + 2 * SZ_W_OUT;
constexpr size_t WS_W_DN = WS_W_UP + 4 * SZ_W_UP;
constexpr size_t WS_W_C1 = WS_W_DN + 4 * SZ_W_DN;
constexpr size_t WS_W_C2 = WS_W_C1 + 4 * SZ_W_C1;
constexpr size_t WS_C1B = WS_W_C2 + 4 * SZ_W_C2;
constexpr size_t WS_HB = WS_C1B + 131072;
constexpr size_t WS_RES = WS_HB;
constexpr size_t SZ_HB = (size_t)M * D * 2;
constexpr size_t WS_R = WS_HB + SZ_HB;
constexpr size_t SZ_PROJ = (size_t)M * OD_NP * 2;
constexpr size_t WS_PROJ = WS_R;
constexpr size_t WS_R2 = WS_R + SZ_PROJ;
constexpr size_t WS_CF = WS_R2;
constexpr size_t SZ_CMPBUF = (size_t)(16 * T + 64) * 128 * 2;
constexpr size_t WS_KCMP = WS_R2, WS_VCMP = al256(WS_KCMP + SZ_CMPBUF);
constexpr int NCHUNK = NB * 8 * (T / 64);
constexpr size_t SZ_G16 = (size_t)NCHUNK * 64 * 128 * 2;
constexpr size_t WS_G_U = al256(WS_VCMP + SZ_CMPBUF), WS_G_W = WS_G_U + SZ_G16, WS_G_QG = WS_G_W + SZ_G16, WS_G_KT = WS_G_QG + SZ_G16;
constexpr size_t WS_G_ATT = WS_G_KT + SZ_G16;
constexpr size_t WS_G_GL = WS_G_ATT + (size_t)NCHUNK * 64 * 64 * 2;
constexpr size_t WS_CHID = al256(WS_G_GL + (size_t)NCHUNK * 4);
constexpr size_t WS_KC = WS_CHID + (size_t)2 * 4096 * 256 * 2;
constexpr size_t WS_NSAACC = WS_KC + (size_t)2 * 4096 * 256 * 2;
constexpr size_t WS_R_END_ODD = WS_NSAACC + (size_t)256 * 256 * 128 * 4;
constexpr size_t SZ_HALO = (size_t)(M / 256) * 2 * FF * 4;
constexpr size_t WS_ACT = WS_R, WS_TAIL = WS_ACT + (size_t)M * FF * 2, WS_HEADG = WS_TAIL + SZ_HALO, WS_HEADU = WS_HEADG + SZ_HALO, WS_R_END_FFN = WS_HEADU + SZ_HALO;
constexpr size_t WS_END = (WS_R_END_ODD > WS_R_END_FFN ? WS_R_END_ODD : WS_R_END_FFN);

constexpr int CW_BAR = 0;
constexpr int CW_QUEUE = 4096;
constexpr int CW_NORM = 8192;

typedef __bf16 bf16v2_ __attribute__((ext_vector_type(2)));
__device__ __forceinline__ unsigned cvt_pk_bf16(float lo, float hi) { const f32x2 v = {lo, hi}; const bf16v2_ r = __builtin_convertvector(v, bf16v2_); return __builtin_bit_cast(unsigned, r); }
__device__ __forceinline__ bf16_t f2bf(float f) { return (bf16_t)(cvt_pk_bf16(f, 0.f) & 0xffffu); }
__device__ __forceinline__ float bf2f(bf16_t b) { return __uint_as_float(((unsigned)b) << 16); }
__device__ __forceinline__ float bflo(unsigned w) { return __uint_as_float(w << 16); }
__device__ __forceinline__ float bfhi(unsigned w) { return __uint_as_float(w & 0xffff0000u); }
__device__ __forceinline__ int opaque_tid() { int t = threadIdx.x; asm volatile("" : "+v"(t)); return t; }
__device__ __forceinline__ int olane() { return opaque_tid() & 63; }
__device__ __forceinline__ float shx(float v, int m) { return __builtin_bit_cast(float, __builtin_amdgcn_ds_bpermute((olane() ^ m) << 2, __builtin_bit_cast(int, v))); }
__device__ __forceinline__ unsigned shx(unsigned v, int m) { return (unsigned)__builtin_amdgcn_ds_bpermute((olane() ^ m) << 2, (int)v); }
__device__ __forceinline__ float shu(float v, int d) { const int l = olane(), s = l - d; return __builtin_bit_cast(float, __builtin_amdgcn_ds_bpermute((s < 0 ? l : s) << 2, __builtin_bit_cast(int, v))); }
#define DPPF(x, ctrl) __builtin_bit_cast(float, __builtin_amdgcn_update_dpp(0, __builtin_bit_cast(int, (x)), (ctrl), 0xf, 0xf, true))
__device__ __forceinline__ float row16_sum(float x) { x += DPPF(x, 0x128); x += DPPF(x, 0x124); x += DPPF(x, 0x122); x += DPPF(x, 0x121); return x; }
__device__ __forceinline__ float row8_sum(float x) { x += DPPF(x, 0xB1); x += DPPF(x, 0x4E); x += DPPF(x, 0x141); return x; }
__device__ __forceinline__ float wave_sum(float v) { v = row16_sum(v); v += shx(v, 16); v += shx(v, 32); return v; }
__device__ __forceinline__ float sigmoidf_(float x) { return __builtin_amdgcn_rcpf(1.f + __expf(-x)); }
__device__ __forceinline__ float siluf_(float x) { return x * __builtin_amdgcn_rcpf(1.f + __expf(-x)); }

#define XB_TMO      128
#define XB_XCNT(j)  (256  + 64 * (j))
#define XB_XSUB(j)  (1280 + 64 * (j))
#define XB_XGEN(j)  (2304 + 64 * (j))
#define XB_TOP      3328
#define XB_TOPGEN   3392
#define XCD_BAR_WORDS 3456
#define XB_SPIN_CAP (1u << 24)

__device__ __forceinline__ unsigned xb_ld(unsigned* p)              { return __hip_atomic_load(p, __ATOMIC_RELAXED, __HIP_MEMORY_SCOPE_AGENT); }
__device__ __forceinline__ unsigned xb_add(unsigned* p, unsigned v) { return __hip_atomic_fetch_add(p, v, __ATOMIC_RELAXED, __HIP_MEMORY_SCOPE_AGENT); }
__device__ __forceinline__ unsigned xb_xcc_id() { return (unsigned)__builtin_amdgcn_s_getreg((3 << 11) | 20) & 0xFu; }
#define XB_SPIN(cond, bar) do { unsigned _sp = 0; while (cond) { __builtin_amdgcn_s_sleep(1); \
    if ((++_sp & 255u) == 0u) { if (xb_ld(&(bar)[XB_TMO])) break; if (_sp > XB_SPIN_CAP) { atomicAdd(&(bar)[XB_TMO], 1u); break; } } } } while (0)

struct XcdBarrier { unsigned* bar; unsigned x; volatile LAS unsigned* st; };

__device__ __forceinline__ XcdBarrier xcd_barrier_post(unsigned* bar, volatile LAS unsigned* st) {
    XcdBarrier b; b.bar = bar; b.x = xb_xcc_id(); b.st = st;
    if (threadIdx.x == 0) (void)xb_add(&bar[XB_XCNT(b.x)], 1u);
    return b;
}
__device__ __forceinline__ void xcd_barrier_complete(unsigned* bar, unsigned x, unsigned& nloc, unsigned& nx) {
    const unsigned G = gridDim.x * gridDim.y * gridDim.z;
    unsigned sum, cnt, mine, sp = 0u;
    for (;;) {
        sum = 0u; cnt = 0u; mine = 0u;
#pragma unroll
        for (unsigned j = 0; j < 16; ++j) { const unsigned c = xb_ld(&bar[XB_XCNT(j)]); sum += c; cnt += (c > 0u) ? 1u : 0u; mine = (j == x) ? c : mine; }
        if (sum == G) break;
        __builtin_amdgcn_s_sleep(1);
        if ((++sp & 255u) == 0u) { if (xb_ld(&bar[XB_TMO])) break; if (sp > XB_SPIN_CAP) { atomicAdd(&bar[XB_TMO], 1u); break; } }
    }
    nloc = mine > 0u ? mine : 1u; nx = cnt > 0u ? cnt : 1u;
}
__device__ __forceinline__ void xcd_barrier(const XcdBarrier& b) {
    asm volatile("s_waitcnt vmcnt(0)" ::: "memory");
    __syncthreads();
    if (threadIdx.x == 0) {
        unsigned* bar = b.bar;
        __builtin_amdgcn_s_waitcnt(0);
        unsigned nloc = b.st[0], nx = b.st[1];
        if (nloc == 0u) { xcd_barrier_complete(bar, b.x, nloc, nx); b.st[0] = nloc; b.st[1] = nx; }
        const unsigned old = xb_add(&bar[XB_XSUB(b.x)], 1u);
        const unsigned gen = old / nloc;
        if (old + 1u == (gen + 1u) * nloc) {
            __builtin_amdgcn_fence(__ATOMIC_RELEASE, "agent");
            asm volatile("s_waitcnt vmcnt(0)" ::: "memory");
            const unsigned og = xb_add(&bar[XB_TOP], 1u);
            const unsigned tg = og / nx;
            if (og + 1u == (tg + 1u) * nx) xb_add(&bar[XB_TOPGEN], 1u);
            else XB_SPIN(xb_ld(&bar[XB_TOPGEN]) == tg, bar);
            __builtin_amdgcn_fence(__ATOMIC_ACQUIRE, "agent");
            xb_add(&bar[XB_XGEN(b.x)], 1u);
            asm volatile("s_waitcnt vmcnt(0)" ::: "memory");
        } else {
            XB_SPIN(xb_ld(&bar[XB_XGEN(b.x)]) == gen, bar);
            __builtin_amdgcn_fence(__ATOMIC_ACQUIRE, "agent");
            asm volatile("s_waitcnt vmcnt(0)" ::: "memory");
        }
    }
    __syncthreads();
}

namespace pg8 {
constexpr int BM = 256, BK = 64, HALF = 128, HTB = HALF * BK * 2, STAGE_BYTES = 8 * HTB, NXCD = 8, WGM = 4;
__host__ __device__ __forceinline__ int lds_byte(int r, int c) { const int st = (r >> 4) * 2 + (c >> 5), rr = r & 15, cc = c & 31, ob = rr * 64 + cc * 2; return st * 1024 + (ob ^ (((ob >> 9) & 1) << 5)); }
__host__ __device__ __forceinline__ void stage_rc(int b, int& R, int& C) { const int st = b / 1024, sb = b % 1024, swz = sb ^ (((sb >> 9) & 1) << 5); R = (st >> 1) * 16 + swz / 64; C = (st & 1) * 32 + (swz % 64) / 2; }
__host__ __device__ __forceinline__ int perm32(int rho) { const int n = rho >> 4, i = rho & 15; return 8 * (i >> 2) + 4 * n + (i & 3); }

struct Unit { int pm, pn; };
struct Gemm { const bf16_t* A; const bf16_t* Bt; int M, N, K, lda; };

struct StaticOrder {
    int nM, nN, nwg, G, c;
    __host__ __device__ void init(int M_, int N_, int G_, int c_) { nM = M_ / BM; nN = N_ / BM; nwg = nM * nN; G = G_; c = c_; }
    __host__ __device__ bool next(int i, Unit& u) const {
        const long L = (long)i * G + c; if (L >= nwg) return false;
        int wgid = (int)L; { const int q = nwg / NXCD, r = nwg % NXCD, xcd = wgid % NXCD, off = wgid / NXCD; wgid = (xcd < r ? xcd * (q + 1) : r * (q + 1) + (xcd - r) * q) + off; }
        const int nig = WGM * nN, gid = wgid / nig, fm = gid * WGM, gsz = (nM - fm) < WGM ? (nM - fm) : WGM;
        u.pm = fm + ((wgid % nig) % gsz); u.pn = (wgid % nig) / gsz; return true;
    }
    __device__ __forceinline__ void a_ready(const Unit&) const {}
    __device__ __forceinline__ void done(const Unit&) const {}
};

constexpr int L_RSPF = 131072 + 4096;
__device__ __forceinline__ void rs_prefetch(const float* rs, int pm, int ui) {
    const int t = opaque_tid(), w = __builtin_amdgcn_readfirstlane(t >> 6);
    extern __shared__ __attribute__((aligned(16))) unsigned char lds_dyn_[];
    if (w < 4) __builtin_amdgcn_global_load_lds((const unsigned*)(rs + pm * BM + t), (LAS unsigned*)((LAS unsigned char*)lds_dyn_ + L_RSPF + (ui & 1) * 1024 + w * 256), 4, 0, 0);
}
__device__ __forceinline__ void rs_read(float (&r_)[2][4], int ui, int wr, int fr) {
    extern __shared__ __attribute__((aligned(16))) unsigned char lds_dyn_[];
    const LAS float* rl = (const LAS float*)((LAS unsigned char*)lds_dyn_ + L_RSPF + (ui & 1) * 1024) + wr * 64 + fr;
#pragma unroll
    for (int ai = 0; ai < 2; ++ai)
#pragma unroll
        for (int m = 0; m < 4; ++m) r_[ai][m] = rl[ai * HALF + m * 16];
}
struct EpiStoreBf16 {
    static constexpr bool PERM = true;
    bf16_t* O; int ldc; const float* rs;
    __device__ __forceinline__ void prefetch(const Unit& u, int ui) const { if (rs) rs_prefetch(rs, u.pm, ui); }
    __device__ __forceinline__ void operator()(const f32x4 (&acc)[2][2][4][2], const Unit& u, int wr, int wc, int ui, int) const {
        const int ol_ = opaque_tid() & 63, fr = ol_ & 15, fq = ol_ >> 4;
        const int row0 = u.pm * BM + wr * 64 + fr, col0 = u.pn * BM + wc * 32 + 8 * fq;
        float r_[2][4];
        if (rs) rs_read(r_, ui, wr, fr);
        else {
#pragma unroll
            for (int ai = 0; ai < 2; ++ai)
#pragma unroll
                for (int m = 0; m < 4; ++m) r_[ai][m] = 1.f;
        }
#pragma unroll
        for (int ai = 0; ai < 2; ++ai)
#pragma unroll
            for (int m = 0; m < 4; ++m) { bf16_t* rowp = O + (size_t)(row0 + ai * HALF + m * 16) * ldc + col0; const float r = r_[ai][m];
#pragma unroll
                for (int bj = 0; bj < 2; ++bj) { const f32x4 v0 = acc[ai][bj][m][0] * r, v1 = acc[ai][bj][m][1] * r;
                    u32x4 w; w.x = cvt_pk_bf16(v0[0], v0[1]); w.y = cvt_pk_bf16(v0[2], v0[3]); w.z = cvt_pk_bf16(v1[0], v1[1]); w.w = cvt_pk_bf16(v1[2], v1[3]);
                    *(u32x4*)(rowp + bj * HALF) = w; } }
    }
};
struct EpiAddRes {
    static constexpr bool PERM = true;
    bf16_t* C; int ldc;
    __device__ __forceinline__ void prefetch(const Unit&, int) const {}
    __device__ __forceinline__ void operator()(const f32x4 (&acc)[2][2][4][2], const Unit& u, int wr, int wc, int, int) const {
        const int ol_ = opaque_tid() & 63, fr = ol_ & 15, fq = ol_ >> 4;
        const int row0 = u.pm * BM + wr * 64 + fr, col0 = u.pn * BM + wc * 32 + 8 * fq;
        u32x4 cin[2][4][2];
#pragma unroll
        for (int ai = 0; ai < 2; ++ai)
#pragma unroll
            for (int m = 0; m < 4; ++m)
#pragma unroll
                for (int bj = 0; bj < 2; ++bj) cin[ai][m][bj] = *(const u32x4*)(C + (size_t)(row0 + ai * HALF + m * 16) * ldc + col0 + bj * HALF);
#pragma unroll
        for (int ai = 0; ai < 2; ++ai)
#pragma unroll
            for (int m = 0; m < 4; ++m)
#pragma unroll
                for (int bj = 0; bj < 2; ++bj) { const u32x4 c = cin[ai][m][bj]; const f32x4 v0 = acc[ai][bj][m][0], v1 = acc[ai][bj][m][1];
                    u32x4 w; w.x = cvt_pk_bf16(bflo(c.x) + v0[0], bfhi(c.x) + v0[1]); w.y = cvt_pk_bf16(bflo(c.y) + v0[2], bfhi(c.y) + v0[3]);
                    w.z = cvt_pk_bf16(bflo(c.z) + v1[0], bfhi(c.z) + v1[1]); w.w = cvt_pk_bf16(bflo(c.w) + v1[2], bfhi(c.w) + v1[3]);
                    *(u32x4*)(C + (size_t)(row0 + ai * HALF + m * 16) * ldc + col0 + bj * HALF) = w; }
    }
};
struct EpiFfnGate {
    static constexpr bool PERM = true;
    bf16_t* act; const float* cw; const float* cb; float* tail; float* headg; float* headu; LAS unsigned char* hl; const float* rs;
    __device__ __forceinline__ void prefetch(const Unit& u, int ui) const { rs_prefetch(rs, u.pm, ui); }
    __device__ __forceinline__ void operator()(f32x4 (&acc)[2][2][4][2], const Unit& u, int wr, int wc, int ui, int) const {
        const int ol_ = opaque_tid() & 63, fr = ol_ & 15, fq = ol_ >> 4;
        { float r_[2][4];
          rs_read(r_, ui, wr, fr);
#pragma unroll
          for (int ai = 0; ai < 2; ++ai)
#pragma unroll
              for (int bj = 0; bj < 2; ++bj)
#pragma unroll
                  for (int m = 0; m < 4; ++m) { acc[ai][bj][m][0] *= r_[ai][m]; acc[ai][bj][m][1] *= r_[ai][m]; } }
        const int col = u.pn * 128 + wc * 32 + 8 * fq;
        if (fr >= 14) {
#pragma unroll
            for (int ai = 0; ai < 2; ++ai) { LAS f32x4* s = (LAS f32x4*)(hl + ((((ai * 2 + wr) * 4 + wc) * 8 + fq * 2 + (fr - 14)) * 32));
                s[0] = acc[ai][1][3][0]; s[1] = acc[ai][1][3][1]; }
        }
        asm volatile("s_waitcnt lgkmcnt(0)" ::: "memory"); __builtin_amdgcn_s_barrier(); asm volatile("" ::: "memory");
        __builtin_amdgcn_s_barrier(); asm volatile("" ::: "memory");
        float w0[8], w1[8], w2[8], bb[8];
        { const f32x4 a0 = *(const f32x4*)(cw + col), a1 = *(const f32x4*)(cw + col + 4), b0 = *(const f32x4*)(cw + FF + col), b1 = *(const f32x4*)(cw + FF + col + 4),
                      c0 = *(const f32x4*)(cw + 2 * FF + col), c1 = *(const f32x4*)(cw + 2 * FF + col + 4), d0 = *(const f32x4*)(cb + col), d1 = *(const f32x4*)(cb + col + 4);
#pragma unroll
          for (int e = 0; e < 4; ++e) { w0[e] = a0[e] * -LOG2E; w0[4 + e] = a1[e] * -LOG2E; w1[e] = b0[e] * -LOG2E; w1[4 + e] = b1[e] * -LOG2E; w2[e] = c0[e] * -LOG2E; w2[4 + e] = c1[e] * -LOG2E; bb[e] = d0[e] * -LOG2E; bb[4 + e] = d1[e] * -LOG2E; } }
#pragma unroll
        for (int ai = 0; ai < 2; ++ai) {
            f32x4 hal[2] = {(f32x4){0.f, 0.f, 0.f, 0.f}, (f32x4){0.f, 0.f, 0.f, 0.f}};
            if (!(ai == 0 && wr == 0) && fr >= 14) {
                const int sai = (wr == 1) ? ai : 0, swr = (wr == 1) ? 0 : 1;
                const LAS f32x4* s = (const LAS f32x4*)(hl + ((((sai * 2 + swr) * 4 + wc) * 8 + fq * 2 + (fr - 14)) * 32));
                hal[0] = s[0]; hal[1] = s[1];
            }
#pragma unroll
            for (int m = 0; m < 4; ++m) {
                const int row = u.pm * BM + ai * HALF + wr * 64 + m * 16 + fr;
                float o[8], z[8], g1[8], g2[8];
#pragma unroll
                for (int k = 0; k < 8; ++k) { const int n = k >> 2, e = k & 3;
                    const float gc = acc[ai][1][m][n][e], gp = (m == 0) ? hal[n][e] : acc[ai][1][m - 1][n][e];
                    const int gci = __builtin_bit_cast(int, gc), gpi = __builtin_bit_cast(int, gp);
                    const int r1 = __builtin_amdgcn_update_dpp(0, gpi, 0x121, 0xf, 0xf, true), r2 = __builtin_amdgcn_update_dpp(0, gpi, 0x122, 0xf, 0xf, true);
                    g1[k] = __builtin_bit_cast(float, __builtin_amdgcn_update_dpp(r1, gci, 0x111, 0xf, 0xf, false));
                    g2[k] = __builtin_bit_cast(float, __builtin_amdgcn_update_dpp(r2, gci, 0x112, 0xf, 0xf, false)); }
#pragma unroll
                for (int k = 0; k < 8; ++k) z[k] = w0[k] * g2[k] + bb[k];
#pragma unroll
                for (int k = 0; k < 8; ++k) z[k] += w1[k] * g1[k];
#pragma unroll
                for (int k = 0; k < 8; ++k) z[k] += w2[k] * acc[ai][1][m][k >> 2][k & 3];
#pragma unroll
                for (int k = 0; k < 8; ++k) o[k] = __builtin_amdgcn_exp2f(z[k]);
#pragma unroll
                for (int k = 0; k < 8; ++k) o[k] += 1.f;
#pragma unroll
                for (int k = 0; k < 8; ++k) o[k] = __builtin_amdgcn_rcpf(o[k]);
#pragma unroll
                for (int k = 0; k < 8; ++k) z[k] *= acc[ai][0][m][k >> 2][k & 3];
#pragma unroll
                for (int k = 0; k < 8; ++k) o[k] *= z[k];
                u32x4 w; w.x = cvt_pk_bf16(o[0], o[1]); w.y = cvt_pk_bf16(o[2], o[3]); w.z = cvt_pk_bf16(o[4], o[5]); w.w = cvt_pk_bf16(o[6], o[7]);
                *(u32x4*)(act + (size_t)row * FF + col) = w;
            }
        }
        if (wr == 1 && fr >= 14) { float* t = tail + ((size_t)u.pm * 2 + (fr - 14)) * FF + col; *(f32x4*)t = acc[1][1][3][0]; *(f32x4*)(t + 4) = acc[1][1][3][1]; }
        if (wr == 0 && fr < 2) { float* hg = headg + ((size_t)u.pm * 2 + fr) * FF + col; *(f32x4*)hg = acc[0][1][0][0]; *(f32x4*)(hg + 4) = acc[0][1][0][1];
                                 float* hu = headu + ((size_t)u.pm * 2 + fr) * FF + col; *(f32x4*)hu = acc[0][0][0][0]; *(f32x4*)(hu + 4) = acc[0][0][0][1]; }
    }
};

template <class Epi, class Sched>
__device__ __forceinline__ void gemm_phase(LAS unsigned char* lds, const Gemm g, const Sched& S, const Epi& E) {
    const int tid = opaque_tid(), wid = __builtin_amdgcn_readfirstlane(tid >> 6), lane = tid & 63, wr = wid >> 2, wc = wid & 3, fr = lane & 15, fq = lane >> 4;
    const int K = g.K, nt = K / BK, lda = g.lda;
    unsigned voffA[2], voffB[2];
#pragma unroll
    for (int i = 0; i < 2; ++i) { int R, C; stage_rc(tid * 16 + i * 8192, R, C); const int Rb = Epi::PERM ? ((R & ~31) + perm32(R & 31)) : R;
        voffA[i] = (unsigned)(R * lda + C) * 2u; voffB[i] = (unsigned)(Rb * K + C) * 2u; }
    const size_t kstep = (size_t)(BK * 2);
    const size_t hstepA = (size_t)HALF * lda * 2, hstepB = (size_t)HALF * K * 2;
    const size_t tstepA = 2 * hstepA, tstepB = 2 * hstepB;
    const unsigned ldsw = (unsigned)wid * 1024u;
    const int aoff = lds_byte(wr * 64 + fr, fq * 8), boff = lds_byte(wc * 32 + fr, fq * 8);
#define PG8_SA(b, h) (((b) * 2 + (h)) * HTB)
#define PG8_SB(b, h) ((4 + (b) * 2 + (h)) * HTB)
#define PG8_STAGE(bufoff, gbase, voff) do { _Pragma("unroll") for (int _i = 0; _i < 2; ++_i) \
        __builtin_amdgcn_global_load_lds((const unsigned*)((const char*)(gbase) + (voff)[_i]), (LAS unsigned*)(lds + (bufoff) + ldsw + _i * 8192), 16, 0, 0); } while (0)
#define PG8_LDA(dst, b, h) do { _Pragma("unroll") for (int m = 0; m < 4; ++m) _Pragma("unroll") for (int k = 0; k < 2; ++k) dst[m][k] = *(const LAS bf16x8*)(lds + PG8_SA(b, h) + aoff + m * 2048 + k * 1024); } while (0)
#define PG8_LDB(dst, b, h) do { _Pragma("unroll") for (int n = 0; n < 2; ++n) _Pragma("unroll") for (int k = 0; k < 2; ++k) dst[n][k] = *(const LAS bf16x8*)(lds + PG8_SB(b, h) + boff + n * 2048 + k * 1024); } while (0)
#define PG8_MMA(ai, bj, At, Bt) do { __builtin_amdgcn_s_setprio(1); _Pragma("unroll") for (int m = 0; m < 4; ++m) _Pragma("unroll") for (int n = 0; n < 2; ++n) _Pragma("unroll") for (int k = 0; k < 2; ++k) \
        acc[ai][bj][m][n] = __builtin_amdgcn_mfma_f32_16x16x32_bf16(Bt[n][k], At[m][k], acc[ai][bj][m][n], 0, 0, 0); __builtin_amdgcn_s_setprio(0); } while (0)
#define PG8_WAIT_V(n) asm volatile("s_waitcnt vmcnt(" #n ")" ::: "memory")
#define PG8_WAIT_L(n) asm volatile("s_waitcnt lgkmcnt(" #n ")" ::: "memory")
#define PG8_BAR __builtin_amdgcn_s_barrier()
#define PG8_SCHED __builtin_amdgcn_sched_barrier(0)
    Unit cur, nxt; int ui = 0;
    if (!S.next(0, cur)) return;
    f32x4 acc[2][2][4][2];
#pragma unroll
    for (int a = 0; a < 2; ++a)
#pragma unroll
        for (int b = 0; b < 2; ++b)
#pragma unroll
            for (int m = 0; m < 4; ++m)
#pragma unroll
                for (int n = 0; n < 2; ++n) acc[a][b][m][n] = (f32x4){0.f, 0.f, 0.f, 0.f};
    bf16x8 At[4][2], B0[2][2], B1[2][2];
    const char* cA = (const char*)g.A + (size_t)cur.pm * tstepA; const char* cB = (const char*)g.Bt + (size_t)cur.pn * tstepB;
    S.a_ready(cur);
    PG8_STAGE(PG8_SB(0, 0), cB, voffB); PG8_STAGE(PG8_SA(0, 0), cA, voffA); PG8_STAGE(PG8_SB(0, 1), cB + hstepB, voffB); PG8_STAGE(PG8_SA(0, 1), cA + hstepA, voffA);
    if (wr == 1) PG8_BAR;
    PG8_WAIT_V(4); PG8_BAR;
    PG8_STAGE(PG8_SB(1, 0), cB + kstep, voffB); PG8_STAGE(PG8_SA(1, 0), cA + kstep, voffA); PG8_STAGE(PG8_SB(1, 1), cB + hstepB + kstep, voffB);
    PG8_WAIT_V(6); PG8_BAR;
    for (;;) {
        E.prefetch(cur, ui);
        const bool has_next = S.next(ui + 1, nxt);
        const char* nA = has_next ? (const char*)g.A + (size_t)nxt.pm * tstepA : cA; const char* nB = has_next ? (const char*)g.Bt + (size_t)nxt.pn * tstepB : cB;
        for (int t = 0; t < nt; t += 2) {
            const bool last = (t == nt - 2);
            const char* a1 = cA + (size_t)(t + 1) * kstep;
            const char* a2 = last ? nA : cA + (size_t)(t + 2) * kstep; const char* b2 = last ? nB : cB + (size_t)(t + 2) * kstep;
            const char* a3 = a2 + kstep; const char* b3 = b2 + kstep;
            if (last && has_next) S.a_ready(nxt);
            PG8_LDB(B0, 0, 0); PG8_SCHED; PG8_LDA(At, 0, 0); PG8_STAGE(PG8_SA(1, 1), a1 + hstepA, voffA);
            PG8_WAIT_L(8); PG8_BAR; PG8_WAIT_L(0); PG8_MMA(0, 0, At, B0); PG8_BAR; PG8_SCHED;
            PG8_LDB(B1, 0, 1); PG8_STAGE(PG8_SB(0, 0), b2, voffB);
            PG8_BAR; PG8_WAIT_L(0); PG8_MMA(0, 1, At, B1); PG8_BAR;
            PG8_LDA(At, 0, 1); PG8_STAGE(PG8_SA(0, 0), a2, voffA);
            PG8_BAR; PG8_WAIT_L(0); PG8_MMA(1, 0, At, B0); PG8_BAR; PG8_SCHED;
            PG8_STAGE(PG8_SB(0, 1), b2 + hstepB, voffB);
            PG8_WAIT_V(6); PG8_BAR; PG8_MMA(1, 1, At, B1); PG8_BAR;
            PG8_LDB(B0, 1, 0); PG8_SCHED; PG8_LDA(At, 1, 0); PG8_STAGE(PG8_SA(0, 1), a2 + hstepA, voffA);
            PG8_WAIT_L(8); PG8_BAR; PG8_WAIT_L(0); PG8_MMA(0, 0, At, B0); PG8_BAR; PG8_SCHED;
            PG8_LDB(B1, 1, 1); PG8_STAGE(PG8_SB(1, 0), b3, voffB);
            PG8_BAR; PG8_WAIT_L(0); PG8_MMA(0, 1, At, B1); PG8_BAR;
            PG8_LDA(At, 1, 1); PG8_STAGE(PG8_SA(1, 0), a3, voffA);
            PG8_BAR; PG8_WAIT_L(0); PG8_MMA(1, 0, At, B0); PG8_BAR; PG8_SCHED;
            PG8_STAGE(PG8_SB(1, 1), b3 + hstepB, voffB);
            PG8_WAIT_V(6); PG8_BAR; PG8_MMA(1, 1, At, B1); PG8_BAR;
        }
        E(acc, cur, wr, wc, ui, fq);
        S.done(cur);
        if (!has_next) break;
#pragma unroll
        for (int a = 0; a < 2; ++a)
#pragma unroll
            for (int b = 0; b < 2; ++b)
#pragma unroll
                for (int m = 0; m < 4; ++m)
#pragma unroll
                    for (int n = 0; n < 2; ++n) acc[a][b][m][n] = (f32x4){0.f, 0.f, 0.f, 0.f};
        cur = nxt; cA = nA; cB = nB; ++ui;
    }
    PG8_WAIT_V(0);
    if (wr == 0) PG8_BAR;
    PG8_BAR;
#undef PG8_SA
#undef PG8_SB
#undef PG8_STAGE
#undef PG8_LDA
#undef PG8_LDB
#undef PG8_MMA
#undef PG8_WAIT_V
#undef PG8_WAIT_L
#undef PG8_BAR
#undef PG8_SCHED
}
}
struct Frame {
    LAS unsigned char* lds; int G, bid;
    const float* const* in; float* out; unsigned char* ws; unsigned* ctl;
};
#define TID (opaque_tid())
#define LANE (opaque_tid() & 63)
#define WAVE (__builtin_amdgcn_readfirstlane(opaque_tid() >> 6))
enum { I_X = 0, I_RELB, I_NMIX, I_NFFN, I_NFIN, I_EV_WIN, I_EV_BF, I_EV_SINK, I_EV_WOUT, I_OD_WIN, I_OD_CPOS, I_OD_CW1, I_OD_CW2, I_OD_CONVW, I_OD_ALOG, I_OD_DTB,
       I_OD_GNORM, I_OD_WOUT, I_F_WUP, I_F_CONVW, I_F_CONVB, I_F_WDN };

template <int MAP>
__device__ __forceinline__ int cvt_map(int n, int srcN) {
    if (MAP == 0) return (n < srcN) ? n : -1;
    if (MAP == 1) return ev_src(n);
    if (MAP == 2) return od_src(n);
    return ((n & 255) < 128) ? (n >> 8) * 128 + (n & 127) : FF + (n >> 8) * 128 + (n & 127);
}
template <int MAP>
__device__ __forceinline__ void cvt_load(f32x4 (&v)[8], const float* __restrict__ src, int srcN, const float* __restrict__ gain, int k0, int n0, int tid) {
    const int n4 = (tid & 31) * 4, s = cvt_map<MAP>(n0 + n4, srcN);
    const int sc = s >= 0 ? s : 0;
    const float keep = (MAP == 3) ? ((((n0 + n4) & 255) < 128) ? -0.6931471805599453f : 1.f) : (s >= 0 ? 1.f : 0.f);
    float gv[8];
#pragma unroll
    for (int e = 0; e < 8; ++e) { const int kk = e * 16 + (tid >> 5);
        v[e] = *(const f32x4*)(src + (size_t)(k0 + kk) * srcN + sc);
        gv[e] = gain ? gain[k0 + kk] : 1.f; }
#pragma unroll
    for (int e = 0; e < 8; ++e) v[e] *= gv[e] * keep;
}
template <int MAP>
__device__ __forceinline__ void cvt_transpose(const Frame& F, const float* __restrict__ src, int srcN, int K, int Npad, const float* __restrict__ gain, bf16_t* __restrict__ dst) {
    LAS float* tile = (LAS float*)F.lds;
    const int tid = TID, tk = K / 128, tn = Npad / 128, ntile = tk * tn;
    int t = F.bid;
    f32x4 v[8];
    if (t < ntile) cvt_load<MAP>(v, src, srcN, gain, (t % tk) * 128, (t / tk) * 128, tid);
    for (; t < ntile; t += F.G) {
        const int k0 = (t % tk) * 128, n0 = (t / tk) * 128;
        __syncthreads();
#pragma unroll
        for (int e = 0; e < 8; ++e) *(LAS f32x4*)(tile + (e * 16 + (tid >> 5)) * 132 + (tid & 31) * 4) = v[e];
        __syncthreads();
        const int tnx = t + F.G;
        if (tnx < ntile) cvt_load<MAP>(v, src, srcN, gain, (tnx % tk) * 128, (tnx / tk) * 128, tid);
        { const int nn = tid & 127, kq = (tid >> 7) * 32;
          bf16_t* d = dst + (size_t)(n0 + nn) * K + k0 + kq;
#pragma unroll
          for (int q = 0; q < 4; ++q) { float x[8];
#pragma unroll
              for (int i = 0; i < 8; ++i) x[i] = tile[(kq + q * 8 + i) * 132 + nn];
              u32x4 w; w.x = cvt_pk_bf16(x[0], x[1]); w.y = cvt_pk_bf16(x[2], x[3]); w.z = cvt_pk_bf16(x[4], x[5]); w.w = cvt_pk_bf16(x[6], x[7]);
              *(u32x4*)(d + q * 8) = w; } }
    }
    __syncthreads();
}

__device__ __forceinline__ void rownorm_phase(const Frame& F, const float* __restrict__ src, bf16_t* __restrict__ cpy, float* __restrict__ rstd_out) {
    for (int row = F.bid * NWAVE + WAVE; row < M; row += F.G * NWAVE) {
        const float* p = src + (size_t)row * D + LANE * 4;
        f32x4 v[8]; float ss = 0.f;
        u32x2 c[8];
#pragma unroll
        for (int i = 0; i < 8; ++i) { v[i] = *(const f32x4*)(p + i * 256); c[i].x = cvt_pk_bf16(v[i][0], v[i][1]); c[i].y = cvt_pk_bf16(v[i][2], v[i][3]);
            ss += bflo(c[i].x) * bflo(c[i].x) + bfhi(c[i].x) * bfhi(c[i].x) + bflo(c[i].y) * bflo(c[i].y) + bfhi(c[i].y) * bfhi(c[i].y); }
        ss = wave_sum(ss);
        if (LANE == 0) rstd_out[row] = rsqrtf(ss * (1.f / D) + EPS);
#pragma unroll
        for (int i = 0; i < 8; ++i) *(u32x2*)(cpy + (size_t)row * D + LANE * 4 + i * 256) = c[i];
    }
}
__device__ __forceinline__ void rowstat_phase(const Frame& F, const bf16_t* __restrict__ res, float* __restrict__ rstd_out) {
    for (int row0 = (F.bid * NWAVE + WAVE) * 4; row0 < M; row0 += F.G * NWAVE * 4) {
        u32x4 v[4][4];
#pragma unroll
        for (int r = 0; r < 4; ++r)
#pragma unroll
            for (int i = 0; i < 4; ++i) v[r][i] = *(const u32x4*)(res + (size_t)(row0 + r) * D + LANE * 8 + i * 512);
        float ss[4];
#pragma unroll
        for (int r = 0; r < 4; ++r) { ss[r] = 0.f;
#pragma unroll
            for (int i = 0; i < 4; ++i) { const u32x4 x = v[r][i];
                ss[r] += bflo(x.x) * bflo(x.x) + bfhi(x.x) * bfhi(x.x) + bflo(x.y) * bflo(x.y) + bfhi(x.y) * bfhi(x.y) + bflo(x.z) * bflo(x.z) + bfhi(x.z) * bfhi(x.z) + bflo(x.w) * bflo(x.w) + bfhi(x.w) * bfhi(x.w); }
            ss[r] = wave_sum(ss[r]); }
        if (LANE < 4) rstd_out[row0 + LANE] = rsqrtf((LANE == 0 ? ss[0] : LANE == 1 ? ss[1] : LANE == 2 ? ss[2] : ss[3]) * (1.f / D) + EPS);
    }
}
__device__ __forceinline__ void rowstat_f_phase(const Frame& F, const bf16_t* __restrict__ res, float* __restrict__ rstd_out, const bf16_t* __restrict__ wf  , bf16_t* __restrict__ proj) {
    LAS unsigned char* lds = F.lds;
    __syncthreads();
    for (int i = TID; i < 8 * D / 8; i += NTHR) *(LAS u32x4*)(lds + i * 16) = *(const u32x4*)(wf + (size_t)i * 8);
    __syncthreads();
    const int l = LANE, r = l & 15, kq = l >> 4;
    for (int blk = F.bid * NWAVE + WAVE; blk < M / 16; blk += F.G * NWAVE) {
        const bf16_t* rowp = res + (size_t)(blk * 16 + r) * D + kq * 8;
        f32x4 acc = {0.f, 0.f, 0.f, 0.f}; float ss = 0.f;
#pragma unroll 1
        for (int s0 = 0; s0 < 64; s0 += 32) {
            u32x4 a[32];
#pragma unroll
            for (int s = 0; s < 32; ++s) a[s] = *(const u32x4*)(rowp + (s0 + s) * 32);
#pragma unroll
            for (int s = 0; s < 32; ++s) { const u32x4 x = a[s];
                ss += bflo(x.x) * bflo(x.x) + bfhi(x.x) * bfhi(x.x) + bflo(x.y) * bflo(x.y) + bfhi(x.y) * bfhi(x.y) + bflo(x.z) * bflo(x.z) + bfhi(x.z) * bfhi(x.z) + bflo(x.w) * bflo(x.w) + bfhi(x.w) * bfhi(x.w);
                u32x4 b = *(const LAS u32x4*)(lds + (r & 7) * 4096 + ((s0 + s) * 32 + kq * 8) * 2);
                if (r >= 8) b = (u32x4){0u, 0u, 0u, 0u};
                u32x4 xa = x;
                acc = __builtin_amdgcn_mfma_f32_16x16x32_bf16(*reinterpret_cast<bf16x8*>(&xa), *reinterpret_cast<bf16x8*>(&b), acc, 0, 0, 0); }
        }
        ss += shx(ss, 16); ss += shx(ss, 32);
        const float rstd = rsqrtf(ss * (1.f / D) + EPS);
        if (kq == 0) rstd_out[blk * 16 + r] = rstd;
#pragma unroll
        for (int reg = 0; reg < 4; ++reg) { const float rr = __builtin_bit_cast(float, __builtin_amdgcn_ds_bpermute((4 * kq + reg) << 2, __builtin_bit_cast(int, rstd)));
            if (r < 8) proj[(size_t)(blk * 16 + 4 * kq + reg) * EV_NP + EC_F + r] = f2bf(acc[reg] * rr); }
    }
    __syncthreads();
}
__device__ __forceinline__ void final_norm_phase(const Frame& F, const bf16_t* __restrict__ res, float* __restrict__ out, const float* __restrict__ g) {
    for (int row0 = (F.bid * NWAVE + WAVE) * 2; row0 < M; row0 += F.G * NWAVE * 2) {
        u32x4 v[2][4];
#pragma unroll
        for (int r = 0; r < 2; ++r)
#pragma unroll
            for (int i = 0; i < 4; ++i) v[r][i] = *(const u32x4*)(res + (size_t)(row0 + r) * D + LANE * 8 + i * 512);
#pragma unroll
        for (int r = 0; r < 2; ++r) {
            float ss = 0.f;
#pragma unroll
            for (int i = 0; i < 4; ++i) { const u32x4 x = v[r][i];
                ss += bflo(x.x) * bflo(x.x) + bfhi(x.x) * bfhi(x.x) + bflo(x.y) * bflo(x.y) + bfhi(x.y) * bfhi(x.y) + bflo(x.z) * bflo(x.z) + bfhi(x.z) * bfhi(x.z) + bflo(x.w) * bflo(x.w) + bfhi(x.w) * bfhi(x.w); }
            ss = wave_sum(ss);
            const float rstd = rsqrtf(ss * (1.f / D) + EPS);
#pragma unroll
            for (int i = 0; i < 4; ++i) { const u32x4 x = v[r][i];
                const f32x4 g0 = *(const f32x4*)(g + LANE * 8 + i * 512), g1 = *(const f32x4*)(g + LANE * 8 + i * 512 + 4);
                float* o = out + (size_t)(row0 + r) * D + LANE * 8 + i * 512;
                *(f32x4*)o = (f32x4){bflo(x.x), bfhi(x.x), bflo(x.y), bfhi(x.y)} * rstd * g0;
                *(f32x4*)(o + 4) = (f32x4){bflo(x.z), bfhi(x.z), bflo(x.w), bfhi(x.w)} * rstd * g1; }
        }
    }
}

__device__ __forceinline__ void ffn_fixup_phase(const Frame& F, bf16_t* __restrict__ act, const float* __restrict__ tail, const float* __restrict__ headg, const float* __restrict__ headu,
                                                const float* __restrict__ cw, const float* __restrict__ cb) {
    constexpr int C4 = FF / 4, NPM = M / 256;
    for (int idx = F.bid * NTHR + TID; idx < NPM * 2 * C4; idx += F.G * NTHR) {
        const int c = (idx % C4) * 4, r = (idx / C4) & 1, pm = idx / (2 * C4);
        if ((pm & 15) == 0) continue;
        const f32x4 t0 = *(const f32x4*)(tail + ((size_t)(pm - 1) * 2 + 0) * FF + c), t1 = *(const f32x4*)(tail + ((size_t)(pm - 1) * 2 + 1) * FF + c);
        const f32x4 h0 = *(const f32x4*)(headg + ((size_t)pm * 2 + 0) * FF + c), h1 = *(const f32x4*)(headg + ((size_t)pm * 2 + 1) * FF + c);
        const f32x4 uu = *(const f32x4*)(headu + ((size_t)pm * 2 + r) * FF + c);
        const f32x4 gm2 = r == 0 ? t0 : t1, gm1 = r == 0 ? t1 : h0, g0 = r == 0 ? h0 : h1;
        const f32x4 w0 = *(const f32x4*)(cw + c), w1 = *(const f32x4*)(cw + FF + c), w2 = *(const f32x4*)(cw + 2 * FF + c), bb = *(const f32x4*)(cb + c);
        float o[4];
#pragma unroll
        for (int e = 0; e < 4; ++e) { const float z = w0[e] * gm2[e] + w1[e] * gm1[e] + w2[e] * g0[e] + bb[e]; o[e] = siluf_(z) * (uu[e] * -LOG2E); }
        u32x2 w; w.x = cvt_pk_bf16(o[0], o[1]); w.y = cvt_pk_bf16(o[2], o[3]);
        *(u32x2*)(act + (size_t)(pm * 256 + r) * FF + c) = w;
    }
}

__device__ __forceinline__ void p0_prologue(const Frame& F) {
    unsigned char* ws = F.ws;
    for (int j = 0; j < 2; ++j) {
        cvt_transpose<1>(F, F.in[I_EV_WIN] + (size_t)j * D * EV_N, EV_N, D, EV_NP, F.in[I_NMIX] + (size_t)(2 * j) * D, (bf16_t*)(ws + WS_W_EV_IN + j * SZ_W_EV_IN));
        cvt_transpose<0>(F, F.in[I_EV_WOUT] + (size_t)j * D * D, D, D, D, nullptr, (bf16_t*)(ws + WS_W_EV_OUT + j * SZ_W_OUT));
        cvt_transpose<2>(F, F.in[I_OD_WIN] + (size_t)j * D * OD_N, OD_N, D, OD_NP, F.in[I_NMIX] + (size_t)(2 * j + 1) * D, (bf16_t*)(ws + WS_W_OD_IN + j * SZ_W_OD_IN));
        cvt_transpose<0>(F, F.in[I_OD_WOUT] + (size_t)j * D * D, D, D, D, nullptr, (bf16_t*)(ws + WS_W_OD_OUT + j * SZ_W_OUT));
        for (int kv = 0; kv < 2; ++kv) {
            cvt_transpose<0>(F, F.in[I_OD_CW1] + (size_t)(j * 2 + kv) * 4096 * 256, 256, 4096, 256, nullptr, (bf16_t*)(ws + WS_W_C1 + (j * 2 + kv) * SZ_W_C1));
            cvt_transpose<0>(F, F.in[I_OD_CW2] + (size_t)(j * 2 + kv) * 256 * 128, 128, 256, 256, nullptr, (bf16_t*)(ws + WS_W_C2 + (j * 2 + kv) * SZ_W_C2));
        }
    }
    for (int l = 0; l < 4; ++l) {
        cvt_transpose<3>(F, F.in[I_F_WUP] + (size_t)l * D * FF2, FF2, D, FF2, F.in[I_NFFN] + (size_t)l * D, (bf16_t*)(ws + WS_W_UP + l * SZ_W_UP));
        cvt_transpose<0>(F, F.in[I_F_WDN] + (size_t)l * FF * D, D, FF, D, nullptr, (bf16_t*)(ws + WS_W_DN + l * SZ_W_DN));
    }
    if (F.bid < 64) {
        const int tid = TID, jk = F.bid >> 4, part = (F.bid & 15) * 2 + (tid >> 8), n = tid & 255;
        const float* pe = F.in[I_OD_CPOS] + (size_t)jk * 4096 + part * 128; const float* w1 = F.in[I_OD_CW1] + ((size_t)jk * 4096 + part * 128) * 256 + n;
        float s = 0.f;
        for (int i0 = 0; i0 < 128; i0 += 16) {
            float a[16], b[16];
#pragma unroll
            for (int u = 0; u < 16; ++u) { a[u] = pe[i0 + u]; b[u] = w1[(size_t)(i0 + u) * 256]; }
#pragma unroll
            for (int u = 0; u < 16; ++u) s += a[u] * b[u];
        }
        ((float*)(ws + WS_C1B))[(jk * 32 + part) * 256 + n] = s;
    }
    rownorm_phase(F, F.in[I_X], (bf16_t*)(ws + WS_RES), F.out + (size_t)M * D / 2);
}
namespace att {
constexpr int KVBLK = 64, SHM_K = KVBLK * 128 * 2, SHM_V = KVBLK * 128 * 2;
constexpr int KVBUF = SHM_V + SHM_K;
constexpr int L_V = 0, L_K = SHM_V;
constexpr int EL_WS = 4 * KVBUF, EL_CFR = EL_WS + 2048, EL_TAB = EL_CFR + 8192  , EL_MISC = EL_TAB + 4096, EL_END = EL_MISC + 256;
static_assert(EL_END <= LDS_BARW, "even attention lds");
#define KSWZ_F(row) (((row) & 7) | ((((row) >> 4) & 1) << 3))
#define KSWZ(row, colB) ((row) * 256 + ((colB) ^ (KSWZ_F(row) << 4)))
#define SBAR() __builtin_amdgcn_sched_barrier(0)
__device__ __forceinline__ int v_st(int k, int c) { const int kk = (k & ~0xC) | ((k & 4) << 1) | ((k & 8) >> 1); return ((kk >> 3) * 4 + (c >> 5)) * 512 + ((kk & 7) * 32 + (c & 31)) * 2; }
__device__ __forceinline__ int v_rd_base(int lane) { return ((lane & 3) << 3) | (((lane >> 2) & 3) << 6) | (((lane >> 4) & 1) << 5) | (((lane >> 5) & 1) << 8); }
constexpr int v_rd_off(int d0, int ks, int half) { return d0 * 512 + ks * 4096 + half * 2048; }
__device__ __forceinline__ int crow(int r, int hi) { return (r & 3) + 8 * (r >> 2) + 4 * hi; }
constexpr float C2 = LOG2E * SCALE;

struct KvOff { unsigned k, v; };
__device__ __forceinline__ KvOff kv_dma_off(int tid, int ld) {
    const int row = tid >> 4, cch = (tid & 15) ^ KSWZ_F(row);
    const int kk = ((tid >> 7) << 3) | ((tid >> 2) & 7), key = (kk & ~0xC) | ((kk & 4) << 1) | ((kk & 8) >> 1), col = ((tid >> 5) & 3) * 32 + (tid & 3) * 8;
    KvOff o; o.k = (unsigned)(row * ld + cch * 8) * 2u; o.v = (unsigned)(key * ld + col) * 2u; return o;
}
__device__ __forceinline__ void kv_dma(LAS unsigned char* buf, const bf16_t* __restrict__ Kg, const bf16_t* __restrict__ Vg, int ld, KvOff o, int wid) {
    const char* k0 = (const char*)Kg; const char* k1 = (const char*)(Kg + (size_t)32 * ld);
    const char* v0 = (const char*)Vg; const char* v1 = (const char*)(Vg + (size_t)32 * ld);
    LAS unsigned char* l = buf + wid * 1024;
    __builtin_amdgcn_global_load_lds((const unsigned*)(k0 + o.k), (LAS unsigned*)(l + L_K), 16, 0, 0);
    __builtin_amdgcn_global_load_lds((const unsigned*)(k1 + o.k), (LAS unsigned*)(l + L_K + 8192), 16, 0, 0);
    __builtin_amdgcn_global_load_lds((const unsigned*)(v0 + o.v), (LAS unsigned*)(l + L_V), 16, 0, 0);
    __builtin_amdgcn_global_load_lds((const unsigned*)(v1 + o.v), (LAS unsigned*)(l + L_V + 8192), 16, 0, 0);
}
template <int NI> __device__ __forceinline__ void dma_wait(int ahead) {
    if (ahead >= 2) { if (NI == 4) asm volatile("s_waitcnt vmcnt(8)" ::: "memory"); else asm volatile("s_waitcnt vmcnt(10)" ::: "memory"); }
    else if (ahead == 1) { if (NI == 4) asm volatile("s_waitcnt vmcnt(4)" ::: "memory"); else asm volatile("s_waitcnt vmcnt(5)" ::: "memory"); }
    else asm volatile("s_waitcnt vmcnt(0)" ::: "memory");
}
#define RING_BAR() do { asm volatile("s_waitcnt lgkmcnt(0)" ::: "memory"); __builtin_amdgcn_s_barrier(); asm volatile("" ::: "memory"); } while (0)
template <int NSET = 4>
__device__ __forceinline__ void qkt(f32x16& p0, f32x16& p1, LAS unsigned char* lds, int r32, int hi, const bf16x8* qr) {
    p0 = f32x16{}; p1 = f32x16{};
    int ad[4];
#pragma unroll
    for (int dd = 0; dd < 4; ++dd) ad[dd] = (int)(uintptr_t)(lds + L_K + KSWZ(r32, (dd * 16 + hi * 8) * 2));
    bf16x8 k0[NSET], k1[NSET];
#define KRD(dst, a_, off_) asm volatile("ds_read_b128 %0, %1 offset:%2" : "=&v"(dst) : "v"(a_), "i"(off_) : "memory")
#define KWAIT(n_, x_, y_) asm volatile("s_waitcnt lgkmcnt(" #n_ ")" : "+v"(x_), "+v"(y_) :: "memory")
#define KISSUE(d_) do { if ((d_) < 4) { KRD(k0[(d_) % NSET], ad[(d_) & 3], 0); KRD(k1[(d_) % NSET], ad[(d_) & 3], 32 * 256); } \
                        else { const int a2_ = ad[(d_) & 3] ^ 128;         \
                               KRD(k0[(d_) % NSET], a2_, 0); KRD(k1[(d_) % NSET], a2_, 32 * 256); } } while (0)
#pragma unroll
    for (int d0 = 0; d0 < NSET; ++d0) KISSUE(d0);
#define KWAITN(n_, x_, y_) do { if ((n_) == 6) KWAIT(6, x_, y_); else if ((n_) == 4) KWAIT(4, x_, y_); else if ((n_) == 2) KWAIT(2, x_, y_); else KWAIT(0, x_, y_); } while (0)
#define QK_STEP(d0_) do { constexpr int inflight_ = ((8 - (d0_)) < NSET ? (8 - (d0_)) : NSET) - 1; KWAITN(2 * inflight_, k0[(d0_) % NSET], k1[(d0_) % NSET]); \
        p0 = __builtin_amdgcn_mfma_f32_32x32x16_bf16(k0[(d0_) % NSET], qr[d0_], p0, 0, 0, 0); p1 = __builtin_amdgcn_mfma_f32_32x32x16_bf16(k1[(d0_) % NSET], qr[d0_], p1, 0, 0, 0); \
        if ((d0_) + NSET < 8) KISSUE((d0_) + NSET); } while (0)
    QK_STEP(0); QK_STEP(1); QK_STEP(2); QK_STEP(3); QK_STEP(4); QK_STEP(5); QK_STEP(6); QK_STEP(7);
#undef KWAITN
#undef QK_STEP
#undef KISSUE
#undef KWAIT
#undef KRD
}
__device__ __forceinline__ void partialSM(f32x16& p0, f32x16& p1, float& m_reg, float& mn, float& alpha) {
    float mx[4] = {p0[0], p0[1], p0[2], p0[3]};
#pragma unroll
    for (int r = 4; r < 16; ++r) mx[r & 3] = fmaxf(mx[r & 3], p0[r]);
#pragma unroll
    for (int r = 0; r < 16; ++r) mx[r & 3] = fmaxf(mx[r & 3], p1[r]);
    float pmax = fmaxf(fmaxf(mx[0], mx[1]), fmaxf(mx[2], mx[3]));
    { auto rr = __builtin_amdgcn_permlane32_swap(__float_as_uint(pmax), __float_as_uint(pmax), false, false);
      pmax = fmaxf(__uint_as_float(rr[0]), __uint_as_float(rr[1])); }
    if (__any((pmax - m_reg) * C2 > 8.f)) { mn = fmaxf(m_reg, pmax); alpha = __builtin_amdgcn_exp2f((m_reg - mn) * C2); m_reg = mn; }
    else { mn = m_reg; alpha = 1.f; }
    const float mnL = -mn * C2;
#pragma unroll
    for (int r = 0; r < 16; ++r) p0[r] = __builtin_amdgcn_exp2f(fmaf(p0[r], C2, mnL));
#pragma unroll
    for (int r = 0; r < 16; ++r) p1[r] = __builtin_amdgcn_exp2f(fmaf(p1[r], C2, mnL));
}
__device__ __forceinline__ void pack_p(const f32x16& p0, const f32x16& p1, bf16x8& pa0, bf16x8& pa1, bf16x8& pa2, bf16x8& pa3) {
#define PK4(P, B_, OUT) do { unsigned a0 = cvt_pk_bf16(P[B_+0], P[B_+1]), a1 = cvt_pk_bf16(P[B_+2], P[B_+3]);                          \
        unsigned b0 = cvt_pk_bf16(P[B_+4], P[B_+5]), b1 = cvt_pk_bf16(P[B_+6], P[B_+7]);                                             \
        auto r0 = __builtin_amdgcn_permlane32_swap(a0, b0, false, false); auto r1 = __builtin_amdgcn_permlane32_swap(a1, b1, false, false); \
        u32x4 w = {r0[0], r1[0], r0[1], r1[1]}; OUT = *reinterpret_cast<bf16x8*>(&w); } while (0)
    PK4(p0, 0, pa0); PK4(p0, 8, pa1); PK4(p1, 0, pa2); PK4(p1, 8, pa3);
#undef PK4
}
__device__ __forceinline__ float row_sum(const f32x16& p0, const f32x16& p1) {
    float sm[4] = {0.f, 0.f, 0.f, 0.f};
#pragma unroll
    for (int r = 0; r < 16; ++r) sm[r & 3] += p0[r] + p1[r];
    const float ps = (sm[0] + sm[1]) + (sm[2] + sm[3]);
    auto rr = __builtin_amdgcn_permlane32_swap(__float_as_uint(ps), __float_as_uint(ps), false, false);
    return __uint_as_float(rr[0]) + __uint_as_float(rr[1]);
}
__device__ __forceinline__ void pv_tile(f32x16* o, int vb0, bf16x8 pa0, bf16x8 pa1, bf16x8 pa2, bf16x8 pa3) {
#define TRRD(dst, off) asm volatile("ds_read_b64_tr_b16 %0, %1 offset:%2" : "=&v"(dst) : "v"(vb0), "i"(off) : "memory")
    s16x4 l[2][4], h[2][4];
#define PV_RD(d0, st) do { constexpr int b_ = L_V + v_rd_off(d0, 0, 0); \
        TRRD(l[st][0], b_); TRRD(h[st][0], b_ + 2048); TRRD(l[st][1], b_ + 4096); TRRD(h[st][1], b_ + 6144); TRRD(l[st][2], b_ + 8192); TRRD(h[st][2], b_ + 10240); TRRD(l[st][3], b_ + 12288); TRRD(h[st][3], b_ + 14336); } while (0)
#define PV_WAIT(n_, st) asm volatile("s_waitcnt lgkmcnt(" #n_ ")" : "+v"(l[st][0]), "+v"(h[st][0]), "+v"(l[st][1]), "+v"(h[st][1]), "+v"(l[st][2]), "+v"(h[st][2]), "+v"(l[st][3]), "+v"(h[st][3]) :: "memory")
#define PV_MM(d0, st) do { \
        o[d0] = __builtin_amdgcn_mfma_f32_32x32x16_bf16(pa0, (bf16x8){l[st][0][0], l[st][0][1], l[st][0][2], l[st][0][3], h[st][0][0], h[st][0][1], h[st][0][2], h[st][0][3]}, o[d0], 0, 0, 0);   \
        o[d0] = __builtin_amdgcn_mfma_f32_32x32x16_bf16(pa1, (bf16x8){l[st][1][0], l[st][1][1], l[st][1][2], l[st][1][3], h[st][1][0], h[st][1][1], h[st][1][2], h[st][1][3]}, o[d0], 0, 0, 0);   \
        o[d0] = __builtin_amdgcn_mfma_f32_32x32x16_bf16(pa2, (bf16x8){l[st][2][0], l[st][2][1], l[st][2][2], l[st][2][3], h[st][2][0], h[st][2][1], h[st][2][2], h[st][2][3]}, o[d0], 0, 0, 0);   \
        o[d0] = __builtin_amdgcn_mfma_f32_32x32x16_bf16(pa3, (bf16x8){l[st][3][0], l[st][3][1], l[st][3][2], l[st][3][3], h[st][3][0], h[st][3][1], h[st][3][2], h[st][3][3]}, o[d0], 0, 0, 0); } while (0)
    PV_RD(0, 0); PV_RD(1, 1);
    PV_WAIT(8, 0); PV_MM(0, 0); PV_RD(2, 0);
    PV_WAIT(8, 1); PV_MM(1, 1); PV_RD(3, 1);
    PV_WAIT(8, 0); PV_MM(2, 0);
    PV_WAIT(0, 1); PV_MM(3, 1);
#undef PV_MM
#undef PV_WAIT
#undef PV_RD
#undef TRRD
}
__device__ __forceinline__ void rescale_o(f32x16* o, float alpha, LAS float* al_l, int r32, int hi) {
    if (__any(alpha < 1.f)) {
        if (hi == 0) al_l[r32] = alpha;
        asm volatile("s_waitcnt lgkmcnt(0)" ::: "memory");
#pragma unroll
        for (int r = 0; r < 16; ++r) { const float a = al_l[crow(r, hi)];
#pragma unroll
            for (int d = 0; d < 4; ++d) o[d][r] *= a; }
        asm volatile("s_waitcnt lgkmcnt(0)" ::: "memory");
    }
}
__device__ __forceinline__ void sm_pv_step(f32x16& p0, f32x16& p1, f32x16* o, float& m_reg, float& l_reg, LAS float* al_l, int vb0, int r32, int hi) {
    float mn, alpha;
    partialSM(p0, p1, m_reg, mn, alpha);
    rescale_o(o, alpha, al_l, r32, hi);
    l_reg = l_reg * alpha + row_sum(p0, p1);
    bf16x8 pa0, pa1, pa2, pa3; pack_p(p0, p1, pa0, pa1, pa2, pa3);
    pv_tile(o, vb0, pa0, pa1, pa2, pa3);
}
__device__ __forceinline__ void lanes_to_rows(float x, float* vals, LAS float* xl, int r32, int hi) {
    if (hi == 0) xl[r32] = x;
    asm volatile("s_waitcnt lgkmcnt(0)" ::: "memory");
#pragma unroll
    for (int r = 0; r < 16; ++r) vals[r] = xl[crow(r, hi)];
    asm volatile("s_waitcnt lgkmcnt(0)" ::: "memory");
}
template <int NI, class Issue, class Active, class Fixup>
__device__ __forceinline__ void pingpong_attn(int nT, int wid, LAS unsigned char* lds, int vb0, const bf16x8* qr, f32x16* o, float& m_reg, float& l_reg, LAS float* al_l, int r32, int hi,
                                              Issue issue, Active active, Fixup fixup) {
    const bool grpB = wid >= 4;
    issue(0); if (nT > 1) issue(1);
    dma_wait<NI>(nT > 1 ? 1 : 0);
    RING_BAR();
    if (grpB) RING_BAR();
    bf16x8 pa0 = {}, pa1 = {}, pa2 = {}, pa3 = {}; bool act_prev = false;
    f32x16 p0 = {}, p1 = {};
    for (int s = 0; s <= nT; ++s) {
        if (s + 2 < nT) issue(s + 2);
        if (act_prev) pv_tile(o, vb0 + ((s - 1) & 3) * KVBUF, pa0, pa1, pa2, pa3);
        bool act = false;
        if (s < nT) { act = active(s); if (act) qkt(p0, p1, lds + (s & 3) * KVBUF, r32, hi, qr); }
        if (s + 1 < nT) dma_wait<NI>(s + 2 < nT ? 1 : 0);
        RING_BAR();
        if (s < nT) {
            if (act) { fixup(s, p0, p1); float mn, alpha; partialSM(p0, p1, m_reg, mn, alpha); rescale_o(o, alpha, al_l, r32, hi); l_reg = l_reg * alpha + row_sum(p0, p1);
                       pack_p(p0, p1, pa0, pa1, pa2, pa3); }
            act_prev = act;
            RING_BAR();
        }
    }
    if (!grpB) RING_BAR();
}
template <int NI, int NSET, class Issue, class Active, class Fixup>
__device__ __forceinline__ void dual_attn(int nT, int wid, LAS unsigned char* lds, int vb0, const bf16x8* qr, f32x16* o, float& m_reg, float& l_reg, LAS float* al_l, int r32, int hi,
                                          Issue issue, Active active, Fixup fixup) {
    const int nS = (nT + 1) >> 1;
    issue(0); if (nT > 1) issue(1);
    for (int s = 0; s < nS; ++s) {
        asm volatile("s_waitcnt vmcnt(0)" ::: "memory");
        RING_BAR();
        if (2 * s + 2 < nT) issue(2 * s + 2);
        if (2 * s + 3 < nT) issue(2 * s + 3);
        const int sa = (2 * s) & 3;
        const float NEGI = -__builtin_inff();
        f32x16 p0, p1, p2, p3;
        const bool acta = active(2 * s);
        if (acta) { qkt<NSET>(p0, p1, lds + sa * KVBUF, r32, hi, qr); fixup(2 * s, p0, p1); }
        else {
#pragma unroll
            for (int r = 0; r < 16; ++r) { p0[r] = NEGI; p1[r] = NEGI; } }
        if (NSET == 2) __builtin_amdgcn_sched_barrier(0);
        bool actb = false;
        if (2 * s + 1 < nT) actb = active(2 * s + 1);
        if (actb) { qkt<NSET>(p2, p3, lds + (sa + 1) * KVBUF, r32, hi, qr); fixup(2 * s + 1, p2, p3); }
        else {
#pragma unroll
            for (int r = 0; r < 16; ++r) { p2[r] = NEGI; p3[r] = NEGI; } }
        if (!acta && !actb) continue;
        float mx[4] = {p0[0], p0[1], p0[2], p0[3]};
#pragma unroll
        for (int r = 4; r < 16; ++r) mx[r & 3] = fmaxf(mx[r & 3], p0[r]);
#pragma unroll
        for (int r = 0; r < 16; ++r) mx[r & 3] = fmaxf(mx[r & 3], fmaxf(p1[r], fmaxf(p2[r], p3[r])));
        float pmax = fmaxf(fmaxf(mx[0], mx[1]), fmaxf(mx[2], mx[3]));
        { auto rr = __builtin_amdgcn_permlane32_swap(__float_as_uint(pmax), __float_as_uint(pmax), false, false);
          pmax = fmaxf(__uint_as_float(rr[0]), __uint_as_float(rr[1])); }
        float mn = m_reg, alpha = 1.f;
        if (__any((pmax - m_reg) * C2 > 8.f)) { mn = fmaxf(m_reg, pmax); alpha = __builtin_amdgcn_exp2f((m_reg - mn) * C2); m_reg = mn; }
        const float mnL = -mn * C2;
#pragma unroll
        for (int r = 0; r < 16; ++r) { p0[r] = __builtin_amdgcn_exp2f(fmaf(p0[r], C2, mnL)); p1[r] = __builtin_amdgcn_exp2f(fmaf(p1[r], C2, mnL));
                                       p2[r] = __builtin_amdgcn_exp2f(fmaf(p2[r], C2, mnL)); p3[r] = __builtin_amdgcn_exp2f(fmaf(p3[r], C2, mnL)); }
        rescale_o(o, alpha, al_l, r32, hi);
        { float sm[4] = {0.f, 0.f, 0.f, 0.f};
#pragma unroll
          for (int r = 0; r < 16; ++r) sm[r & 3] += (p0[r] + p1[r]) + (p2[r] + p3[r]);
          const float ps = (sm[0] + sm[1]) + (sm[2] + sm[3]);
          auto rr = __builtin_amdgcn_permlane32_swap(__float_as_uint(ps), __float_as_uint(ps), false, false);
          l_reg = l_reg * alpha + (__uint_as_float(rr[0]) + __uint_as_float(rr[1])); }
        if (acta) { bf16x8 a0, a1, a2, a3; pack_p(p0, p1, a0, a1, a2, a3); pv_tile(o, vb0 + sa * KVBUF, a0, a1, a2, a3); }
        if (actb) { bf16x8 b0, b1, b2, b3; pack_p(p2, p3, b0, b1, b2, b3); pv_tile(o, vb0 + (sa + 1) * KVBUF, b0, b1, b2, b3); }
    }
}
__device__ __forceinline__ void store_o_bf16(const f32x16* o, const float* rs, bf16_t* __restrict__ Ow, int ldo, int r32, int hi) {
    unsigned w[16][4];
#pragma unroll
    for (int r = 0; r < 16; ++r)
#pragma unroll
        for (int d0 = 0; d0 < 4; ++d0) { const float v = o[d0][r] * rs[r]; const float vn = DPPF(v, 0xB1); w[r][d0] = cvt_pk_bf16(v, vn); }
    if ((r32 & 1) == 0) {
#pragma unroll
        for (int r = 0; r < 16; ++r)
#pragma unroll
            for (int d0 = 0; d0 < 4; ++d0) *(unsigned*)(Ow + (size_t)crow(r, hi) * ldo + d0 * 32 + r32) = w[r][d0];
    }
}
__device__ __forceinline__ int t5_bucket(int n) {
    if (n < 16) return n;
    const float lr = logf((float)n / 16.f) / 2.0794415416798357f;
    const int v = 16 + (int)(lr * 16.f);
    return v < 31 ? v : 31;
}
}

__device__ __forceinline__ void fox_norm_phase(const Frame& F, const bf16_t* __restrict__ proj, unsigned* __restrict__ nrm) {
    const int tid = TID, sub = tid & 15, rl = tid >> 4;
    for (int it = F.bid; it < 256; it += F.G) {
        const int bh = it >> 2, qtr = it & 3, b = bh >> 3, h = bh & 7;
        float mq = 0.f, mk = 0.f;
        for (int r0 = 0; r0 < 1024; r0 += 256) {
            u32x4 qv[8], kv[8];
#pragma unroll
            for (int u = 0; u < 8; ++u) { const size_t row = (size_t)(b * T + qtr * 1024 + r0 + u * 32 + rl) * EV_NP;
                qv[u] = *(const u32x4*)(proj + row + EC_QB + h * 128 + sub * 8); kv[u] = *(const u32x4*)(proj + row + EC_KB + h * 128 + sub * 8); }
#pragma unroll
            for (int u = 0; u < 8; ++u) { const u32x4 q = qv[u], k = kv[u];
                float sq = bflo(q.x) * bflo(q.x) + bfhi(q.x) * bfhi(q.x) + bflo(q.y) * bflo(q.y) + bfhi(q.y) * bfhi(q.y) + bflo(q.z) * bflo(q.z) + bfhi(q.z) * bfhi(q.z) + bflo(q.w) * bflo(q.w) + bfhi(q.w) * bfhi(q.w);
                float sk = bflo(k.x) * bflo(k.x) + bfhi(k.x) * bfhi(k.x) + bflo(k.y) * bflo(k.y) + bfhi(k.y) * bfhi(k.y) + bflo(k.z) * bflo(k.z) + bfhi(k.z) * bfhi(k.z) + bflo(k.w) * bflo(k.w) + bfhi(k.w) * bfhi(k.w);
                sq = row16_sum(sq); sk = row16_sum(sk);
                mq = fmaxf(mq, sq); mk = fmaxf(mk, sk); }
        }
#pragma unroll
        for (int o = 16; o < 64; o <<= 1) { mq = fmaxf(mq, shx(mq, o)); mk = fmaxf(mk, shx(mk, o)); }
        if ((tid & 63) == 0) { atomicMax(nrm + bh * 2, __float_as_uint(mq)); atomicMax(nrm + bh * 2 + 1, __float_as_uint(mk)); }
    }
}
__device__ __forceinline__ void fscan_phase(const Frame& F, const bf16_t* __restrict__ proj, const float* __restrict__ bforget, float* __restrict__ cf) {
    LAS float* red = (LAS float*)F.lds;
    const int tid = TID;
    for (int it = F.bid; it < NB * 8; it += F.G) {
        const int b = it >> 3, h = it & 7; const float bf = bforget[h];
        float v[8]; float s = 0.f;
#pragma unroll
        for (int i = 0; i < 8; ++i) { const int t = tid * 8 + i; const float x = bf2f(proj[(size_t)(b * T + t) * EV_NP + EC_F + h]) + bf;
            const float ls = fminf(x, 0.f) - log1pf(__expf(-fabsf(x))); s += ls; v[i] = s; }
        __syncthreads();
        red[tid] = s;
        __syncthreads();
        if (tid < 64) { float a = 0.f;
            float loc[8];
#pragma unroll
            for (int i = 0; i < 8; ++i) { a += red[tid * 8 + i]; loc[i] = a; }
            float incl = a;
#pragma unroll
            for (int o = 1; o < 64; o <<= 1) { const float n = shu(incl, o); if (tid >= o) incl += n; }
            const float excl = incl - a;
#pragma unroll
            for (int i = 0; i < 8; ++i) red[tid * 8 + i] = excl + loc[i];
        }
        __syncthreads();
        const float base = tid > 0 ? red[tid - 1] : 0.f;
#pragma unroll
        for (int i = 0; i < 8; ++i) cf[(size_t)it * T + tid * 8 + i] = base + v[i];
    }
    __syncthreads();
}

__device__ __forceinline__ void even_attn_phase(const Frame& F, const bf16_t* __restrict__ proj, bf16_t* __restrict__ mix, const float* __restrict__ cf, const float* __restrict__ relb, const float* __restrict__ sinks, const unsigned* __restrict__ nrm, unsigned* __restrict__ qhead) {
    using namespace att;
    LAS unsigned char* lds = F.lds;
    const int tid = opaque_tid(), wid = __builtin_amdgcn_readfirstlane(tid >> 6), lane = tid & 63, r32 = lane & 31, hi = lane >> 5;
    LAS float* al_l = (LAS float*)(lds + EL_WS) + wid * 64;
    LAS float* cfr = (LAS float*)(lds + EL_CFR) + wid * 64;
    LAS float* tab = (LAS float*)(lds + EL_TAB);
    constexpr int LD = EV_NP;
    LAS int* qi = (LAS int*)(lds + EL_MISC);
    for (int i = tid; i < 1024; i += NTHR) tab[i] = relb[t5_bucket(i & 127) * 8 + (i >> 7)] * INV_SCALE;
    for (;;) {
        __syncthreads();
        if (threadIdx.x == 0) *qi = (int)__hip_atomic_fetch_add(qhead, 1u, __ATOMIC_RELAXED, __HIP_MEMORY_SCOPE_AGENT);
        __syncthreads();
        const int it = __builtin_amdgcn_readfirstlane(*qi);
        if (it >= 2048) break;
        const int tid = opaque_tid(), lane = tid & 63, r32 = lane & 31, hi = lane >> 5;
        const int vb0 = (int)(uintptr_t)(lds + L_V) + v_rd_base(lane);
        const KvOff ko = kv_dma_off(tid, LD);
        if (it < 1024) {
            const int qb = 15 - (it >> 6), bh = it & 63;
            const int b = bh >> 3, h = bh & 7, P0 = qb * 256, qpos0 = P0 + wid * 32;
            const bf16_t* Qg = proj + (size_t)(b * T + qpos0 + r32) * LD + EC_QB + h * 128;
            const bf16_t* Kg = proj + (size_t)(b * T) * LD + EC_KB + h * 128;
            const bf16_t* Vg = proj + (size_t)(b * T) * LD + EC_VB + h * 128;
            const float* cfh = cf + (size_t)(b * 8 + h) * T;
            bf16x8 qr[8];
#pragma unroll
            for (int d0 = 0; d0 < 8; ++d0) qr[d0] = *(const bf16x8*)(Qg + d0 * 16 + hi * 8);
            const float crefS = cfh[P0 + 255] * INV_SCALE;
            float m_reg = -1e30f, l_reg = 0.f; f32x16 o[4] = {};
            const int ntile = 4 * qb + 4;
            int jlo;
            { const float bnd = 2.f * sqrtf(__uint_as_float(nrm[(b * 8 + h) * 2]) * __uint_as_float(nrm[(b * 8 + h) * 2 + 1])) * SCALE * 1.02f + cfh[P0];
              const bool keep = (lane >= 4 * qb) || (bnd - cfh[lane * 64 + 63] >= -36.f);
              jlo = __builtin_amdgcn_readfirstlane(__builtin_ctzll(__ballot(keep))); }
            const int nT = ntile - jlo;
#define FOX_ISSUE(k_) do { const int t_ = jlo + (k_), s_ = (k_) & 3; kv_dma(lds + s_ * KVBUF, Kg + (size_t)(t_ * 64) * LD, Vg + (size_t)(t_ * 64) * LD, LD, ko, wid); \
                __builtin_amdgcn_global_load_lds((const unsigned*)(cfh + t_ * 64 + lane), (LAS unsigned*)(cfr + s_ * 512), 4, 0, 0); } while (0)
            __syncthreads();
            int kb = 0; const LAS float* kbb = cfr;
            pingpong_attn<5>(nT, wid, lds, vb0, qr, o, m_reg, l_reg, al_l, r32, hi,
                [&](int k) { FOX_ISSUE(k); },
                [&](int s) { kb = (jlo + s) * 64; kbb = cfr + (s & 3) * 512; return kb <= qpos0 + 31; },
                [&](int, f32x16& p0, f32x16& p1) {
#pragma unroll
                    for (int g4 = 0; g4 < 4; ++g4) { const f32x4 b0 = *(const LAS f32x4*)(kbb + 8 * g4 + 4 * hi), b1 = *(const LAS f32x4*)(kbb + 32 + 8 * g4 + 4 * hi);
#pragma unroll
                        for (int i = 0; i < 4; ++i) { p0[4 * g4 + i] += fmaf(b0[i], -INV_SCALE, crefS); p1[4 * g4 + i] += fmaf(b1[i], -INV_SCALE, crefS); } }
                    if (kb + 63 > qpos0) {
                        const int dq = qpos0 + r32 - kb - 4 * hi; const float NEG = -__builtin_inff();
#pragma unroll
                        for (int r = 0; r < 16; ++r) { const int c = (r & 3) + 8 * (r >> 2); if (dq - c < 0) p0[r] = NEG; if (dq - c - 32 < 0) p1[r] = NEG; }
                    }
                });
#undef FOX_ISSUE
            float rs[16]; lanes_to_rows(__builtin_amdgcn_rcpf(l_reg), rs, al_l, r32, hi);
            store_o_bf16(o, rs, mix + (size_t)(b * T + qpos0) * D + 1024 + h * 128, D, r32, hi);
        } else {
            const int i2 = it - 1024, qb = i2 & 63, bg = i2 >> 6, b = bg >> 1, g = bg & 1;
            const int hl = wid >> 1, head = g * 4 + hl, P0 = qb * 64, qpos0 = P0 + (wid & 1) * 32;
            const bf16_t* Qg = proj + (size_t)(b * T + qpos0 + r32) * LD + EC_QA + head * 128;
            const bf16_t* Kg = proj + (size_t)(b * T) * LD + EC_KA + g * 128;
            const bf16_t* Vg = proj + (size_t)(b * T) * LD + EC_VA + g * 128;
            bf16x8 qr[8];
#pragma unroll
            for (int d0 = 0; d0 < 8; ++d0) qr[d0] = *(const bf16x8*)(Qg + d0 * 16 + hi * 8);
            float m_reg = sinks[head] * INV_SCALE, l_reg = 1.f; f32x16 o[4] = {};
            const LAS float* tb = tab + head * 128;
            const int jt0 = (qb >= 2 ? qb - 2 : 0), nT = qb - jt0 + 1;
            __syncthreads();
            int kb = 0;
            pingpong_attn<4>(nT, wid, lds, vb0, qr, o, m_reg, l_reg, al_l, r32, hi,
                [&](int k) { kv_dma(lds + (k & 3) * KVBUF, Kg + (size_t)((jt0 + k) * 64) * LD, Vg + (size_t)((jt0 + k) * 64) * LD, LD, ko, wid); },
                [&](int s) { kb = (jt0 + s) * 64; return kb <= qpos0 + 31 && kb + 63 >= qpos0 - 127; },
                [&](int, f32x16& p0, f32x16& p1) {
                    const int dq = qpos0 + r32 - kb - 4 * hi; const float NEG = -__builtin_inff();
#pragma unroll
                    for (int r = 0; r < 16; ++r) { const int c = (r & 3) + 8 * (r >> 2); const int d0_ = dq - c, d1_ = dq - c - 32;
                        float t0 = tb[d0_ & 127], t1 = tb[d1_ & 127];
                        asm("" : "+v"(t0), "+v"(t1));
                        p0[r] = ((unsigned)d0_ < 128u) ? p0[r] + t0 : NEG; p1[r] = ((unsigned)d1_ < 128u) ? p1[r] + t1 : NEG; }
                });
            float rs[16]; lanes_to_rows(__builtin_amdgcn_rcpf(l_reg), rs, al_l, r32, hi);
            store_o_bf16(o, rs, mix + (size_t)(b * T + qpos0) * D + head * 128, D, r32, hi);
        }
    }
    __syncthreads();
}

#define N_EVEN_PHASES 5
#define even_mixer_phases \
    PH_BEGIN { pg8::Gemm g{RES, (const bf16_t*)(ws + WS_W_EV_IN + j * SZ_W_EV_IN), M, EC_F, D, D}; pg8::StaticOrder S; S.init(M, EC_F, F.G, F.bid);     \
               pg8::EpiStoreBf16 E{PROJ, EV_NP, RSTD}; pg8::gemm_phase(F.lds, g, S, E); } PH_END \
    PH_BEGIN fscan_phase(F, PROJ, F.in[I_EV_BF] + j * 8, (float*)(ws + WS_CF)); fox_norm_phase(F, PROJ, F.ctl + CW_NORM + j * 128); PH_END \
    PH_BEGIN even_attn_phase(F, PROJ, HB, (const float*)(ws + WS_CF), F.in[I_RELB], F.in[I_EV_SINK] + j * 8, F.ctl + CW_NORM + j * 128, F.ctl + CW_QUEUE + 64 * (4 + j)); PH_END \
    PH_BEGIN { pg8::Gemm g{HB, (const bf16_t*)(ws + WS_W_EV_OUT + j * SZ_W_OUT), M, D, D, D}; pg8::StaticOrder S; S.init(M, D, F.G, F.bid); \
               pg8::EpiAddRes E{RES, D}; pg8::gemm_phase(F.lds, g, S, E); } PH_END \
    PH_BEGIN rowstat_phase(F, RES, RSTD); PH_END
namespace gdn {
constexpr int RLD = 260, AMLD = 68;
constexpr int L_R = 0, L_KB16 = 64 * RLD * 4, L_QB16 = L_KB16 + 64 * 272, L_AM = L_QB16 + 64 * 272, L_GAM = L_AM + 64 * AMLD * 4, L_BETA = L_GAM + 256, L_BEG = L_BETA + 256, L_END = L_BEG + 256, L_WL = L_END + 16  , L_END2 = L_WL + 3 * 4 * 128 * 4;
static_assert(L_END2 <= LDS_BARW && (L_KB16 % 16) == 0 && (L_AM % 16) == 0 && (L_WL % 16) == 0, "gdn lds");
constexpr int RS16 = 272;

__device__ __forceinline__ void chunk_phase(const Frame& F, const bf16_t* __restrict__ proj, const float* __restrict__ convw, const float* __restrict__ alog, const float* __restrict__ dtb, unsigned* __restrict__ qhead) {
    LAS unsigned char* lds = F.lds;
    unsigned char* ws = F.ws;
    bf16_t* Ug = (bf16_t*)(ws + WS_G_U); bf16_t* Wg = (bf16_t*)(ws + WS_G_W); bf16_t* QGg = (bf16_t*)(ws + WS_G_QG); bf16_t* KTg = (bf16_t*)(ws + WS_G_KT);
    bf16_t* ATg = (bf16_t*)(ws + WS_G_ATT); float* GLg = (float*)(ws + WS_G_GL);
    LAS float* R = (LAS float*)(lds + L_R);
    LAS float* AM = (LAS float*)(lds + L_AM); LAS float* GAM = (LAS float*)(lds + L_GAM); LAS float* BETA = (LAS float*)(lds + L_BETA); LAS float* BEG = (LAS float*)(lds + L_BEG);
    LAS int* qi = (LAS int*)(lds + L_END);
    u32x4 xv[3][2][4]; f32x4 wld = (f32x4){0.f, 0.f, 0.f, 0.f}; unsigned blr = 0u, alr = 0u;
#define CH_LOADS(ci_) do { const int n_ = (ci_) & 63, bh_ = (ci_) >> 6, b_ = bh_ >> 3, h_ = bh_ & 7, t0_ = n_ * 64; \
        const int tl_ = opaque_tid(), c0_ = (tl_ & 15) * 8, i0_ = tl_ >> 4;     \
        _Pragma("unroll") for (int which = 0; which < 3; ++which) {             \
            const int pcol = (which == 0 ? OC_QD : which == 1 ? OC_KD : OC_VD) + h_ * 128; \
            _Pragma("unroll") for (int e = 0; e < 2; ++e) \
                _Pragma("unroll") for (int jj = 0; jj < 4; ++jj) { const int t = t0_ + i0_ + e * 32 - 3 + jj, tc = t < 0 ? 0 : t;         \
                    xv[which][e][jj] = *(const u32x4*)(proj + (size_t)(b_ * T + tc) * OD_NP + pcol + c0_); } } \
        if (tl_ < 384) { const int wh = tl_ >> 7, jj = (tl_ & 127) >> 5, c4 = tl_ & 31; wld = *(const f32x4*)(convw + (size_t)jj * 3072 + wh * 1024 + h_ * 128 + c4 * 4); } \
        if (tl_ < 64) { const size_t row = (size_t)(b_ * T + t0_ + tl_) * OD_NP; blr = proj[row + OC_BETA + h_]; alr = proj[row + OC_A + h_]; } } while (0)
#define CH_STEP01(ci_) do { const int n = (ci_) & 63, bh = (ci_) >> 6, h = bh & 7, t0 = n * 64; const int tl = opaque_tid(), c0 = (tl & 15) * 8, i0 = tl >> 4; \
        LAS float* WL = (LAS float*)(lds + L_WL); \
        if (tl < 384) *(LAS f32x4*)(WL + ((tl >> 7) * 4 + ((tl & 127) >> 5)) * 128 + (tl & 31) * 4) = wld; \
        if (tl < 64) { \
            const float bl = __uint_as_float(blr << 16), al = __uint_as_float(alr << 16); const float x = al + dtb[h]; \
            const float sp = fmaxf(x, 0.f) + log1pf(__expf(-fabsf(x))); \
            float g = -__expf(alog[h]) * sp; \
        _Pragma("unroll") \
            for (int o = 1; o < 64; o <<= 1) { const float nb = shu(g, o); if (tl >= o) g += nb; } \
            const float be = sigmoidf_(bl); GAM[tl] = g; BETA[tl] = be; BEG[tl] = be * __expf(g); \
            if (tl == 63) GLg[ci_] = __expf(g); \
        } \
        __syncthreads(); \
        _Pragma("unroll") \
        for (int which = 0; which < 3; ++which) { \
            f32x4 wa[4], wb[4]; \
        _Pragma("unroll") \
            for (int jj = 0; jj < 4; ++jj) { wa[jj] = *(LAS f32x4*)(WL + (which * 4 + jj) * 128 + c0); wb[jj] = *(LAS f32x4*)(WL + (which * 4 + jj) * 128 + c0 + 4); } \
        _Pragma("unroll") \
            for (int e = 0; e < 2; ++e) { \
                const int i = i0 + e * 32; \
                float acc[8]; \
        _Pragma("unroll") \
                for (int q = 0; q < 8; ++q) acc[q] = 0.f; \
        _Pragma("unroll") \
                for (int jj = 0; jj < 4; ++jj) { \
                    const float vz = (t0 + i - 3 + jj >= 0) ? 1.f : 0.f; const u32x4 x = xv[which][e][jj]; \
                    const f32x4 a_ = wa[jj] * vz, b_ = wb[jj] * vz; \
                    acc[0] += a_[0] * bflo(x.x); acc[1] += a_[1] * bfhi(x.x); acc[2] += a_[2] * bflo(x.y); acc[3] += a_[3] * bfhi(x.y); \
                    acc[4] += b_[0] * bflo(x.z); acc[5] += b_[1] * bfhi(x.z); acc[6] += b_[2] * bflo(x.w); acc[7] += b_[3] * bfhi(x.w); \
                } \
                float ss = 0.f; \
        _Pragma("unroll") \
                for (int q = 0; q < 8; ++q) { acc[q] = siluf_(acc[q]); ss += acc[q] * acc[q]; } \
                if (which < 2) { \
                    ss = row16_sum(ss); \
                    const float rn = rsqrtf(ss + EPS) * (which == 0 ? SCALE : 1.f); \
        _Pragma("unroll") \
                    for (int q = 0; q < 8; ++q) acc[q] *= rn; \
                    u32x4 w; w.x = cvt_pk_bf16(acc[0], acc[1]); w.y = cvt_pk_bf16(acc[2], acc[3]); w.z = cvt_pk_bf16(acc[4], acc[5]); w.w = cvt_pk_bf16(acc[6], acc[7]); \
                    *(LAS u32x4*)(lds + (which == 0 ? L_QB16 : L_KB16) + i * RS16 + c0 * 2) = w; \
                } \
                if (which >= 1) { const float sc = (which == 1) ? BEG[i] : BETA[i]; LAS float* dst = R + i * RLD + (which == 1 ? 128 : 0) + c0; \
                    *(LAS f32x4*)dst = (f32x4){acc[0], acc[1], acc[2], acc[3]} * sc; *(LAS f32x4*)(dst + 4) = (f32x4){acc[4], acc[5], acc[6], acc[7]} * sc; } \
            } \
        } \
    } while (0)
    unsigned pend = 0u;
    if (threadIdx.x == 0) pend = __hip_atomic_fetch_add(qhead, 1u, __ATOMIC_RELAXED, __HIP_MEMORY_SCOPE_AGENT);
    __syncthreads();
    if (threadIdx.x == 0) { *qi = (int)pend; pend = __hip_atomic_fetch_add(qhead, 1u, __ATOMIC_RELAXED, __HIP_MEMORY_SCOPE_AGENT); }
    __syncthreads();
    int ci = __builtin_amdgcn_readfirstlane(*qi);
    if (ci < NCHUNK) { CH_LOADS(ci); CH_STEP01(ci); }
    if (threadIdx.x == 0) { *qi = (int)pend; pend = __hip_atomic_fetch_add(qhead, 1u, __ATOMIC_RELAXED, __HIP_MEMORY_SCOPE_AGENT); }
    for (;;) {
        if (ci >= NCHUNK) break;
        __syncthreads();
        const int ci_next = __builtin_amdgcn_readfirstlane(*qi);
        if (ci_next < NCHUNK) CH_LOADS(ci_next);
        {
            const int t2 = opaque_tid(), wid = __builtin_amdgcn_readfirstlane(t2 >> 6), lane = t2 & 63, r32 = lane & 31, hi = lane >> 5;
            const int mat = wid >> 2, ti = (wid >> 1) & 1, tj = wid & 1;
            f32x16 acc = {};
            if (!(ti == 0 && tj == 1)) {
                LAS unsigned char* xa = lds + (mat == 0 ? L_KB16 : L_QB16) + (32 * ti + r32) * RS16 + hi * 16;
                LAS unsigned char* xb = lds + L_KB16 + (32 * tj + r32) * RS16 + hi * 16;
#pragma unroll
                for (int ks = 0; ks < 8; ++ks) acc = __builtin_amdgcn_mfma_f32_32x32x16_bf16(*(LAS bf16x8*)(xa + ks * 32), *(LAS bf16x8*)(xb + ks * 32), acc, 0, 0, 0);
            }
            const int jc = 32 * tj + r32; const float gj = GAM[jc];
#pragma unroll
            for (int r = 0; r < 16; ++r) {
                const int i = 32 * ti + att::crow(r, hi);
                const float dec = __expf(fminf(GAM[i] - gj, 0.f));
                if (mat == 0) AM[i * AMLD + jc] = (jc < i) ? acc[r] * BETA[i] * dec : 0.f;
                else ATg[(size_t)ci * 4096 + i * 64 + jc] = f2bf((jc <= i) ? acc[r] * dec : 0.f);
            }
        }
        __syncthreads();
        const int tid3 = opaque_tid();
        {
            { const int i = tid3 >> 3, c0 = (tid3 & 7) * 16; const float eg = __expf(GAM[i]);
#pragma unroll
              for (int q8 = 0; q8 < 2; ++q8) { const u32x4 x = *(LAS u32x4*)(lds + L_QB16 + i * RS16 + (c0 + q8 * 8) * 2);
                  u32x4 w; w.x = cvt_pk_bf16(bflo(x.x) * eg, bfhi(x.x) * eg); w.y = cvt_pk_bf16(bflo(x.y) * eg, bfhi(x.y) * eg);
                  w.z = cvt_pk_bf16(bflo(x.z) * eg, bfhi(x.z) * eg); w.w = cvt_pk_bf16(bflo(x.w) * eg, bfhi(x.w) * eg);
                  *(u32x4*)(QGg + (size_t)ci * 8192 + i * 128 + c0 + q8 * 8) = w; } }
            { const int dk = tid3 >> 2, i0 = (tid3 & 3) * 16; const float gl = GAM[63];
#pragma unroll
              for (int q8 = 0; q8 < 2; ++q8) { float v[8];
#pragma unroll
                  for (int e = 0; e < 8; ++e) { const int i = i0 + q8 * 8 + e; v[e] = bf2f(*(LAS bf16_t*)(lds + L_KB16 + i * RS16 + dk * 2)) * __expf(gl - GAM[i]); }
                  u32x4 w; w.x = cvt_pk_bf16(v[0], v[1]); w.y = cvt_pk_bf16(v[2], v[3]); w.z = cvt_pk_bf16(v[4], v[5]); w.w = cvt_pk_bf16(v[6], v[7]);
                  *(u32x4*)(KTg + (size_t)ci * 8192 + dk * 64 + i0 + q8 * 8) = w; } }
        }
        {
            const int l3 = tid3 & 63, ln = l3 & 15, lk = l3 >> 4, w3 = __builtin_amdgcn_readfirstlane(tid3 >> 6);
            LAS float* Ro = R; LAS float* AMo = AM;
            asm volatile("" : "+v"(Ro), "+v"(AMo));
#pragma unroll
            for (int bb = 0; bb < 4; ++bb) {
                if (bb > 0) {
                    const int col0 = w3 * 32 + ln, col1 = col0 + 16;
                    f32x4 c0v, c1v;
#pragma unroll
                    for (int r = 0; r < 4; ++r) { c0v[r] = Ro[(16 * bb + 4 * lk + r) * RLD + col0]; c1v[r] = Ro[(16 * bb + 4 * lk + r) * RLD + col1]; }
#pragma unroll
                    for (int bp = 0; bp < bb; ++bp)
#pragma unroll
                        for (int s = 0; s < 4; ++s) {
                            const float am = -AMo[(16 * bb + ln) * AMLD + 16 * bp + 4 * s + lk];
                            const float x0 = Ro[(16 * bp + 4 * s + lk) * RLD + col0], x1 = Ro[(16 * bp + 4 * s + lk) * RLD + col1];
                            c0v = __builtin_amdgcn_mfma_f32_16x16x4f32(am, x0, c0v, 0, 0, 0);
                            c1v = __builtin_amdgcn_mfma_f32_16x16x4f32(am, x1, c1v, 0, 0, 0);
                        }
#pragma unroll
                    for (int r = 0; r < 4; ++r) { Ro[(16 * bb + 4 * lk + r) * RLD + col0] = c0v[r]; Ro[(16 * bb + 4 * lk + r) * RLD + col1] = c1v[r]; }
                    __syncthreads();
                }
                if (tid3 < 256) {
                    LAS float* rc = Ro + (16 * bb) * RLD + tid3;
                    float x[16];
#pragma unroll
                    for (int i = 0; i < 16; ++i) x[i] = rc[i * RLD];
#pragma unroll
                    for (int i = 1; i < 16; ++i) {
#pragma unroll
                        for (int j4 = 0; j4 < (i + 3) / 4; ++j4) {
                            const f32x4 am = *(LAS f32x4*)(AMo + (16 * bb + i) * AMLD + 16 * bb + j4 * 4);
#pragma unroll
                            for (int e = 0; e < 4; ++e) if (j4 * 4 + e < i) x[i] -= am[e] * x[j4 * 4 + e];
                        }
                    }
#pragma unroll
                    for (int i = 1; i < 16; ++i) rc[i * RLD] = x[i];
                }
                __syncthreads();
            }
        }
        if (threadIdx.x == 0) { *qi = (int)pend; pend = __hip_atomic_fetch_add(qhead, 1u, __ATOMIC_RELAXED, __HIP_MEMORY_SCOPE_AGENT); }
        {
            const int tid4 = opaque_tid();
#pragma unroll
            for (int e = 0; e < 4; ++e) { const int idx = tid4 + e * NTHR, i = idx >> 5, ch = idx & 31;
                const f32x4 a0 = *(LAS f32x4*)(R + i * RLD + ch * 8), a1 = *(LAS f32x4*)(R + i * RLD + ch * 8 + 4);
                const float sg = ch < 16 ? 1.f : -1.f;
                u32x4 w; w.x = cvt_pk_bf16(a0[0] * sg, a0[1] * sg); w.y = cvt_pk_bf16(a0[2] * sg, a0[3] * sg); w.z = cvt_pk_bf16(a1[0] * sg, a1[1] * sg); w.w = cvt_pk_bf16(a1[2] * sg, a1[3] * sg);
                *(u32x4*)((ch < 16 ? Ug : Wg) + (size_t)ci * 8192 + i * 128 + (ch & 15) * 8) = w; }
        }
        __syncthreads();
        if (ci_next < NCHUNK) CH_STEP01(ci_next);
        ci = ci_next;
    }
#undef CH_STEP01
#undef CH_LOADS
    __syncthreads();
}

__device__ __forceinline__ bf16x8 ld_afrag(const bf16_t* __restrict__ rowp, int hi) {
    const u32x2 a = *(const u32x2*)(rowp + 4 * hi), b = *(const u32x2*)(rowp + 8 + 4 * hi);
    u32x4 w = {a.x, a.y, b.x, b.y}; return *reinterpret_cast<bf16x8*>(&w);
}
__device__ __forceinline__ bf16x8 acc_bfrag(const f32x16& x, int s) {
    u32x4 w = {cvt_pk_bf16(x[8 * s + 0], x[8 * s + 1]), cvt_pk_bf16(x[8 * s + 2], x[8 * s + 3]), cvt_pk_bf16(x[8 * s + 4], x[8 * s + 5]), cvt_pk_bf16(x[8 * s + 6], x[8 * s + 7])};
    return *reinterpret_cast<bf16x8*>(&w);
}

constexpr int SL_W = 0, SL_QG = SL_W + 64 * 272, SL_KT = SL_QG + 64 * 272, SL_AT = SL_KT + 128 * 144, SL_U = SL_AT + 64 * 144, SL_OS = SL_U + 64 * 256, SL_END = SL_OS + 64 * 132 * 4;
static_assert(SL_END <= LDS_BARW, "scan lds");
__device__ __forceinline__ bf16x8 ld_afrag_lds(const LAS unsigned char* rowp, int hi) {
    const u32x2 a = *(const LAS u32x2*)(rowp + 8 * hi), b = *(const LAS u32x2*)(rowp + 16 + 8 * hi);
    u32x4 w = {a.x, a.y, b.x, b.y}; return *reinterpret_cast<bf16x8*>(&w);
}
__device__ __forceinline__ void scan_item(const Frame& F, int bh, const bf16_t* __restrict__ proj, bf16_t* __restrict__ mix, const float* __restrict__ gnorm) {
    LAS unsigned char* lds = F.lds;
    const int tid = opaque_tid(), wid = __builtin_amdgcn_readfirstlane(tid >> 6), lane = tid & 63, r32 = lane & 31, hi = lane >> 5;
    unsigned char* ws = F.ws;
    const bf16_t* Ug = (const bf16_t*)(ws + WS_G_U); const bf16_t* Wg = (const bf16_t*)(ws + WS_G_W); const bf16_t* QGg = (const bf16_t*)(ws + WS_G_QG); const bf16_t* KTg = (const bf16_t*)(ws + WS_G_KT);
    const bf16_t* ATg = (const bf16_t*)(ws + WS_G_ATT); const float* GLg = (const float*)(ws + WS_G_GL);
    LAS float* OS = (LAS float*)(lds + SL_OS);
    const int b = bh >> 3, h = bh & 7;
    const bool loader = wid >= 4;
    u32x4 st[18];
#define SCAN_LOAD(ci_) do { const size_t c_ = (size_t)(ci_); const int lt = opaque_tid() & 255;     \
        _Pragma("unroll") for (int e = 0; e < 4; ++e) { const int idx = lt + 256 * e; \
            st[e]      = *(const u32x4*)(Wg  + c_ * 8192 + (idx >> 4) * 128 + (idx & 15) * 8); \
            st[4 + e]  = *(const u32x4*)(QGg + c_ * 8192 + (idx >> 4) * 128 + (idx & 15) * 8); \
            st[8 + e]  = *(const u32x4*)(KTg + c_ * 8192 + (idx >> 3) * 64 + (idx & 7) * 8); \
            st[12 + e] = *(const u32x4*)(Ug  + c_ * 8192 + (idx >> 4) * 128 + (idx & 15) * 8); } \
        _Pragma("unroll") for (int e = 0; e < 2; ++e) { const int idx = lt + 256 * e; st[16 + e] = *(const u32x4*)(ATg + c_ * 4096 + (idx >> 3) * 64 + (idx & 7) * 8); } } while (0)
#define SCAN_STORE() do { const int lt = opaque_tid() & 255; \
        _Pragma("unroll") for (int e = 0; e < 4; ++e) { const int idx = lt + 256 * e; \
            *(LAS u32x4*)(lds + SL_W  + (idx >> 4) * 272 + (idx & 15) * 16) = st[e]; \
            *(LAS u32x4*)(lds + SL_QG + (idx >> 4) * 272 + (idx & 15) * 16) = st[4 + e]; \
            *(LAS u32x4*)(lds + SL_KT + (idx >> 3) * 144 + (idx & 7) * 16) = st[8 + e]; \
            *(LAS u32x4*)(lds + SL_U  + (idx >> 4) * 256 + (idx & 15) * 16) = st[12 + e]; } \
        _Pragma("unroll") for (int e = 0; e < 2; ++e) { const int idx = lt + 256 * e; *(LAS u32x4*)(lds + SL_AT + (idx >> 3) * 144 + (idx & 7) * 16) = st[16 + e]; } } while (0)
    const int ci0 = bh * 64;
    const int ni = tid >> 3, nc0 = (tid & 7) * 16;
    const bf16_t* zbase = proj + (size_t)(b * T + ni) * OD_NP + OC_Z + h * 128 + nc0;
    u32x4 z0 = *(const u32x4*)zbase, z1 = *(const u32x4*)(zbase + 8);
    float glv = GLg[ci0];
    if (loader) SCAN_LOAD(ci0);
    __syncthreads();
    if (loader) { SCAN_STORE(); SCAN_LOAD(ci0 + 1); }
    __syncthreads();
    f32x16 S[4] = {};
#pragma unroll 1
    for (int n = 0; n < 64; ++n) {
        if (!loader) {
            const int c0 = 32 * wid;
            bf16x8 vb[2][2];
#pragma unroll
            for (int mt = 0; mt < 2; ++mt) {
                f32x16 vn;
#pragma unroll
                for (int r = 0; r < 16; ++r) vn[r] = bf2f(*(const LAS bf16_t*)(lds + SL_U + (32 * mt + att::crow(r, hi)) * 256 + (c0 + r32) * 2));
                const LAS unsigned char* wrow = lds + SL_W + (32 * mt + r32) * 272;
#pragma unroll
                for (int kt = 0; kt < 4; ++kt)
#pragma unroll
                    for (int s = 0; s < 2; ++s) vn = __builtin_amdgcn_mfma_f32_32x32x16_bf16(ld_afrag_lds(wrow + (kt * 32 + s * 16) * 2, hi), acc_bfrag(S[kt], s), vn, 0, 0, 0);
                vb[mt][0] = acc_bfrag(vn, 0); vb[mt][1] = acc_bfrag(vn, 1);
            }
#pragma unroll
            for (int mt = 0; mt < 2; ++mt) {
                f32x16 oa = {};
                const LAS unsigned char* qrow = lds + SL_QG + (32 * mt + r32) * 272;
#pragma unroll
                for (int kt = 0; kt < 4; ++kt)
#pragma unroll
                    for (int s = 0; s < 2; ++s) oa = __builtin_amdgcn_mfma_f32_32x32x16_bf16(ld_afrag_lds(qrow + (kt * 32 + s * 16) * 2, hi), acc_bfrag(S[kt], s), oa, 0, 0, 0);
                const LAS unsigned char* arow = lds + SL_AT + (32 * mt + r32) * 144;
#pragma unroll
                for (int m2 = 0; m2 <= mt; ++m2)
#pragma unroll
                    for (int s = 0; s < 2; ++s) oa = __builtin_amdgcn_mfma_f32_32x32x16_bf16(ld_afrag_lds(arow + (m2 * 32 + s * 16) * 2, hi), vb[m2][s], oa, 0, 0, 0);
#pragma unroll
                for (int r = 0; r < 16; ++r) OS[(32 * mt + att::crow(r, hi)) * 132 + c0 + r32] = oa[r];
            }
#pragma unroll
            for (int kt = 0; kt < 4; ++kt) {
#pragma unroll
                for (int r = 0; r < 16; ++r) S[kt][r] *= glv;
                const LAS unsigned char* krow = lds + SL_KT + (32 * kt + r32) * 144;
#pragma unroll
                for (int m2 = 0; m2 < 2; ++m2)
#pragma unroll
                    for (int s = 0; s < 2; ++s) S[kt] = __builtin_amdgcn_mfma_f32_32x32x16_bf16(ld_afrag_lds(krow + (m2 * 32 + s * 16) * 2, hi), vb[m2][s], S[kt], 0, 0, 0);
            }
        }
        __syncthreads();
        {
            const int t = n * 64 + ni;
            float v[16]; float ss = 0.f;
#pragma unroll
            for (int q = 0; q < 4; ++q) { const f32x4 x = *(LAS f32x4*)(OS + ni * 132 + nc0 + q * 4); v[q * 4] = x[0]; v[q * 4 + 1] = x[1]; v[q * 4 + 2] = x[2]; v[q * 4 + 3] = x[3]; }
#pragma unroll
            for (int q = 0; q < 16; ++q) ss += v[q] * v[q];
            ss += shx(ss, 1); ss += shx(ss, 2); ss += shx(ss, 4);
            const float rn = rsqrtf(ss * (1.f / 128.f) + EPS);
            const float z[16] = {bflo(z0.x), bfhi(z0.x), bflo(z0.y), bfhi(z0.y), bflo(z0.z), bfhi(z0.z), bflo(z0.w), bfhi(z0.w),
                                 bflo(z1.x), bfhi(z1.x), bflo(z1.y), bfhi(z1.y), bflo(z1.z), bfhi(z1.z), bflo(z1.w), bfhi(z1.w)};
            float y[16];
#pragma unroll
            for (int q = 0; q < 16; ++q) y[q] = v[q] * rn * gnorm[nc0 + q] * siluf_(z[q]);
            u32x4 w0, w1;
            w0.x = cvt_pk_bf16(y[0], y[1]); w0.y = cvt_pk_bf16(y[2], y[3]); w0.z = cvt_pk_bf16(y[4], y[5]); w0.w = cvt_pk_bf16(y[6], y[7]);
            w1.x = cvt_pk_bf16(y[8], y[9]); w1.y = cvt_pk_bf16(y[10], y[11]); w1.z = cvt_pk_bf16(y[12], y[13]); w1.w = cvt_pk_bf16(y[14], y[15]);
            bf16_t* mrow = mix + (size_t)(b * T + t) * D + 1024 + h * 128 + nc0;
            *(u32x4*)mrow = w0; *(u32x4*)(mrow + 8) = w1;
            if (n + 1 < 64) { const bf16_t* zn = zbase + (size_t)((n + 1) * 64) * OD_NP; z0 = *(const u32x4*)zn; z1 = *(const u32x4*)(zn + 8); glv = GLg[ci0 + n + 1]; }
        }
        if (loader && n + 1 < 64) { SCAN_STORE(); if (n + 2 < 64) SCAN_LOAD(ci0 + n + 2); }
        __syncthreads();
    }
#undef SCAN_LOAD
#undef SCAN_STORE
}
}
namespace pg8 {
struct EpiProjOdd {
    static constexpr bool PERM = true;
    bf16_t* O; int ldc; bf16_t* kcmp; bf16_t* vcmp; const float* rs;
    __device__ __forceinline__ void prefetch(const Unit& u, int ui) const { rs_prefetch(rs, u.pm, ui); }
    __device__ __forceinline__ void operator()(const f32x4 (&acc)[2][2][4][2], const Unit& u, int wr, int wc, int ui, int) const {
        const int ol_ = opaque_tid() & 63, fr = ol_ & 15, fq = ol_ >> 4;
        const int row0 = u.pm * BM + wr * 64 + fr, col0 = u.pn * BM + wc * 32 + 8 * fq;
        const bool cmp = (u.pn == 8 || u.pn == 9);
        bf16_t* cb = (u.pn == 8) ? kcmp : vcmp;
        float r_[2][4];
        rs_read(r_, ui, wr, fr);
#pragma unroll
        for (int ai = 0; ai < 2; ++ai)
#pragma unroll
            for (int m = 0; m < 4; ++m) { const int row = row0 + ai * HALF + m * 16; const float r = r_[ai][m];
#pragma unroll
                for (int bj = 0; bj < 2; ++bj) { const f32x4 v0 = acc[ai][bj][m][0] * r, v1 = acc[ai][bj][m][1] * r;
                    u32x4 w; w.x = cvt_pk_bf16(v0[0], v0[1]); w.y = cvt_pk_bf16(v0[2], v0[3]); w.z = cvt_pk_bf16(v1[0], v1[1]); w.w = cvt_pk_bf16(v1[2], v1[3]);
                    bf16_t* p = cmp ? cb + ((size_t)((row / T) * 2 + bj) * T + (row % T)) * 128 + wc * 32 + 8 * fq
                                    : O + (size_t)row * ldc + col0 + bj * HALF;
                    *(u32x4*)p = w; } }
    }
};
__device__ __forceinline__ float gelu_tanh(float x) { const float y = 0.7978845608028654f * (x + 0.044715f * x * x * x); return x * __builtin_amdgcn_rcpf(1.f + __expf(-2.f * y)); }
struct EpiGeluBf16 {
    static constexpr bool PERM = true;
    bf16_t* O; int ldc; const float* bias;
    __device__ __forceinline__ void prefetch(const Unit&, int) const {}
    __device__ __forceinline__ void operator()(const f32x4 (&acc)[2][2][4][2], const Unit& u, int wr, int wc, int, int) const {
        const int ol_ = opaque_tid() & 63, fr = ol_ & 15, fq = ol_ >> 4;
        const int row0 = u.pm * BM + wr * 64 + fr, col0 = u.pn * BM + wc * 32 + 8 * fq;
#pragma unroll
        for (int bj = 0; bj < 2; ++bj) { f32x4 b0 = (f32x4){0.f, 0.f, 0.f, 0.f}, b1 = b0;
#pragma unroll 8
            for (int pp = 0; pp < 32; ++pp) { b0 += *(const f32x4*)(bias + pp * 256 + col0 + bj * HALF); b1 += *(const f32x4*)(bias + pp * 256 + col0 + bj * HALF + 4); }
#pragma unroll
            for (int ai = 0; ai < 2; ++ai)
#pragma unroll
                for (int m = 0; m < 4; ++m) { const f32x4 v0 = acc[ai][bj][m][0] + b0, v1 = acc[ai][bj][m][1] + b1;
                    u32x4 w; w.x = cvt_pk_bf16(gelu_tanh(v0[0]), gelu_tanh(v0[1])); w.y = cvt_pk_bf16(gelu_tanh(v0[2]), gelu_tanh(v0[3]));
                    w.z = cvt_pk_bf16(gelu_tanh(v1[0]), gelu_tanh(v1[1])); w.w = cvt_pk_bf16(gelu_tanh(v1[2]), gelu_tanh(v1[3]));
                    *(u32x4*)(O + (size_t)(row0 + ai * HALF + m * 16) * ldc + col0 + bj * HALF) = w; } }
    }
};
}

namespace nsa {
using namespace att;
constexpr int IMP_LD = 257, SC_LD = 65;
constexpr int L_IMP = 2 * att::KVBUF, L_SC = L_IMP + 64 * IMP_LD * 4  , L_WS = L_SC + 64 * SC_LD * 4, L_TAB = L_WS + 2048, L_BM = L_TAB + 8 * 129 * 4, L_QI = L_BM + 512, L_GATE = L_QI + 16  , L_ENDN = L_GATE + 4096;
static_assert(L_ENDN <= LDS_BARW && (L_IMP % 16) == 0 && L_IMP + 2 * att::KVBUF <= L_SC, "nsa lds");

template <int MODE>
__device__ __forceinline__ void branch_out(const f32x16* o, const float* rs, float* __restrict__ accw, bf16_t* __restrict__ Ow, int ldo, int, int) {
    const int l_ = opaque_tid() & 63, r32 = l_ & 31, hi = l_ >> 5;
    float* base = accw + 4 * hi * 128 + r32;
    float a[16][4];
    if (MODE != 0) {
#pragma unroll
        for (int r = 0; r < 16; ++r)
#pragma unroll
            for (int d0 = 0; d0 < 4; ++d0) a[r][d0] = base[((r & 3) + 8 * (r >> 2)) * 128 + d0 * 32];
    }
    if (MODE != 2) {
#pragma unroll
        for (int r = 0; r < 16; ++r)
#pragma unroll
            for (int d0 = 0; d0 < 4; ++d0) { const float v = o[d0][r] * rs[r]; base[((r & 3) + 8 * (r >> 2)) * 128 + d0 * 32] = (MODE == 0) ? v : a[r][d0] + v; }
    } else {
        unsigned w[16][4];
#pragma unroll
        for (int r = 0; r < 16; ++r)
#pragma unroll
            for (int d0 = 0; d0 < 4; ++d0) { const float v = o[d0][r] * rs[r] + a[r][d0]; const float vn = DPPF(v, 0xB1); w[r][d0] = cvt_pk_bf16(v, vn); }
        if ((r32 & 1) == 0) {
#pragma unroll
            for (int r = 0; r < 16; ++r) { const int orow = crow(r, hi);
#pragma unroll
                for (int d0 = 0; d0 < 4; ++d0) *(unsigned*)(Ow + (size_t)(orow >> 2) * ldo + (orow & 3) * 128 + d0 * 32 + r32) = w[r][d0]; }
        }
    }
}

__device__ __forceinline__ void nsa_item(const Frame& F, int item, const bf16_t* __restrict__ proj, bf16_t* __restrict__ mix, const float* __restrict__ relb) {
    LAS unsigned char* lds = F.lds;
    const int tid = opaque_tid(), wid = __builtin_amdgcn_readfirstlane(tid >> 6), lane = tid & 63, r32 = lane & 31, hi = lane >> 5;
    unsigned char* ws = F.ws;
    LAS float* al_l = (LAS float*)(lds + L_WS) + wid * 64;
    LAS float* tab = (LAS float*)(lds + L_TAB);
    LAS float* IMP = (LAS float*)(lds + L_IMP);
    LAS float* SC = (LAS float*)(lds + L_SC);
    LAS unsigned* BM = (LAS unsigned*)(lds + L_BM);
    const int vb0 = (int)(uintptr_t)(lds + L_V) + v_rd_base(lane);
    constexpr int LD = OD_NP;
    const int qb = 63 - (item >> 4), bg = item & 15, b = bg >> 1, g = bg & 1;
    const int P0 = qb * 64, qlo = P0 + wid * 8, qhi = qlo + 7, ql = wid * 8 + (r32 >> 2), hl = r32 & 3, head = g * 4 + hl, qpos = qlo + (r32 >> 2), cur = qb;
    float* accw = (float*)(ws + WS_NSAACC) + ((size_t)F.bid * 256 + wid * 32) * 128;
    __syncthreads();
    for (int i = tid; i < 64 * IMP_LD; i += NTHR) IMP[i] = 0.f;
    if (tid < 128) BM[tid] = 0u;
    const size_t qrow = (size_t)(b * T + qpos) * LD;
    bf16x8 qr[8];
#pragma unroll
    for (int d0 = 0; d0 < 8; ++d0) qr[d0] = *(const bf16x8*)(proj + qrow + OC_QC + head * 128 + d0 * 16 + hi * 8);
    { u32x2 gg; gg.x = (unsigned)proj[qrow + OC_GATE + head] | ((unsigned)proj[qrow + OC_GATE + 8 + head] << 16); gg.y = proj[qrow + OC_GATE + 16 + head];
      *(LAS u32x2*)(lds + L_GATE + tid * 8) = gg; }
#define gate01_ (((const LAS unsigned*)(lds + L_GATE))[opaque_tid() * 2])
#define gate2_  (((const LAS unsigned*)(lds + L_GATE))[opaque_tid() * 2 + 1])
#define NSA_GATE(br) sigmoidf_((br) == 0 ? bflo(gate01_) : (br) == 1 ? bfhi(gate01_) : bflo(gate2_))
    const LAS float* tb = tab + head * 129;
    const float NEG = -__builtin_inff();

    const bf16_t* KCg = (const bf16_t*)(ws + WS_KC) + (size_t)(bg * 256) * 256;
    const bf16_t* VCg = KCg + (size_t)4096 * 256;
    const int cmax = (qpos - 31) >> 4;
    const int cmax_wg = (P0 + 63 - 31) >> 4;
    const int nct = (cmax_wg >> 6) + 1;
    float m_reg = -1e30f, l_reg = 0.f;
    {
        const KvOff kc = kv_dma_off(tid, 256);
        kv_dma(lds, KCg, VCg, 256, kc, wid);
        float inv_l = 0.f, mL = 0.f;
        f32x16 o[4] = {};
        for (int s = 0; s < 2 * nct; ++s) {
            const int jt = s < nct ? s : s - nct, bo = (s & 1) * KVBUF;
            asm volatile("s_waitcnt vmcnt(0)" ::: "memory");
            RING_BAR();
            if (s + 1 < 2 * nct) { const int jn = (s + 1 < nct) ? s + 1 : s + 1 - nct; kv_dma(lds + (bo ^ KVBUF), KCg + (size_t)(jn * 64) * 256, VCg + (size_t)(jn * 64) * 256, 256, kc, wid); }
            if (s == nct) { inv_l = l_reg > 0.f ? 1.f / l_reg : 0.f; mL = -m_reg * C2; }
            f32x16 p0, p1; qkt(p0, p1, lds + bo, r32, hi, qr);
            if (s < nct) {
#pragma unroll
                for (int r = 0; r < 16; ++r) { const int c = jt * 64 + crow(r, hi); if (c > cmax) p0[r] = NEG; if (c + 32 > cmax) p1[r] = NEG; }
                float mn, alpha; partialSM(p0, p1, m_reg, mn, alpha);
                l_reg = l_reg * alpha + row_sum(p0, p1);
            } else {
                LAS float* ib = IMP + ql * IMP_LD + jt * 64 + 4 * hi;
#pragma unroll
                for (int r = 0; r < 16; ++r) { const int c = jt * 64 + crow(r, hi);
                    p0[r] = (c <= cmax) ? __builtin_amdgcn_exp2f(fmaf(p0[r], C2, mL)) * inv_l : 0.f;
                    p1[r] = (c + 32 <= cmax) ? __builtin_amdgcn_exp2f(fmaf(p1[r], C2, mL)) * inv_l : 0.f;
                    float s0 = p0[r], s1 = p1[r];
                    s0 += DPPF(s0, 0xB1); s1 += DPPF(s1, 0xB1); s0 += DPPF(s0, 0x4E); s1 += DPPF(s1, 0x4E);
                    if (hl == 0) { ib[(r & 3) + 8 * (r >> 2)] = s0; ib[(r & 3) + 8 * (r >> 2) + 32] = s1; } }
                bf16x8 pa0, pa1, pa2, pa3; pack_p(p0, p1, pa0, pa1, pa2, pa3);
                pv_tile(o, vb0 + bo, pa0, pa1, pa2, pa3);
            }
        }
        float rs[16]; lanes_to_rows(NSA_GATE(0), rs, al_l, r32, hi);
        branch_out<0>(o, rs, accw, nullptr, 0, r32, hi);
    }
    __syncthreads();
    {
        const int q = tid & 63, j0 = (tid >> 6) * 8;
        const LAS float* ip = IMP + q * IMP_LD;
#pragma unroll
        for (int e = 0; e < 8; ++e) { const int j = j0 + e;
            const float left = (j > 0) ? ip[4 * j - 1] : 0.f;
            const float blk = left + 2.f * (ip[4 * j] + ip[4 * j + 1] + ip[4 * j + 2]) + ip[4 * j + 3];
            const bool forced = (j == 0) || (j == cur) || (j == cur - 1);
            SC[q * SC_LD + j] = forced ? 1e9f : (j > cur ? -1e9f : blk); }
    }
    __syncthreads();
    {
        const int q = tid & 63, j0 = (tid >> 6) * 8;
        unsigned long long mine[8]; int rank[8];
#define NSA_KEY(sc_, j_) ((((unsigned long long)(__float_as_uint(sc_) ^ ((__float_as_uint(sc_) >> 31) ? 0xffffffffu : 0x80000000u))) << 6) | (unsigned)(63 - (j_)))
#pragma unroll
        for (int e = 0; e < 8; ++e) { const float v = SC[q * SC_LD + j0 + e]; mine[e] = NSA_KEY(v, j0 + e); rank[e] = 0; }
#pragma unroll 2
        for (int jj = 0; jj <= cur; ++jj) { const float sv = SC[q * SC_LD + jj]; const unsigned long long ks = NSA_KEY(sv, jj);
#pragma unroll
            for (int e = 0; e < 8; ++e) rank[e] += (ks > mine[e]) ? 1 : 0; }
#undef NSA_KEY
        unsigned bits = 0u;
#pragma unroll
        for (int e = 0; e < 8; ++e) if (rank[e] < 8 && (j0 + e) <= cur) bits |= 1u << e;
        if (bits) __hip_atomic_fetch_or(BM + q * 2 + (j0 >> 5), bits << (j0 & 31), __ATOMIC_RELAXED, __HIP_MEMORY_SCOPE_WORKGROUP);
    }
    __syncthreads();
    unsigned wu_lo, wu_hi, gu_lo, gu_hi;
    {
        unsigned a = 0u, c = 0u;
#pragma unroll
        for (int i = 0; i < 8; ++i) { a |= BM[(wid * 8 + i) * 2]; c |= BM[(wid * 8 + i) * 2 + 1]; }
        wu_lo = __builtin_amdgcn_readfirstlane(a); wu_hi = __builtin_amdgcn_readfirstlane(c);
        const int ln_ = opaque_tid() & 63;
        int a2 = (int)BM[ln_ * 2], c2 = (int)BM[ln_ * 2 + 1];
#define DPPI(x, ctrl) __builtin_amdgcn_update_dpp(0, (x), (ctrl), 0xf, 0xf, true)
        a2 |= DPPI(a2, 0x128); c2 |= DPPI(c2, 0x128); a2 |= DPPI(a2, 0x124); c2 |= DPPI(c2, 0x124);
        a2 |= DPPI(a2, 0x122); c2 |= DPPI(c2, 0x122); a2 |= DPPI(a2, 0x121); c2 |= DPPI(c2, 0x121);
#undef DPPI
        gu_lo = (unsigned)(__builtin_amdgcn_readlane(a2, 0) | __builtin_amdgcn_readlane(a2, 16) | __builtin_amdgcn_readlane(a2, 32) | __builtin_amdgcn_readlane(a2, 48));
        gu_hi = (unsigned)(__builtin_amdgcn_readlane(c2, 0) | __builtin_amdgcn_readlane(c2, 16) | __builtin_amdgcn_readlane(c2, 32) | __builtin_amdgcn_readlane(c2, 48));
    }
    {
        const int tid = opaque_tid(), lane = tid & 63, r32 = lane & 31, hi = lane >> 5, qpos = qlo + (r32 >> 2), ql = wid * 8 + (r32 >> 2);
        const int vb0 = (int)(uintptr_t)(lds + L_V) + v_rd_base(lane);
        const KvOff ko = kv_dma_off(tid, LD);
        const bf16_t* Kg = proj + (size_t)(b * T) * LD + OC_KSEL + g * 128;
        const bf16_t* Vg = proj + (size_t)(b * T) * LD + OC_VSEL + g * 128;
        m_reg = -1e30f; l_reg = 0.f; f32x16 o[4] = {};
        unsigned long long remI = ((unsigned long long)gu_hi << 32) | gu_lo, remC = remI;
        const int nT = __builtin_popcountll(remI);
#define SEL_ISSUE(k_) do { const int jn = __builtin_ctzll(remI); remI &= remI - 1; kv_dma(lds + ((k_) & 3) * KVBUF, Kg + (size_t)(jn * 64) * LD, Vg + (size_t)(jn * 64) * LD, LD, ko, wid); } while (0)
        int jt = 0, kb = 0;
        dual_attn<4, 4>(nT, wid, lds, vb0, qr, o, m_reg, l_reg, al_l, r32, hi,
            [&](int k) { SEL_ISSUE(k); },
            [&](int) { jt = __builtin_ctzll(remC); remC &= remC - 1; kb = jt * 64; return ((jt < 32 ? wu_lo >> jt : wu_hi >> (jt - 32)) & 1u) != 0u; },
            [&](int, f32x16& p0, f32x16& p1) {
                const bool mysel = ((BM[ql * 2 + (jt >> 5)] >> (jt & 31)) & 1u) != 0u;
                const int dq = qpos - kb - 4 * hi;
                if (qlo - kb >= 190) {
                    const float tc = tb[127];
#pragma unroll
                    for (int r = 0; r < 16; ++r) { p0[r] = mysel ? p0[r] + tc : NEG; p1[r] = mysel ? p1[r] + tc : NEG; }
                } else {
#pragma unroll
                for (int r = 0; r < 16; ++r) { const int c = (r & 3) + 8 * (r >> 2); const int d0_ = dq - c, d1_ = dq - c - 32;
                    float t0 = tb[min(max(d0_, 0), 127)], t1 = tb[min(max(d1_, 0), 127)];
                    asm("" : "+v"(t0), "+v"(t1));
                    p0[r] = (mysel && d0_ >= 0) ? p0[r] + t0 : NEG; p1[r] = (mysel && d1_ >= 0) ? p1[r] + t1 : NEG; }
                }
            });
#undef SEL_ISSUE
        float rs[16]; lanes_to_rows(l_reg > 0.f ? NSA_GATE(1) * __builtin_amdgcn_rcpf(l_reg) : 0.f, rs, al_l, r32, hi);
        branch_out<1>(o, rs, accw, nullptr, 0, r32, hi);
    }
    {
        const int tid = opaque_tid(), lane = tid & 63, r32 = lane & 31, hi = lane >> 5, qpos = qlo + (r32 >> 2);
        const int vb0 = (int)(uintptr_t)(lds + L_V) + v_rd_base(lane);
        const KvOff ko = kv_dma_off(tid, LD);
        const bf16_t* Kg = proj + (size_t)(b * T) * LD + OC_KWIN + g * 128;
        const bf16_t* Vg = proj + (size_t)(b * T) * LD + OC_VWIN + g * 128;
        m_reg = -1e30f; l_reg = 0.f; f32x16 o[4] = {};
        const int jt0 = (qb >= 8 ? qb - 8 : 0), nT = qb - jt0 + 1;
#define WIN_ISSUE(k_) kv_dma(lds + ((k_) & 3) * KVBUF, Kg + (size_t)((jt0 + (k_)) * 64) * LD, Vg + (size_t)((jt0 + (k_)) * 64) * LD, LD, ko, wid)
        __syncthreads();
        int kb = 0;
        dual_attn<4, 4>(nT, wid, lds, vb0, qr, o, m_reg, l_reg, al_l, r32, hi,
            [&](int k) { WIN_ISSUE(k); },
            [&](int s) { kb = (jt0 + s) * 64; return kb <= qhi && kb + 63 >= qlo - 511; },
            [&](int, f32x16& p0, f32x16& p1) {
                const int dq = qpos - kb - 4 * hi;
                if (qlo - kb >= 190 && qhi - kb <= 511) {
                    const float tc = tb[127];
#pragma unroll
                    for (int r = 0; r < 16; ++r) { p0[r] += tc; p1[r] += tc; }
                } else {
#pragma unroll
                for (int r = 0; r < 16; ++r) { const int c = (r & 3) + 8 * (r >> 2); const int d0_ = dq - c, d1_ = dq - c - 32;
                    float t0 = tb[min(max(d0_, 0), 127)], t1 = tb[min(max(d1_, 0), 127)];
                    asm("" : "+v"(t0), "+v"(t1));
                    p0[r] = ((unsigned)d0_ < 512u) ? p0[r] + t0 : NEG; p1[r] = ((unsigned)d1_ < 512u) ? p1[r] + t1 : NEG; }
                }
            });
#undef WIN_ISSUE
        float rs[16]; lanes_to_rows(l_reg > 0.f ? NSA_GATE(2) * __builtin_amdgcn_rcpf(l_reg) : 0.f, rs, al_l, r32, hi);
        branch_out<2>(o, rs, accw, mix + (size_t)(b * T + qlo) * D + g * 512, D, r32, hi);
    }
#undef NSA_GATE
#undef gate01_
#undef gate2_
}

__device__ __forceinline__ void odd_attn_phase(const Frame& F, const bf16_t* __restrict__ proj, bf16_t* __restrict__ mix, const float* __restrict__ relb, const float* __restrict__ gnorm, unsigned* __restrict__ qhead) {
    for (int bh = F.bid; bh < NB * 8; bh += F.G) gdn::scan_item(F, bh, proj, mix, gnorm);
    LAS int* qi = (LAS int*)(F.lds + L_QI);
    __syncthreads();
    for (int i = opaque_tid(); i < 8 * 129; i += NTHR) { const int hd = i / 129, dist = i - hd * 129; ((LAS float*)(F.lds + L_TAB))[i] = relb[att::t5_bucket(dist < 128 ? dist : 127) * 8 + hd] * INV_SCALE; }
    for (;;) {
        __syncthreads();
        if (threadIdx.x == 0) *qi = (int)__hip_atomic_fetch_add(qhead, 1u, __ATOMIC_RELAXED, __HIP_MEMORY_SCOPE_AGENT);
        __syncthreads();
        const int item = __builtin_amdgcn_readfirstlane(*qi);
        if (item >= 1024) break;
        nsa_item(F, item, proj, mix, relb);
    }
    __syncthreads();
}
}

#define N_ODD_PHASES 5
#define odd_mixer_phases \
    PH_BEGIN { pg8::Gemm g{RES, (const bf16_t*)(ws + WS_W_OD_IN + j * SZ_W_OD_IN), M, OD_NP, D, D}; pg8::StaticOrder S; S.init(M, OD_NP, F.G, F.bid); \
               pg8::EpiProjOdd E{PROJ, OD_NP, (bf16_t*)(ws + WS_KCMP), (bf16_t*)(ws + WS_VCMP), RSTD}; pg8::gemm_phase(F.lds, g, S, E); } PH_END \
    PH_BEGIN { for (int kv = 0; kv < 2; ++kv) { \
                 { pg8::Gemm g{(const bf16_t*)(ws + (kv ? WS_VCMP : WS_KCMP)), (const bf16_t*)(ws + WS_W_C1 + (j * 2 + kv) * SZ_W_C1), 4096, 256, 4096, 2048}; \
                   pg8::StaticOrder S; S.init(4096, 256, F.G, (F.bid + F.G - 16 * kv) % F.G); \
                   pg8::EpiGeluBf16 E{(bf16_t*)(ws + WS_CHID) + (size_t)kv * 4096 * 256, 256, (const float*)(ws + WS_C1B) + (j * 2 + kv) * 32 * 256}; pg8::gemm_phase(F.lds, g, S, E); } \
                 asm volatile("s_waitcnt vmcnt(0)" ::: "memory"); __syncthreads();     \
                 { pg8::Gemm g{(const bf16_t*)(ws + WS_CHID) + (size_t)kv * 4096 * 256, (const bf16_t*)(ws + WS_W_C2 + (j * 2 + kv) * SZ_W_C2), 4096, 256, 256, 256}; \
                   pg8::StaticOrder S; S.init(4096, 256, F.G, (F.bid + F.G - 16 * kv) % F.G); \
                   pg8::EpiStoreBf16 E{(bf16_t*)(ws + WS_KC) + (size_t)kv * 4096 * 256, 256, nullptr}; pg8::gemm_phase(F.lds, g, S, E); } } \
               gdn::chunk_phase(F, PROJ, F.in[I_OD_CONVW] + (size_t)j * 4 * 3072, F.in[I_OD_ALOG] + j * 8, F.in[I_OD_DTB] + j * 8, F.ctl + CW_QUEUE + 64 * (2 + j)); } PH_END \
    PH_BEGIN nsa::odd_attn_phase(F, PROJ, HB, F.in[I_RELB], F.in[I_OD_GNORM] + j * 128, F.ctl + CW_QUEUE + 64 * j); PH_END \
    PH_BEGIN { pg8::Gemm g{HB, (const bf16_t*)(ws + WS_W_OD_OUT + j * SZ_W_OUT), M, D, D, D}; pg8::StaticOrder S; S.init(M, D, F.G, F.bid); \
               pg8::EpiAddRes E{RES, D}; pg8::gemm_phase(F.lds, g, S, E); } PH_END \
    PH_BEGIN rowstat_phase(F, RES, RSTD); PH_END
struct Args { const float* in[22]; float* out; unsigned char* ws; int ph_lo, ph_hi; };

#ifndef MIXERS
#define MIXERS 3
#endif

__global__ void __launch_bounds__(NTHR, 2) mega(Args args) {
    extern __shared__ __attribute__((aligned(16))) unsigned char lds_raw[];
    Frame F;
    F.lds = (LAS unsigned char*)lds_raw;
    F.G = gridDim.x; F.bid = blockIdx.x;
    F.in = (const float* const*)__builtin_amdgcn_kernarg_segment_ptr();
    F.out = args.out; F.ws = args.ws; F.ctl = (unsigned*)(args.ws + WS_CTL);
    const int lo = args.ph_lo, hi = args.ph_hi;
    volatile LAS unsigned* barw = (volatile LAS unsigned*)(F.lds + LDS_BARW);
    if (TID < 4) barw[TID] = 0u;
    __syncthreads();
    XcdBarrier bar; bar.bar = F.ctl + CW_BAR; bar.x = 0; bar.st = barw;
    if (hi - lo > 1) bar = xcd_barrier_post(F.ctl + CW_BAR, barw);
    int ph = 0;
#define PH_BEGIN if (lo <= ph && ph < hi) {
#define PH_END   if (ph + 1 < hi) xcd_barrier(bar); } ++ph;
    unsigned char* ws = F.ws;
    bf16_t* HB = (bf16_t*)F.out;
    bf16_t* RES = (bf16_t*)(ws + WS_RES);
    float* RSTD = F.out + (size_t)M * D / 2;
    bf16_t* PROJ = (bf16_t*)(ws + WS_PROJ);

    PH_BEGIN p0_prologue(F); PH_END
    PH_BEGIN rowstat_f_phase(F, RES, RSTD, (const bf16_t*)(ws + WS_W_EV_IN) + (size_t)EC_F * D, PROJ); PH_END

    for (int layer = 0; layer < 4; ++layer) {
        const int j = layer >> 1;
        if ((layer & 1) == 0) {
#if (MIXERS & 1)
            even_mixer_phases
#endif
        } else {
#if (MIXERS & 2)
            odd_mixer_phases
#endif
        }
        PH_BEGIN {
            pg8::Gemm g{RES, (const bf16_t*)(ws + WS_W_UP + layer * SZ_W_UP), M, FF2, D, D};
            pg8::StaticOrder S; S.init(M, FF2, F.G, F.bid);
            pg8::EpiFfnGate E{(bf16_t*)(ws + WS_ACT), F.in[I_F_CONVW] + (size_t)layer * 3 * FF, F.in[I_F_CONVB] + (size_t)layer * FF,
                              (float*)(ws + WS_TAIL), (float*)(ws + WS_HEADG), (float*)(ws + WS_HEADU), F.lds + 131072, RSTD};
            pg8::gemm_phase(F.lds, g, S, E);
        } PH_END
        PH_BEGIN
            ffn_fixup_phase(F, (bf16_t*)(ws + WS_ACT), (const float*)(ws + WS_TAIL), (const float*)(ws + WS_HEADG), (const float*)(ws + WS_HEADU),
                            F.in[I_F_CONVW] + (size_t)layer * 3 * FF, F.in[I_F_CONVB] + (size_t)layer * FF);
        PH_END
        PH_BEGIN {
            pg8::Gemm g{(const bf16_t*)(ws + WS_ACT), (const bf16_t*)(ws + WS_W_DN + layer * SZ_W_DN), M, D, FF, FF};
            pg8::StaticOrder S; S.init(M, D, F.G, F.bid);
            pg8::EpiAddRes E{RES, D};
            pg8::gemm_phase(F.lds, g, S, E);
        } PH_END
        if (layer == 1) { PH_BEGIN rowstat_f_phase(F, RES, RSTD, (const bf16_t*)(ws + WS_W_EV_IN + SZ_W_EV_IN) + (size_t)EC_F * D, PROJ); PH_END }
        else if (layer < 3) { PH_BEGIN rowstat_phase(F, RES, RSTD); PH_END }
        else { PH_BEGIN final_norm_phase(F, RES, F.out, F.in[I_NFIN]); PH_END }
    }
#undef PH_BEGIN
#undef PH_END
}

static int count_phases() {
    int ph = 2;
    for (int layer = 0; layer < 4; ++layer) {
        if ((layer & 1) == 0) { if (MIXERS & 1) ph += N_EVEN_PHASES; } else { if (MIXERS & 2) ph += N_ODD_PHASES; }
        ph += 3; ph += 1;
    }
    return ph;
}

#ifndef N_LAUNCH_MODE
#define N_LAUNCH_MODE 0
#endif

extern "C" void kernel_launch(void* const* d_in, const int* in_sizes, int n_in, void* d_out, int out_size, void* d_ws, size_t ws_size, hipStream_t stream) {
    static int grid = 0;
    if (grid == 0) {
        if (n_in != 22 || out_size != M * D || ws_size < WS_END) { fprintf(stderr, "kernel_launch: unexpected shapes (n_in %d out %d ws %zu need %zu)\n", n_in, out_size, ws_size, (size_t)WS_END); grid = -1; return; }
        int dev = 0, cus = 0, per_cu = 0;
        if (hipGetDevice(&dev) != hipSuccess || hipDeviceGetAttribute(&cus, hipDeviceAttributeMultiprocessorCount, dev) != hipSuccess) { grid = -1; return; }
        if (hipFuncSetAttribute((const void*)mega, hipFuncAttributeMaxDynamicSharedMemorySize, LDS_BYTES) != hipSuccess) { fprintf(stderr, "kernel_launch: hipFuncSetAttribute failed\n"); grid = -1; return; }
        if (hipOccupancyMaxActiveBlocksPerMultiprocessor(&per_cu, (const void*)mega, NTHR, LDS_BYTES) != hipSuccess || per_cu < 1) { fprintf(stderr, "kernel_launch: occupancy query says %d\n", per_cu); }
        (void)hipGetLastError();
        grid = cus;
    }
    if (grid < 0) return;
    (void)hipMemsetAsync((char*)d_ws + WS_CTL, 0, CTL_BYTES, stream);
    Args a{};
    for (int i = 0; i < 22; ++i) a.in[i] = (const float*)d_in[i];
    a.out = (float*)d_out; a.ws = (unsigned char*)d_ws;
    const int nph = count_phases();
#if N_LAUNCH_MODE == 1
    a.ph_lo = 0; a.ph_hi = nph;
    hipLaunchKernelGGL(mega, dim3(grid), dim3(NTHR), LDS_BYTES, stream, a);
#else
    for (int p = 0; p < nph; ++p) { a.ph_lo = p; a.ph_hi = p + 1; hipLaunchKernelGGL(mega, dim3(grid), dim3(NTHR), LDS_BYTES, stream, a); }
#endif
}
```
